# Optimizing an MI355X kernel written in HIP

```python
import math
import jax, jax.numpy as jnp
from jax import lax
import numpy as np

D_MODEL = 1024
BATCH = 2
SEQ = 16384
DEPTH = 1

HEAD_DIM = 64
DIFF_HEADS = 4
DIFF_V_DIM = 2 * HEAD_DIM
SWA_Q_HEADS = 8
SWA_KV_HEADS = 2
SWA_GROUP = SWA_Q_HEADS // SWA_KV_HEADS
WINDOW = 128
Q_BLOCK = 128
ROPE_THETA = 10000.0
N_GROUPS = 4
EXPERTS_PER_GROUP = 8
N_EXPERTS = N_GROUPS * EXPERTS_PER_GROUP
TOP_K_IN_GROUP = 2
EXPERT_FF = 512
EXPERT_BLOCK = 256
EPS = 1e-6
NEG = -1e30

DIFF_QK_COLS = DIFF_HEADS * 2 * HEAD_DIM
DIFF_V_COLS = DIFF_HEADS * DIFF_V_DIM
SWA_Q_COLS = SWA_Q_HEADS * HEAD_DIM
SWA_KV_COLS = SWA_KV_HEADS * HEAD_DIM
IN_COLS = 2 * DIFF_QK_COLS + DIFF_V_COLS + SWA_Q_COLS + 2 * SWA_KV_COLS
MIX_WIDTH = DIFF_V_COLS + SWA_Q_COLS
SPLITS = [DIFF_QK_COLS, 2 * DIFF_QK_COLS, 2 * DIFF_QK_COLS + DIFF_V_COLS,
          2 * DIFF_QK_COLS + DIFF_V_COLS + SWA_Q_COLS,
          2 * DIFF_QK_COLS + DIFF_V_COLS + SWA_Q_COLS + SWA_KV_COLS]

kernel_name = "hymba_diffattn_swasink_hiermoe"


def rms_norm(x, g):
    xf = x.astype(jnp.float32)
    y = xf * lax.rsqrt(jnp.mean(xf * xf, axis=-1, keepdims=True) + EPS)
    return (y * g.astype(jnp.float32)).astype(x.dtype)


def rope_tables(seq):
    inv = 1.0 / (ROPE_THETA ** (jnp.arange(0, HEAD_DIM, 2, dtype=jnp.float32) / HEAD_DIM))
    ang = jnp.arange(seq, dtype=jnp.float32)[:, None] * inv[None, :]
    return jnp.cos(ang), jnp.sin(ang)


def apply_rope(x, cos, sin):
    half = x.shape[-1] // 2
    shape = (1, x.shape[1]) + (1,) * (x.ndim - 3) + (half,)
    c = cos.reshape(shape).astype(x.dtype)
    s = sin.reshape(shape).astype(x.dtype)
    x1, x2 = x[..., :half], x[..., half:]
    return jnp.concatenate([x1 * c - x2 * s, x1 * s + x2 * c], axis=-1)


def diff_attention(q, k, v, lam, subln_g, lambda_init):
    B, S = q.shape[0], q.shape[1]
    nq = S // Q_BLOCK
    scale = HEAD_DIM ** -0.5
    qb = q.reshape(B, nq, Q_BLOCK, DIFF_HEADS, 2, HEAD_DIM).transpose(1, 0, 2, 3, 4, 5)
    kpos = jnp.arange(S)

    def block(args):
        qblk, i = args
        s = jnp.einsum('bqhcd,bkhcd->bhcqk', qblk, k).astype(jnp.float32) * scale
        qpos = i * Q_BLOCK + jnp.arange(Q_BLOCK)
        causal = kpos[None, :] <= qpos[:, None]
        p = jax.nn.softmax(jnp.where(causal, s, NEG), axis=-1)
        a = p[:, :, 0] - lam * p[:, :, 1]
        return jnp.einsum('bhqk,bkhd->bqhd', a.astype(v.dtype), v)

    o = lax.map(block, (qb, jnp.arange(nq)))
    o = o.transpose(1, 0, 2, 3, 4).reshape(B, S, DIFF_HEADS, DIFF_V_DIM)
    o = rms_norm(o, subln_g) * (1.0 - lambda_init)
    return o.reshape(B, S, DIFF_V_COLS)


def swa_sink_attention(q, k, v, sinks):
    B, S = q.shape[0], q.shape[1]
    nb = S // WINDOW
    scale = HEAD_DIM ** -0.5
    qb = q.reshape(B, nb, WINDOW, SWA_KV_HEADS, SWA_GROUP, HEAD_DIM)

    def with_prev(t):
        t = t.reshape(B, nb, WINDOW, SWA_KV_HEADS, HEAD_DIM)
        prev = jnp.concatenate([jnp.zeros_like(t[:, :1]), t[:, :-1]], axis=1)
        return jnp.concatenate([prev, t], axis=2)

    kw, vw = with_prev(k), with_prev(v)
    s = jnp.einsum('bnqkgd,bnjkd->bnkgqj', qb, kw).astype(jnp.float32) * scale
    qi = jnp.arange(WINDOW)[:, None]
    kj = jnp.arange(2 * WINDOW)[None, :]
    rel = qi + WINDOW - kj
    band = (rel >= 0) & (rel < WINDOW)
    blk = jnp.arange(nb)[:, None, None]
    valid = band[None] & ((blk * WINDOW + kj[None] - WINDOW) >= 0)
    s = jnp.where(valid[None, :, None, None], s, NEG)
    sink = jnp.broadcast_to(
        sinks.astype(jnp.float32).reshape(SWA_KV_HEADS, SWA_GROUP)[None, None, :, :, None, None],
        s.shape[:-1] + (1,))
    p = jax.nn.softmax(jnp.concatenate([s, sink], axis=-1), axis=-1)[..., :-1]
    o = jnp.einsum('bnkgqj,bnjkd->bnqkgd', p.astype(v.dtype), vw)
    return o.reshape(B, S, SWA_Q_COLS)


def hier_moe(xn, w_rg, b_rg, w_re, b_re, w_gate, w_up, w_down):
    B, S, D = xn.shape
    T = B * S
    xt = xn.reshape(T, D)
    pg = jax.nn.softmax((xt @ w_rg).astype(jnp.float32) + b_rg.astype(jnp.float32), axis=-1)
    p_top, g_idx = lax.top_k(pg, 1)
    el = ((xt @ w_re).astype(jnp.float32) + b_re.astype(jnp.float32)).reshape(T, N_GROUPS, EXPERTS_PER_GROUP)
    el_sel = jnp.take_along_axis(el, g_idx[:, :, None], axis=1)[:, 0]
    v2, i2 = lax.top_k(el_sel, TOP_K_IN_GROUP)
    gates = jax.nn.softmax(v2, axis=-1) * p_top
    expert_id = (g_idx * EXPERTS_PER_GROUP + i2).astype(jnp.int32)

    A = T * TOP_K_IN_GROUP
    NB = -(-A // EXPERT_BLOCK) + N_EXPERTS
    P = NB * EXPERT_BLOCK
    e_flat = expert_id.reshape(A)
    g_flat = gates.reshape(A)
    tok_flat = jnp.arange(A, dtype=jnp.int32) // TOP_K_IN_GROUP
    order = jnp.argsort(e_flat)
    e_s, g_s, tok_s = e_flat[order], g_flat[order], tok_flat[order]
    counts = jnp.bincount(e_flat, length=N_EXPERTS).astype(jnp.int32)
    start = jnp.cumsum(counts) - counts
    padded = ((counts + EXPERT_BLOCK - 1) // EXPERT_BLOCK) * EXPERT_BLOCK
    pad_end = jnp.cumsum(padded)
    pad_start = pad_end - padded
    dest = pad_start[e_s] + (jnp.arange(A, dtype=jnp.int32) - start[e_s])
    slot_tok = jnp.full((P,), T, jnp.int32).at[dest].set(tok_s)
    slot_gate = jnp.zeros((P,), jnp.float32).at[dest].set(g_s)
    block_start = jnp.arange(NB, dtype=jnp.int32) * EXPERT_BLOCK
    block_expert = jnp.minimum(jnp.searchsorted(pad_end, block_start, side='right'),
                               N_EXPERTS - 1).astype(jnp.int32)
    x_pad = jnp.concatenate([xt, jnp.zeros((1, D), xt.dtype)], axis=0)
    xs = x_pad[slot_tok].reshape(NB, EXPERT_BLOCK, D)

    def run_block(args):
        xb, e = args
        h = jax.nn.silu(xb @ w_gate[e]) * (xb @ w_up[e])
        return h @ w_down[e]

    ys = lax.map(run_block, (xs, block_expert)).reshape(P, D)
    out = jnp.zeros((T + 1, D), jnp.float32).at[slot_tok].add(ys.astype(jnp.float32) * slot_gate[:, None])[:T]
    return out.reshape(B, S, D).astype(xn.dtype)


def setup_inputs(seed: int = 0) -> dict:
    key = jax.random.key(seed)
    ks = jax.random.split(key, 20)
    f32 = jnp.float32
    L, D = DEPTH, D_MODEL
    nrm = lambda k, shape, s: jax.random.normal(k, shape, f32) * s
    return {
        "x": nrm(ks[0], (BATCH, SEQ, D), 1.0),
        "norm1_g": 1.0 + nrm(ks[1], (L, D), 0.05),
        "w_in": nrm(ks[2], (L, D, IN_COLS), D ** -0.5),
        "lambda_q1": nrm(ks[3], (L, HEAD_DIM), 0.1),
        "lambda_k1": nrm(ks[4], (L, HEAD_DIM), 0.1),
        "lambda_q2": nrm(ks[5], (L, HEAD_DIM), 0.1),
        "lambda_k2": nrm(ks[6], (L, HEAD_DIM), 0.1),
        "subln_g": 1.0 + nrm(ks[7], (L, DIFF_V_DIM), 0.05),
        "sinks": nrm(ks[8], (L, SWA_Q_HEADS), 0.5),
        "w_out": nrm(ks[9], (L, MIX_WIDTH, D), MIX_WIDTH ** -0.5),
        "norm2_g": 1.0 + nrm(ks[10], (L, D), 0.05),
        "w_router_group": nrm(ks[11], (L, D, N_GROUPS), D ** -0.5),
        "b_router_group": nrm(ks[12], (L, N_GROUPS), 0.01),
        "w_router_expert": nrm(ks[13], (L, D, N_EXPERTS), D ** -0.5),
        "b_router_expert": nrm(ks[14], (L, N_EXPERTS), 0.01),
        "w_gate": nrm(ks[15], (L, N_EXPERTS, D, EXPERT_FF), D ** -0.5),
        "w_up": nrm(ks[16], (L, N_EXPERTS, D, EXPERT_FF), D ** -0.5),
        "w_down": nrm(ks[17], (L, N_EXPERTS, EXPERT_FF, D), EXPERT_FF ** -0.5),
        "final_g": 1.0 + nrm(ks[18], (D,), 0.05),
    }


def reference(x, norm1_g, w_in, lambda_q1, lambda_k1, lambda_q2, lambda_k2, subln_g, sinks,
              w_out, norm2_g, w_router_group, b_router_group, w_router_expert, b_router_expert,
              w_gate, w_up, w_down, final_g):
    B, S, D = x.shape
    cos, sin = rope_tables(S)
    for l in range(DEPTH):
        lambda_init = 0.8 - 0.6 * math.exp(-0.3 * l)
        n1 = rms_norm(x, norm1_g[l])
        qkv = n1 @ w_in[l]
        dq, dk, dv, sq, sk, sv = jnp.split(qkv, SPLITS, axis=-1)
        dq = apply_rope(dq.reshape(B, S, DIFF_HEADS, 2, HEAD_DIM), cos, sin)
        dk = apply_rope(dk.reshape(B, S, DIFF_HEADS, 2, HEAD_DIM), cos, sin)
        dv = dv.reshape(B, S, DIFF_HEADS, DIFF_V_DIM)
        lam = (jnp.exp(jnp.sum(lambda_q1[l].astype(jnp.float32) * lambda_k1[l].astype(jnp.float32)))
               - jnp.exp(jnp.sum(lambda_q2[l].astype(jnp.float32) * lambda_k2[l].astype(jnp.float32)))
               + lambda_init)
        o_diff = diff_attention(dq, dk, dv, lam, subln_g[l], lambda_init)
        sq = apply_rope(sq.reshape(B, S, SWA_Q_HEADS, HEAD_DIM), cos, sin)
        sk = apply_rope(sk.reshape(B, S, SWA_KV_HEADS, HEAD_DIM), cos, sin)
        sv = sv.reshape(B, S, SWA_KV_HEADS, HEAD_DIM)
        o_swa = swa_sink_attention(sq, sk, sv, sinks[l])
        x = x + jnp.concatenate([o_diff, o_swa], axis=-1) @ w_out[l]
        n2 = rms_norm(x, norm2_g[l])
        x = x + hier_moe(n2, w_router_group[l], b_router_group[l], w_router_expert[l],
                         b_router_expert[l], w_gate[l], w_up[l], w_down[l])
    return rms_norm(x, final_g)
```

```cpp
#include <hip/hip_runtime.h>
#include <cstdio>
#include <cstdint>
namespace pg8 {
#define PG8_LAS __attribute__((address_space(3)))
typedef unsigned short bf16_t;
typedef short bf16x8 __attribute__((ext_vector_type(8)));
typedef float f32x4 __attribute__((ext_vector_type(4)));
typedef unsigned u32x4 __attribute__((ext_vector_type(4)));
constexpr int BM = 256, BK = 64, HALF = 128, HTB = HALF * BK * 2  , STAGE_BYTES = 8 * HTB, NXCD = 8, WGM = 8;

__host__ __device__ __forceinline__ int lds_byte(int r, int c) { const int st = (r >> 4) * 2 + (c >> 5), rr = r & 15, cc = c & 31, ob = rr * 64 + cc * 2; return st * 1024 + (ob ^ (((ob >> 9) & 1) << 5)); }
__host__ __device__ __forceinline__ void stage_rc(int b, int& R, int& C) { const int st = b / 1024, sb = b % 1024, swz = sb ^ (((sb >> 9) & 1) << 5); R = (st >> 1) * 16 + swz / 64; C = (st & 1) * 32 + (swz % 64) / 2; }
__host__ __device__ __forceinline__ int perm32(int rho) { const int n = rho >> 4, i = rho & 15; return 8 * (i >> 2) + 4 * n + (i & 3); }

struct Unit { int pm, pn; };
struct Gemm { const bf16_t* A; const bf16_t* Bt; int M, N, K; };

struct StaticOrder {
    int nM, nN, nwg, G, c;
    __host__ __device__ void init(int M, int N, int G_, int c_) { nM = M / BM; nN = N / BM; nwg = nM * nN; G = G_; c = c_; }
    __host__ __device__ bool next(int i, Unit& u) const {
        const long L = (long)i * G + c; if (L >= nwg) return false;
        int wgid = (int)L; { const int q = nwg / NXCD, r = nwg % NXCD, xcd = wgid % NXCD, off = wgid / NXCD; wgid = (xcd < r ? xcd * (q + 1) : r * (q + 1) + (xcd - r) * q) + off; }
        const int nig = WGM * nN, gid = wgid / nig, fm = gid * WGM, gsz = (nM - fm) < WGM ? (nM - fm) : WGM;
        u.pm = fm + ((wgid % nig) % gsz); u.pn = (wgid % nig) / gsz; return true;
    }
    __device__ __forceinline__ void a_ready(const Unit&) const {}
    __device__ __forceinline__ void done(const Unit&) const {}
};

__device__ __forceinline__ unsigned cvt_pk_bf16(float lo, float hi) { unsigned r; asm volatile("v_cvt_pk_bf16_f32 %0, %1, %2" : "=v"(r) : "v"(lo), "v"(hi)); return r; }
typedef float f32x2 __attribute__((ext_vector_type(2)));
__device__ __forceinline__ f32x2 gelu_pk(f32x2 v) {
    const f32x2 av = __builtin_elementwise_abs(v), d = av * 0.2316418882f + 1.0f;
    f32x2 t; t.x = __builtin_amdgcn_rcpf(d.x); t.y = __builtin_amdgcn_rcpf(d.y);
    f32x2 q = t * 0.5307027145f + (-0.7265760135f); q = q * t + 0.7107068705f; q = q * t + (-0.142248368f); q = q * t + 0.127414796f; q = q * t;
    const f32x2 s = (v * v) * (-0.72134752044f);
    f32x2 e; e.x = __builtin_amdgcn_exp2f(s.x); e.y = __builtin_amdgcn_exp2f(s.y);
    const f32x2 m = v * (q * e), r = v - m;
    f32x2 o; o.x = v.x < 0.f ? m.x : r.x; o.y = v.y < 0.f ? m.y : r.y; return o;
}

template <int ACT  > struct EpiBf16 {
    static constexpr bool PERM = true, AFTER_DRAIN = false; static_assert(ACT == 0 || ACT == 1, "EpiBf16: ACT is 0 (none) or 1 (gelu_pk)");
    bf16_t* O; int ldc; const float* bias; int split_cols; size_t split_stride; float scale0;
    __device__ __forceinline__ void operator()(const f32x4 (&acc)[2][2][4][2], const Unit& u, int wr, int wc, int fr, int fq) const {
        const int row0 = u.pm * BM + wr * 64 + fr; int colt = u.pn * BM; bf16_t* base = O;
        float sc = 1.f; if (split_cols) { const int t = colt / split_cols; base += (size_t)t * split_stride; colt -= t * split_cols; if (t == 0) sc = scale0; }
        const int col0 = colt + wc * 32 + 8 * fq, bcol0 = u.pn * BM + wc * 32 + 8 * fq;
        f32x4 bv[2][2];
#pragma unroll
        for (int bj = 0; bj < 2; ++bj)
#pragma unroll
            for (int n = 0; n < 2; ++n) bv[bj][n] = bias ? *(const f32x4*)(bias + bcol0 + bj * HALF + 4 * n) : (f32x4){0.f, 0.f, 0.f, 0.f};
#pragma unroll
        for (int ai = 0; ai < 2; ++ai)
#pragma unroll
            for (int m = 0; m < 4; ++m) { bf16_t* rowp = base + (size_t)(row0 + ai * HALF + m * 16) * ldc + col0;
#pragma unroll
                for (int bj = 0; bj < 2; ++bj) { f32x4 v0 = acc[ai][bj][m][0] + bv[bj][0], v1 = acc[ai][bj][m][1] + bv[bj][1];
                    if (ACT == 1) { f32x2 a = gelu_pk((f32x2){v0[0], v0[1]}), b = gelu_pk((f32x2){v0[2], v0[3]}), c = gelu_pk((f32x2){v1[0], v1[1]}), d = gelu_pk((f32x2){v1[2], v1[3]});
                        v0 = (f32x4){a.x, a.y, b.x, b.y}; v1 = (f32x4){c.x, c.y, d.x, d.y}; }
                    v0 = v0 * sc; v1 = v1 * sc; u32x4 w; w.x = cvt_pk_bf16(v0[0], v0[1]); w.y = cvt_pk_bf16(v0[2], v0[3]); w.z = cvt_pk_bf16(v1[0], v1[1]); w.w = cvt_pk_bf16(v1[2], v1[3]);
                    *(u32x4*)(rowp + bj * HALF) = w; } }
    }
};

constexpr int QKV_LD = 2304, SEQ_LEN = 16384;
struct EpiQKV {
    static constexpr bool PERM = true, AFTER_DRAIN = false;
    bf16_t* O; const float* rope; float qscale;
    __device__ __forceinline__ void operator()(const f32x4 (&acc)[2][2][4][2], const Unit& u, int wr, int wc, int fr, int fq) const {
        const int row0 = u.pm * BM + wr * 64 + fr;
#pragma unroll
        for (int bj = 0; bj < 2; ++bj) {
            const int cb = u.pn * BM + bj * HALF, col0 = cb + wc * 32 + 8 * fq;
            const bool isrope = (cb < 1024) || (cb >= 1536 && cb < 2176);
            const float sc = ((cb < 512) || (cb >= 1536 && cb < 2048)) ? qscale : 1.f;
            const int i0 = (col0 & 63) >> 1;
#pragma unroll
            for (int ai = 0; ai < 2; ++ai)
#pragma unroll
                for (int m = 0; m < 4; ++m) {
                    const int row = row0 + ai * HALF + m * 16;
                    f32x4 v0 = acc[ai][bj][m][0], v1 = acc[ai][bj][m][1];
                    if (isrope) {
                        const int pos = row & (SEQ_LEN - 1);
                        const f32x4* tp = (const f32x4*)(rope + ((size_t)pos * 32 + i0) * 2);
                        const f32x4 t0 = tp[0], t1 = tp[1];
                        f32x4 r0, r1;
                        r0[0] = v0[0] * t0[0] - v0[1] * t0[1]; r0[1] = v0[0] * t0[1] + v0[1] * t0[0];
                        r0[2] = v0[2] * t0[2] - v0[3] * t0[3]; r0[3] = v0[2] * t0[3] + v0[3] * t0[2];
                        r1[0] = v1[0] * t1[0] - v1[1] * t1[1]; r1[1] = v1[0] * t1[1] + v1[1] * t1[0];
                        r1[2] = v1[2] * t1[2] - v1[3] * t1[3]; r1[3] = v1[2] * t1[3] + v1[3] * t1[2];
                        v0 = r0; v1 = r1;
                    }
                    v0 = v0 * sc; v1 = v1 * sc;
                    u32x4 w; w.x = cvt_pk_bf16(v0[0], v0[1]); w.y = cvt_pk_bf16(v0[2], v0[3]); w.z = cvt_pk_bf16(v1[0], v1[1]); w.w = cvt_pk_bf16(v1[2], v1[3]);
                    *(u32x4*)(O + (size_t)row * QKV_LD + col0) = w;
                }
        }
    }
};
struct EpiResid {
    static constexpr bool PERM = true, AFTER_DRAIN = false;
    const float* x; float* h; bf16_t* hb;
    __device__ __forceinline__ void operator()(const f32x4 (&acc)[2][2][4][2], const Unit& u, int wr, int wc, int fr, int fq) const {
        const int row0 = u.pm * BM + wr * 64 + fr;
#pragma unroll
        for (int ai = 0; ai < 2; ++ai)
#pragma unroll
            for (int m = 0; m < 4; ++m) {
                const size_t ro = (size_t)(row0 + ai * HALF + m * 16) * 1024;
#pragma unroll
                for (int bj = 0; bj < 2; ++bj) {
                    const size_t o = ro + u.pn * BM + bj * HALF + wc * 32 + 8 * fq;
                    const f32x4 v0 = acc[ai][bj][m][0] + *(const f32x4*)(x + o), v1 = acc[ai][bj][m][1] + *(const f32x4*)(x + o + 4);
                    *(f32x4*)(h + o) = v0; *(f32x4*)(h + o + 4) = v1;
                    u32x4 w; w.x = cvt_pk_bf16(v0[0], v0[1]); w.y = cvt_pk_bf16(v0[2], v0[3]); w.z = cvt_pk_bf16(v1[0], v1[1]); w.w = cvt_pk_bf16(v1[2], v1[3]);
                    *(u32x4*)(hb + o) = w;
                }
            }
    }
};
__device__ __forceinline__ float silu_mul(float g, float up) { return g * __builtin_amdgcn_rcpf(1.0f + __builtin_amdgcn_exp2f(-1.4426950408889634f * g)) * up; }
struct EpiGateUp {
    static constexpr bool PERM = true, AFTER_DRAIN = false;
    bf16_t* hm; const float* slot_rstd;
    __device__ __forceinline__ void operator()(const f32x4 (&acc)[2][2][4][2], const Unit& u, int wr, int wc, int fr, int fq) const {
        const int row0 = u.pm * BM + wr * 64 + fr, f0 = (u.pn & 3) * 128 + wc * 32 + 8 * fq;
#pragma unroll
        for (int ai = 0; ai < 2; ++ai)
#pragma unroll
            for (int m = 0; m < 4; ++m) {
                const int row = row0 + ai * HALF + m * 16; const float rs = slot_rstd[row];
                const f32x4 g0 = acc[ai][0][m][0] * rs, g1 = acc[ai][0][m][1] * rs, u0 = acc[ai][1][m][0] * rs, u1 = acc[ai][1][m][1] * rs;
                u32x4 w; w.x = cvt_pk_bf16(silu_mul(g0[0], u0[0]), silu_mul(g0[1], u0[1])); w.y = cvt_pk_bf16(silu_mul(g0[2], u0[2]), silu_mul(g0[3], u0[3]));
                w.z = cvt_pk_bf16(silu_mul(g1[0], u1[0]), silu_mul(g1[1], u1[1])); w.w = cvt_pk_bf16(silu_mul(g1[2], u1[2]), silu_mul(g1[3], u1[3]));
                *(u32x4*)(hm + (size_t)row * 512 + f0) = w;
            }
    }
};
struct EpiDown {
    static constexpr bool PERM = true, AFTER_DRAIN = false;
    bf16_t* Y; const int* slot_dst; const float* slot_gate;
    __device__ __forceinline__ void operator()(const f32x4 (&acc)[2][2][4][2], const Unit& u, int wr, int wc, int fr, int fq) const {
        const int row0 = u.pm * BM + wr * 64 + fr, c0 = (u.pn & 3) * BM + wc * 32 + 8 * fq;
#pragma unroll
        for (int ai = 0; ai < 2; ++ai)
#pragma unroll
            for (int m = 0; m < 4; ++m) {
                const int row = row0 + ai * HALF + m * 16; const int dst = slot_dst[row]; const float gt = slot_gate[row];
                if (dst >= 0) {
#pragma unroll
                    for (int bj = 0; bj < 2; ++bj) { const f32x4 v0 = acc[ai][bj][m][0] * gt, v1 = acc[ai][bj][m][1] * gt;
                        u32x4 w; w.x = cvt_pk_bf16(v0[0], v0[1]); w.y = cvt_pk_bf16(v0[2], v0[3]); w.z = cvt_pk_bf16(v1[0], v1[1]); w.w = cvt_pk_bf16(v1[2], v1[3]);
                        *(u32x4*)(Y + (size_t)dst * 1024 + c0 + bj * HALF) = w; }
                }
            }
    }
};
struct MoeSched {
    const unsigned* blk_e; int nunits, G, c;
    __device__ __forceinline__ bool next(int i, Unit& u) const {
        const long L = (long)i * G + c; if (L >= nunits) return false;
        int wgid = (int)L; { const int q = nunits / NXCD, r = nunits % NXCD, xcd = wgid % NXCD, off = wgid / NXCD; wgid = (xcd < r ? xcd * (q + 1) : r * (q + 1) + (xcd - r) * q) + off; }
        const int rb = wgid >> 2, j = wgid & 3;
        const int e = __builtin_amdgcn_readfirstlane((int)__hip_atomic_load(blk_e + rb, __ATOMIC_RELAXED, __HIP_MEMORY_SCOPE_AGENT));
        u.pm = rb; u.pn = e * 4 + j; return true;
    }
    __device__ __forceinline__ void a_ready(const Unit&) const {}
    __device__ __forceinline__ void done(const Unit&) const {}
};
template <class Epi, class Sched, bool ALIGN_EPI = false, bool SP2 = false>
__device__ __forceinline__ void gemm_phase(PG8_LAS unsigned char* lds, const Gemm g, const Sched& S, const Epi& E) {
    int tid_ = threadIdx.x; asm volatile("" : "+v"(tid_));
    const int tid = tid_, wid = __builtin_amdgcn_readfirstlane(tid >> 6), lane = tid & 63, wr = wid >> 2, wc = wid & 3, fr = lane & 15, fq = lane >> 4;
    const int K = g.K, nt = K / BK;
    unsigned voffA[2], voffB[2];
#pragma unroll
    for (int i = 0; i < 2; ++i) { int R, C; stage_rc(tid * 16 + i * 8192, R, C); const int Rb = Epi::PERM ? ((R & ~31) + perm32(R & 31)) : R;
        voffA[i] = (unsigned)(R * K + C) * 2u; voffB[i] = (unsigned)(Rb * K + C) * 2u; }
    const size_t kstep = (size_t)(BK * 2);
    const size_t hstep = (size_t)HALF * K * 2;
    const size_t tstep = 2 * hstep;
    const unsigned ldsw = (unsigned)wid * 1024u;
    const int aoff = lds_byte(wr * 64 + fr, fq * 8), boff = lds_byte(wc * 32 + fr, fq * 8);
#define PG8_SA(b, h) (((b) * 2 + (h)) * HTB)
#define PG8_SB(b, h) ((4 + (b) * 2 + (h)) * HTB)
#define PG8_STAGE(bufoff, gbase, voff) do { _Pragma("unroll") for (int _i = 0; _i < 2; ++_i) \
        __builtin_amdgcn_global_load_lds((const unsigned*)((const char*)(gbase) + (voff)[_i]), (PG8_LAS unsigned*)(lds + (bufoff) + ldsw + _i * 8192), 16, 0, 0); } while (0)
#define PG8_LDA(dst, b, h) do { _Pragma("unroll") for (int m = 0; m < 4; ++m) _Pragma("unroll") for (int k = 0; k < 2; ++k) dst[m][k] = *(const PG8_LAS bf16x8*)(lds + PG8_SA(b, h) + aoff + m * 2048 + k * 1024); } while (0)
#define PG8_LDB(dst, b, h) do { _Pragma("unroll") for (int n = 0; n < 2; ++n) _Pragma("unroll") for (int k = 0; k < 2; ++k) dst[n][k] = *(const PG8_LAS bf16x8*)(lds + PG8_SB(b, h) + boff + n * 2048 + k * 1024); } while (0)
#define PG8_MMA(ai, bj, At, Bt) do { __builtin_amdgcn_s_setprio(1); _Pragma("unroll") for (int m = 0; m < 4; ++m) _Pragma("unroll") for (int n = 0; n < 2; ++n) _Pragma("unroll") for (int k = 0; k < 2; ++k) \
        acc[ai][bj][m][n] = __builtin_amdgcn_mfma_f32_16x16x32_bf16(Bt[n][k], At[m][k], acc[ai][bj][m][n], 0, 0, 0); __builtin_amdgcn_s_setprio(0); } while (0)
#define PG8_WAIT_V(n) asm volatile("s_waitcnt vmcnt(" #n ")" ::: "memory")
#define PG8_WAIT_L(n) asm volatile("s_waitcnt lgkmcnt(" #n ")" ::: "memory")
#define PG8_BAR __builtin_amdgcn_s_barrier()
#define PG8_SCHED __builtin_amdgcn_sched_barrier(0)
    Unit cur, nxt; int ui = 0;
    if (!S.next(0, cur)) return;
    f32x4 acc[2][2][4][2];
#pragma unroll
    for (int a = 0; a < 2; ++a)
#pragma unroll
        for (int b = 0; b < 2; ++b)
#pragma unroll
            for (int m = 0; m < 4; ++m)
#pragma unroll
                for (int n = 0; n < 2; ++n) acc[a][b][m][n] = (f32x4){0.f, 0.f, 0.f, 0.f};
    bf16x8 At[4][2], B0[2][2], B1[2][2];
    const char* cA = (const char*)g.A + (size_t)cur.pm * tstep; const char* cB = (const char*)g.Bt + (size_t)cur.pn * tstep;
    S.a_ready(cur);
    if constexpr (SP2) {
        PG8_STAGE(PG8_SB(0, 0), cB, voffB); PG8_STAGE(PG8_SB(0, 1), cB + hstep, voffB); PG8_STAGE(PG8_SA(0, 0), cA, voffA); PG8_STAGE(PG8_SA(0, 1), cA + hstep, voffA);
        if (wr == 1) PG8_BAR;
        PG8_WAIT_V(2); PG8_BAR;
        PG8_STAGE(PG8_SB(1, 0), cB + kstep, voffB); PG8_STAGE(PG8_SA(1, 0), cA + kstep, voffA); PG8_STAGE(PG8_SB(1, 1), cB + hstep + kstep, voffB);
        PG8_WAIT_V(6); PG8_BAR;
    } else {
        PG8_STAGE(PG8_SB(0, 0), cB, voffB); PG8_STAGE(PG8_SA(0, 0), cA, voffA); PG8_STAGE(PG8_SB(0, 1), cB + hstep, voffB); PG8_STAGE(PG8_SA(0, 1), cA + hstep, voffA);
        if (wr == 1) PG8_BAR;
        PG8_WAIT_V(4); PG8_BAR;
        PG8_STAGE(PG8_SB(1, 0), cB + kstep, voffB); PG8_STAGE(PG8_SA(1, 0), cA + kstep, voffA); PG8_STAGE(PG8_SB(1, 1), cB + hstep + kstep, voffB);
        PG8_WAIT_V(6); PG8_BAR;
    }
    for (;;) {
        const bool has_next = S.next(ui + 1, nxt);
        const char* nA = has_next ? (const char*)g.A + (size_t)nxt.pm * tstep : cA; const char* nB = has_next ? (const char*)g.Bt + (size_t)nxt.pn * tstep : cB;
        for (int t = 0; t < nt; t += 2) {
            const bool last = (t == nt - 2);
            const char* a1 = cA + (size_t)(t + 1) * kstep;
            const char* a2 = last ? nA : cA + (size_t)(t + 2) * kstep; const char* b2 = last ? nB : cB + (size_t)(t + 2) * kstep;
            const char* a3 = a2 + kstep; const char* b3 = b2 + kstep;
            if (last && has_next) S.a_ready(nxt);
            if constexpr (SP2) {
            PG8_LDB(B0, 0, 0); PG8_LDB(B1, 0, 1); PG8_SCHED; PG8_LDA(At, 0, 0); PG8_STAGE(PG8_SA(1, 1), a1 + hstep, voffA);
            PG8_WAIT_V(8); PG8_WAIT_L(0); PG8_BAR; PG8_MMA(0, 0, At, B0); PG8_MMA(0, 1, At, B1); PG8_BAR; PG8_SCHED;
            PG8_LDA(At, 0, 1); PG8_STAGE(PG8_SB(0, 0), b2, voffB); PG8_STAGE(PG8_SB(0, 1), b2 + hstep, voffB); PG8_STAGE(PG8_SA(0, 0), a2, voffA);
            PG8_WAIT_V(8); PG8_WAIT_L(0); PG8_BAR; PG8_MMA(1, 0, At, B0); PG8_MMA(1, 1, At, B1); PG8_BAR; PG8_SCHED;
            PG8_LDB(B0, 1, 0); PG8_LDB(B1, 1, 1); PG8_SCHED; PG8_LDA(At, 1, 0); PG8_STAGE(PG8_SA(0, 1), a2 + hstep, voffA);
            PG8_WAIT_V(8); PG8_WAIT_L(0); PG8_BAR; PG8_MMA(0, 0, At, B0); PG8_MMA(0, 1, At, B1); PG8_BAR; PG8_SCHED;
            PG8_LDA(At, 1, 1); PG8_STAGE(PG8_SB(1, 0), b3, voffB); PG8_STAGE(PG8_SB(1, 1), b3 + hstep, voffB); PG8_STAGE(PG8_SA(1, 0), a3, voffA);
            PG8_WAIT_V(8); PG8_WAIT_L(0); PG8_BAR; PG8_MMA(1, 0, At, B0); PG8_MMA(1, 1, At, B1); PG8_BAR; PG8_SCHED;
            } else {
            PG8_LDB(B0, 0, 0); PG8_SCHED; PG8_LDA(At, 0, 0); PG8_STAGE(PG8_SA(1, 1), a1 + hstep, voffA);
            PG8_WAIT_L(8); PG8_BAR; PG8_WAIT_L(0); PG8_MMA(0, 0, At, B0); PG8_BAR; PG8_SCHED;
            PG8_LDB(B1, 0, 1); PG8_STAGE(PG8_SB(0, 0), b2, voffB);
            PG8_BAR; PG8_WAIT_L(0); PG8_MMA(0, 1, At, B1); PG8_BAR;
            PG8_LDA(At, 0, 1); PG8_STAGE(PG8_SA(0, 0), a2, voffA);
            PG8_BAR; PG8_WAIT_L(0); PG8_MMA(1, 0, At, B0); PG8_BAR; PG8_SCHED;
            PG8_STAGE(PG8_SB(0, 1), b2 + hstep, voffB);
            PG8_WAIT_V(6); PG8_BAR; PG8_MMA(1, 1, At, B1); PG8_BAR;
            PG8_LDB(B0, 1, 0); PG8_SCHED; PG8_LDA(At, 1, 0); PG8_STAGE(PG8_SA(0, 1), a2 + hstep, voffA);
            PG8_WAIT_L(8); PG8_BAR; PG8_WAIT_L(0); PG8_MMA(0, 0, At, B0); PG8_BAR; PG8_SCHED;
            PG8_LDB(B1, 1, 1); PG8_STAGE(PG8_SB(1, 0), b3, voffB);
            PG8_BAR; PG8_WAIT_L(0); PG8_MMA(0, 1, At, B1); PG8_BAR;
            PG8_LDA(At, 1, 1); PG8_STAGE(PG8_SA(1, 0), a3, voffA);
            PG8_BAR; PG8_WAIT_L(0); PG8_MMA(1, 0, At, B0); PG8_BAR; PG8_SCHED;
            PG8_STAGE(PG8_SB(1, 1), b3 + hstep, voffB);
            PG8_WAIT_V(6); PG8_BAR; PG8_MMA(1, 1, At, B1); PG8_BAR;
            }
        }
        if constexpr (ALIGN_EPI) { if (wr == 0) PG8_BAR; }
        if constexpr (!Epi::AFTER_DRAIN) { E(acc, cur, wr, wc, fr, fq); S.done(cur); }
        if (!has_next) break;
#pragma unroll
        for (int a = 0; a < 2; ++a)
#pragma unroll
            for (int b = 0; b < 2; ++b)
#pragma unroll
                for (int m = 0; m < 4; ++m)
#pragma unroll
                    for (int n = 0; n < 2; ++n) acc[a][b][m][n] = (f32x4){0.f, 0.f, 0.f, 0.f};
        cur = nxt; cA = nA; cB = nB; ++ui;
        if constexpr (ALIGN_EPI) { if (wr == 1) PG8_BAR; }
    }
    PG8_WAIT_V(0);
    if constexpr (!ALIGN_EPI) { if (wr == 0) PG8_BAR; }
    PG8_BAR;
    if constexpr (Epi::AFTER_DRAIN) { E.fused(acc, cur, wr, wc, fr, fq, lds, wid, lane); S.done(cur); }
#undef PG8_SA
#undef PG8_SB
#undef PG8_STAGE
#undef PG8_LDA
#undef PG8_LDB
#undef PG8_MMA
#undef PG8_WAIT_V
#undef PG8_WAIT_L
#undef PG8_BAR
#undef PG8_SCHED
}
}

#ifndef PG8_SP2
#define PG8_SP2 true
#endif
#ifndef PG8_ALIGN
#define PG8_ALIGN true
#endif
#include <hip/hip_bf16.h>
#include <cmath>
namespace attn_body {
using bf16=__hip_bfloat16;
using bf16x8=__attribute__((ext_vector_type(8)))short;
using s16x4=__attribute__((ext_vector_type(4)))short;
using f32x16=__attribute__((ext_vector_type(16)))float;
using u32x4=__attribute__((ext_vector_type(4)))unsigned;
constexpr int D=64,PQ=2304,PO=1024,WIN=128;
constexpr int NW=8,QBLK=32,QB=QBLK*NW,KVBLK=64;
constexpr int ATTN_UNIT_ROWS=QB;
__device__ __forceinline__ int crow(int r,int hi){return (r&3)+8*(r>>2)+4*hi;}
#define SBAR() __builtin_amdgcn_sched_barrier(0)
template<int MODE> __device__ __forceinline__ void cmask(f32x16&p0,f32x16&p1,int jb,int qrel,int hi){
  const float NEG=-INFINITY; int kb=64*jb+4*hi;
  #pragma unroll
  for(int r=0;r<16;++r){int kv=kb+(r&3)+8*(r>>2);
    if(kv>qrel||(MODE==1&&kv+WIN<=qrel))p0[r]=NEG; if(kv+32>qrel||(MODE==1&&kv+32+WIN<=qrel))p1[r]=NEG;}
}

constexpr int NSLOT=3, SLOTB=8192;
constexpr int LDS_K=0, LDS_V=NSLOT*SLOTB, LDS_WS=2*NSLOT*SLOTB, LDS_OST=LDS_WS+NW*64*4, LDS_BYTES=LDS_OST+NW*4096;
constexpr float C2=0.125f*1.4426950408889634f;
__device__ __forceinline__ void glds16(const void*gsrc,unsigned lds_dst){unsigned keep;
  asm volatile("s_mov_b32 %0, m0\n\ts_mov_b32 m0, %2\n\ts_nop 0\n\tglobal_load_lds_dwordx4 %1, off\n\ts_mov_b32 m0, %0":"=&s"(keep):"v"(gsrc),"s"(lds_dst):"memory");}
__device__ __forceinline__ float max3f(float a,float b,float c){float r;asm("v_max3_f32 %0, %1, %2, %3":"=v"(r):"v"(a),"v"(b),"v"(c));return r;}
__device__ __forceinline__ float max2f(float a,float b){float r;asm("v_max_f32_e32 %0, %1, %2":"=v"(r):"v"(a),"v"(b));return r;}
__device__ __forceinline__ float fadd_s(float a,float b){float r;asm("v_add_f32_e32 %0, %1, %2":"=v"(r):"v"(a),"v"(b));return r;}
__device__ __forceinline__ float fsub_s(float a,float b){float r;asm("v_sub_f32_e32 %0, %1, %2":"=v"(r):"v"(a),"v"(b));return r;}
typedef float f32x2_t __attribute__((ext_vector_type(2))); typedef __bf16 bf16x2_t __attribute__((ext_vector_type(2)));
__device__ __forceinline__ unsigned cvtpk_s(float lo,float hi){f32x2_t v={lo,hi};bf16x2_t b=__builtin_convertvector(v,bf16x2_t);return __builtin_bit_cast(unsigned,b);}
#define WAIT_BAR(N) asm volatile("s_waitcnt vmcnt(" #N ") lgkmcnt(0)\n\ts_barrier":::"memory")

__device__ __forceinline__ void qkt(f32x16&p0,f32x16&p1,const char*Kslot,const bf16x8*qr,const f32x16&negm,int r32,int hi){
  const char*kb=Kslot+hi*1024+r32*16;
  #pragma unroll
  for(int d0=0;d0<4;++d0){
    const bf16x8 b0=*reinterpret_cast<const bf16x8*>(kb+d0*2048);
    const bf16x8 b1=*reinterpret_cast<const bf16x8*>(kb+d0*2048+512);
    if(d0==0){p0=__builtin_amdgcn_mfma_f32_32x32x16_bf16(b0,qr[0],negm,0,0,0);p1=__builtin_amdgcn_mfma_f32_32x32x16_bf16(b1,qr[0],negm,0,0,0);}
    else{p0=__builtin_amdgcn_mfma_f32_32x32x16_bf16(b0,qr[d0],p0,0,0,0);p1=__builtin_amdgcn_mfma_f32_32x32x16_bf16(b1,qr[d0],p1,0,0,0);}}
}
typedef __attribute__((address_space(3))) const char* lds_cptr;
typedef short v4i16_t __attribute__((ext_vector_type(4)));
__device__ __forceinline__ void kload8(bf16x8*kf,lds_cptr kp){
  kf[0]=*(const __attribute__((address_space(3))) bf16x8*)(kp);      kf[1]=*(const __attribute__((address_space(3))) bf16x8*)(kp+512);
  kf[2]=*(const __attribute__((address_space(3))) bf16x8*)(kp+2048); kf[3]=*(const __attribute__((address_space(3))) bf16x8*)(kp+2560);
  kf[4]=*(const __attribute__((address_space(3))) bf16x8*)(kp+4096); kf[5]=*(const __attribute__((address_space(3))) bf16x8*)(kp+4608);
  kf[6]=*(const __attribute__((address_space(3))) bf16x8*)(kp+6144); kf[7]=*(const __attribute__((address_space(3))) bf16x8*)(kp+6656);
}
__device__ __forceinline__ void kload2(bf16x8*kf,lds_cptr kp,int j){ kf[2*j]=*(const __attribute__((address_space(3))) bf16x8*)(kp+j*2048); kf[2*j+1]=*(const __attribute__((address_space(3))) bf16x8*)(kp+j*2048+512); }
__device__ __forceinline__ s16x4 vtr(lds_cptr p){ return __builtin_bit_cast(s16x4,__builtin_amdgcn_ds_read_tr16_b64_v4i16((__attribute__((address_space(3))) v4i16_t*)p)); }
__device__ __forceinline__ float rowmax(const f32x16&p0,const f32x16&p1){
  float a=max3f(p0[0],p0[1],p1[0]),b=max3f(p0[2],p0[3],p1[1]);a=max3f(a,p1[2],p1[3]);
  #pragma unroll
  for(int r=4;r<16;r+=4){a=max3f(a,p0[r],p0[r+1]);b=max3f(b,p0[r+2],p0[r+3]);a=max3f(a,p1[r],p1[r+1]);b=max3f(b,p1[r+2],p1[r+3]);}
  const float m=max2f(a,b);
  auto rr=__builtin_amdgcn_permlane32_swap(__float_as_uint(m),__float_as_uint(m),false,false);
  return max2f(__uint_as_float(rr[0]),__uint_as_float(rr[1]));
}
__device__ __forceinline__ void pv(f32x16*o,int vb,bf16x8 pa0,bf16x8 pa1,bf16x8 pa2,bf16x8 pa3){
  #pragma unroll
  for(int d0=0;d0<2;++d0){s16x4 lo[4],hi[4];
    #pragma unroll
    for(int ks=0;ks<4;++ks){
      asm volatile("ds_read_b64_tr_b16 %0,%1 offset:%c2":"=&v"(lo[ks]):"v"(vb),"i"(d0*4096+ks*1024):"memory");
      asm volatile("ds_read_b64_tr_b16 %0,%1 offset:%c2":"=&v"(hi[ks]):"v"(vb),"i"(d0*4096+ks*1024+512):"memory");}
    asm volatile("s_waitcnt lgkmcnt(0)":::"memory");SBAR();
    #define PK(k) (bf16x8){lo[k][0],lo[k][1],lo[k][2],lo[k][3],hi[k][0],hi[k][1],hi[k][2],hi[k][3]}
    o[d0]=__builtin_amdgcn_mfma_f32_32x32x16_bf16(pa0,PK(0),o[d0],0,0,0);
    o[d0]=__builtin_amdgcn_mfma_f32_32x32x16_bf16(pa1,PK(1),o[d0],0,0,0);
    o[d0]=__builtin_amdgcn_mfma_f32_32x32x16_bf16(pa2,PK(2),o[d0],0,0,0);
    o[d0]=__builtin_amdgcn_mfma_f32_32x32x16_bf16(pa3,PK(3),o[d0],0,0,0);
    #undef PK
  }
}

#ifndef ATTN_STORE16
#define ATTN_STORE16(p,v) (*(u32x4*)(p)=(v))
#endif
template<int MODE,int THRL> __device__ __forceinline__ void attn_unit(const bf16*Qh,const bf16*__restrict__ Kh,const bf16*__restrict__ Vh,bf16*Oh,int q0,int kt0,const int NT,float sink2,char*shm){
  int tid_=threadIdx.x; asm volatile("":"+v"(tid_)); const int tid=tid_,lane=tid&63,r32=lane&31,hi=lane>>5; const int wid=__builtin_amdgcn_readfirstlane(tid>>6);
  const bf16*Qw=Qh+(long)(q0+wid*QBLK)*PQ;
  const unsigned lds0=(unsigned)(uintptr_t)shm;
  float*wsf=(float*)(shm+LDS_WS)+wid*64;
  const bf16*ksrc=Kh+(long)(kt0*KVBLK+lane)*PQ+wid*8;
  const bf16*vsrc=Vh+(long)(kt0*KVBLK+16*(wid&3)+(lane>>2))*PQ+(wid>>2)*32+(lane&3)*8;
  const unsigned kdst=lds0+LDS_K+wid*1024, vdst=lds0+LDS_V+wid*1024;
  #define DMA_K(t,slot) glds16(ksrc+(long)(t)*KVBLK*PQ,(unsigned)__builtin_amdgcn_readfirstlane(kdst+(slot)))
  #define DMA_V(t,slot) glds16(vsrc+(long)(t)*KVBLK*PQ,(unsigned)__builtin_amdgcn_readfirstlane(vdst+(slot)))
  const int vb0=(int)(lds0+LDS_V)+((lane>>4)&1)*32+(lane&3)*8+(4*hi+((lane&15)>>2))*64;
  const char*Kbase=shm+LDS_K; bf16x8 kf[8];
  const lds_cptr shm3=(lds_cptr)shm; const lds_cptr kp0=shm3+LDS_K+hi*1024+r32*16; const lds_cptr vp0=shm3+LDS_V+((lane>>4)&1)*32+(lane&3)*8+(4*hi+((lane&15)>>2))*64;
  DMA_K(0,0);DMA_V(0,0);DMA_K(1,SLOTB);
  bf16x8 qr[4];
  #pragma unroll
  for(int d0=0;d0<4;++d0)qr[d0]=*reinterpret_cast<const bf16x8*>(&Qw[(long)r32*PQ+d0*16+hi*8]);
  float mhat=0.f,l_reg=0.f;f32x16 o[2];o[0]=f32x16{};o[1]=f32x16{};f32x16 negm=f32x16{};asm volatile("":"+v"(negm));
  const int qrel=wid*QBLK+r32;
  #define CMASK(P0,P1,t) do{int jb_=(t)-(NT-4); if(MODE==1||jb_>=0)cmask<MODE>(P0,P1,jb_,qrel,hi);}while(0)
  bool resc=false;
  #define START(P0,P1) do{ const float rm=rowmax(P0,P1); resc=false; \
    { const float dl=(MODE==1)?__builtin_fmaxf(rm,-60.f):rm; mhat=fadd_s(mhat,dl); \
      _Pragma("unroll") for(int r=0;r<16;++r){P0[r]=fsub_s(P0[r],dl);P1[r]=fsub_s(P1[r],dl);} \
      _Pragma("unroll") for(int r=0;r<16;++r)negm[r]=-mhat; asm volatile("":"+v"(negm)); } \
    _Pragma("unroll") for(int r=0;r<16;++r)P0[r]=__builtin_amdgcn_exp2f(P0[r]); }while(0)
  #define RESC() do{ if(resc){ asm volatile("s_waitcnt lgkmcnt(0)":::"memory"); \
      _Pragma("unroll") for(int d_=0;d_<2;++d_) _Pragma("unroll") for(int r=0;r<16;++r)o[d_][r]*=wsf[crow(r,hi)]; } }while(0)
  f32x16 pA0,pA1,pB0,pB1;
  int sl_prev=0,sl_cur=0,sl_next=SLOTB;
  #define ROT() do{sl_prev=sl_cur;sl_cur=sl_next;sl_next=(sl_next==(NSLOT-1)*SLOTB)?0:sl_next+SLOTB;}while(0)
  DMA_K(2,2*SLOTB);
  WAIT_BAR(3);
  qkt(pA0,pA1,Kbase,qr,negm,r32,hi);asm volatile("s_nop 15\n\ts_nop 7":"+v"(pA0),"+v"(pA1));CMASK(pA0,pA1,0);
  START(pA0,pA1);
  _Pragma("unroll") for(int r=0;r<16;++r)pA1[r]=__builtin_amdgcn_exp2f(pA1[r]);
  WAIT_BAR(0);
  DMA_K(3,0);DMA_V(1,SLOTB);
  ROT();
  kload8(kf,kp0+sl_cur);
  WAIT_BAR(2);
  s16x4 vlo[8],vhi[8]; u32x4 pw0,pw1,pw2,pw3;
  #define PKW(P,B) cvtpk_s(P[B],P[B+1])
  #define PAF(k) __builtin_bit_cast(bf16x8,pw##k)
  #define VFR(i) (bf16x8){vlo[i][0],vlo[i][1],vlo[i][2],vlo[i][3],vhi[i][0],vhi[i][1],vhi[i][2],vhi[i][3]}
  #define PIN(x) asm volatile("":"+v"(x))
  #define MX3(a,b,c) __builtin_fmaxf(__builtin_fmaxf((a),(b)),(c))
  #define GAPA(MF,A0,A1,A2,A3,W0,W1,PW) do{ MF; sacc+=A0; sacc+=A1; sacc+=A2; sacc+=A3; PIN(sacc); W0; W1; PIN(PW); SBAR(); }while(0)
  #define EX(v) __builtin_amdgcn_exp2f(v)
  #define GAPB(MF,X,B) do{ MF; X[B]=EX(X[B]); X[B+1]=EX(X[B+1]); X[B+2]=EX(X[B+2]); X[B+3]=EX(X[B+3]); PIN(X); SBAR(); }while(0)
  #define VRD(i) do{ vlo[i]=vtr(vp_+(((i)>>2)*4096+((i)&3)*1024)); vhi[i]=vtr(vp_+(((i)>>2)*4096+((i)&3)*1024+512)); }while(0)
  #define KRD(G,j) do{ if(G){ kload2(kf,kp0+sl_next,j); SBAR(); } }while(0)
  #define STEP(C0,C1,P0,P1,t,GK,GV,GL) do{ SBAR(); \
    const lds_cptr vp_=vp0+sl_prev; \
    VRD(0); SBAR(); float sacc=(P0[0]+P0[1]); \
    GAPA(C0=__builtin_amdgcn_mfma_f32_32x32x16_bf16(kf[0],qr[0],negm,0,0,0), P0[2],P0[3],P0[4],P0[5],     pw0[0]=PKW(P0,0), pw0[1]=PKW(P0,2), pw0); \
    VRD(4); SBAR(); GAPA(C1=__builtin_amdgcn_mfma_f32_32x32x16_bf16(kf[1],qr[0],negm,0,0,0), P0[6],P0[7],P0[8],P0[9],     pw0[2]=PKW(P0,4), pw0[3]=PKW(P0,6), pw0); \
    VRD(1); SBAR(); GAPA(C0=__builtin_amdgcn_mfma_f32_32x32x16_bf16(kf[2],qr[1],C0,0,0,0),   P0[10],P0[11],P0[12],P0[13], pw1[0]=PKW(P0,8), pw1[1]=PKW(P0,10), pw1); \
    VRD(5); SBAR(); GAPA(C1=__builtin_amdgcn_mfma_f32_32x32x16_bf16(kf[3],qr[1],C1,0,0,0),   P0[14],P0[15],P1[0],P1[1],   pw1[2]=PKW(P0,12),pw1[3]=PKW(P0,14), pw1); \
    VRD(2); SBAR(); GAPA(C0=__builtin_amdgcn_mfma_f32_32x32x16_bf16(kf[4],qr[2],C0,0,0,0),   P1[2],P1[3],P1[4],P1[5],     pw2[0]=PKW(P1,0), pw2[1]=PKW(P1,2), pw2); \
    VRD(6); SBAR(); GAPA(C1=__builtin_amdgcn_mfma_f32_32x32x16_bf16(kf[5],qr[2],C1,0,0,0),   P1[6],P1[7],P1[8],P1[9],     pw2[2]=PKW(P1,4), pw2[3]=PKW(P1,6), pw2); \
    VRD(3); SBAR(); GAPA(C0=__builtin_amdgcn_mfma_f32_32x32x16_bf16(kf[6],qr[3],C0,0,0,0),   P1[10],P1[11],P1[12],P1[13], pw3[0]=PKW(P1,8), pw3[1]=PKW(P1,10), pw3); \
    VRD(7); SBAR(); GAPA(C1=__builtin_amdgcn_mfma_f32_32x32x16_bf16(kf[7],qr[3],C1,0,0,0),   P1[14],P1[15],0.f,0.f,       pw3[2]=PKW(P1,12),pw3[3]=PKW(P1,14), pw3); \
    l_reg+=sacc; \
    if(GK){DMA_K((t)+3,sl_cur);} if(GV){DMA_V((t)+1,sl_next);} \
    CMASK(C0,C1,t); \
    { float a=MX3(C0[0],C0[1],C1[0]),b=MX3(C0[2],C0[3],C1[1]); a=MX3(a,C1[2],C1[3]); \
      _Pragma("unroll") for(int r=4;r<16;r+=4){a=MX3(a,C0[r],C0[r+1]);b=MX3(b,C0[r+2],C0[r+3]);a=MX3(a,C1[r],C1[r+1]);b=MX3(b,C1[r+2],C1[r+3]);} \
      float rm=__builtin_fmaxf(a,b); { auto rr=__builtin_amdgcn_permlane32_swap(__float_as_uint(rm),__float_as_uint(rm),false,false); rm=__builtin_fmaxf(__uint_as_float(rr[0]),__uint_as_float(rr[1])); } \
      resc=false; \
      if(__builtin_expect(__any(rm>(float)THRL),0)){ const float dl=__builtin_fmaxf(rm,0.f); mhat+=dl; \
        _Pragma("unroll") for(int r=0;r<16;++r){C0[r]-=dl;C1[r]-=dl;} \
        _Pragma("unroll") for(int r=0;r<16;++r)negm[r]=-mhat; asm volatile("":"+v"(negm)); \
        const float f=__builtin_amdgcn_exp2f(-dl); l_reg*=f; if(hi==0)wsf[r32]=f; resc=true; } } \
    SBAR(); \
    GAPB(o[0]=__builtin_amdgcn_mfma_f32_32x32x16_bf16(PAF(0),VFR(0),o[0],0,0,0), C0,0); \
    GAPB(o[1]=__builtin_amdgcn_mfma_f32_32x32x16_bf16(PAF(0),VFR(4),o[1],0,0,0), C0,4); \
    KRD(GL,0); GAPB(o[0]=__builtin_amdgcn_mfma_f32_32x32x16_bf16(PAF(1),VFR(1),o[0],0,0,0), C0,8); \
    KRD(GL,1); GAPB(o[1]=__builtin_amdgcn_mfma_f32_32x32x16_bf16(PAF(1),VFR(5),o[1],0,0,0), C0,12); \
    KRD(GL,2); GAPB(o[0]=__builtin_amdgcn_mfma_f32_32x32x16_bf16(PAF(2),VFR(2),o[0],0,0,0), C1,0); \
    KRD(GL,3); GAPB(o[1]=__builtin_amdgcn_mfma_f32_32x32x16_bf16(PAF(2),VFR(6),o[1],0,0,0), C1,4); \
    GAPB(o[0]=__builtin_amdgcn_mfma_f32_32x32x16_bf16(PAF(3),VFR(3),o[0],0,0,0), C1,8); \
    GAPB(o[1]=__builtin_amdgcn_mfma_f32_32x32x16_bf16(PAF(3),VFR(7),o[1],0,0,0), C1,12); \
    }while(0)
  int t=1;
  #undef CMASK
  #define CMASK(P0,P1,t) do{}while(0)
  for(;t+5<NT;t+=2){
    STEP(pB0,pB1,pA0,pA1,t,true,true,true);     WAIT_BAR(2); RESC(); ROT();
    STEP(pA0,pA1,pB0,pB1,t+1,true,true,true);   WAIT_BAR(2); RESC(); ROT();
  }
  #undef CMASK
  #define CMASK(P0,P1,t) do{int jb_=(t)-(NT-4); if(MODE==1||jb_>=0)cmask<MODE>(P0,P1,jb_,qrel,hi);}while(0)
  #define ENDW(tt) do{ if((tt)+3<NT){WAIT_BAR(2);} else if((tt)+2<NT){WAIT_BAR(1);} else {WAIT_BAR(0);} }while(0)
  for(;t+1<NT;t+=2){
    STEP(pB0,pB1,pA0,pA1,t,(t+3<NT),(t+1<NT),(t+1<NT));       ENDW(t);   RESC(); ROT();
    STEP(pA0,pA1,pB0,pB1,t+1,(t+4<NT),(t+2<NT),(t+2<NT));     ENDW(t+1); RESC(); ROT();
  }
  STEP(pB0,pB1,pA0,pA1,NT-1,false,false,false); RESC();
  { float sacc=pB0[0]+pB0[1]; _Pragma("unroll") for(int r=2;r<16;++r)sacc+=pB0[r]; _Pragma("unroll") for(int r=0;r<16;++r)sacc+=pB1[r]; l_reg+=sacc;
    pw0=(u32x4){PKW(pB0,0),PKW(pB0,2),PKW(pB0,4),PKW(pB0,6)};pw1=(u32x4){PKW(pB0,8),PKW(pB0,10),PKW(pB0,12),PKW(pB0,14)};pw2=(u32x4){PKW(pB1,0),PKW(pB1,2),PKW(pB1,4),PKW(pB1,6)};pw3=(u32x4){PKW(pB1,8),PKW(pB1,10),PKW(pB1,12),PKW(pB1,14)};
    SBAR(); pv(o,vb0+sl_cur,PAF(0),PAF(1),PAF(2),PAF(3)); }
  #undef PKW
  #undef PAF
  #undef VFR
  #undef PIN
  #undef MX3
  #undef GAPA
  #undef GAPB
  #undef EX
  #undef VRD
  #undef KRD
  #undef STEP
  #undef ENDW
  {auto rr=__builtin_amdgcn_permlane32_swap(__float_as_uint(l_reg),__float_as_uint(l_reg),false,false);l_reg=__uint_as_float(rr[0])+__uint_as_float(rr[1]);}
  if(MODE==1)l_reg+=__builtin_amdgcn_exp2f(sink2-mhat);
  if(hi==0)wsf[32+r32]=l_reg;asm volatile("s_waitcnt lgkmcnt(0)":::"memory");
  float rli[16];
  #pragma unroll
  for(int r=0;r<16;++r)rli[r]=__builtin_amdgcn_rcpf(wsf[32+crow(r,hi)]);
  bf16*Ow=Oh+(long)(q0+wid*QBLK)*PO;
  { bf16*stg=(bf16*)(shm+LDS_OST)+wid*2048;
    #pragma unroll
    for(int r=0;r<16;++r){const int orow=crow(r,hi);
      #pragma unroll
      for(int d0=0;d0<2;++d0)stg[orow*64+d0*32+r32]=__float2bfloat16(o[d0][r]*rli[r]);}
    asm volatile("s_waitcnt lgkmcnt(0)":::"memory");
    #pragma unroll
    for(int i=0;i<4;++i){const int row=i*8+(lane>>3),ch=lane&7; const u32x4 v=*(const u32x4*)(stg+row*64+ch*8); ATTN_STORE16(Ow+(long)row*PO+ch*8,v);} }
  asm volatile("s_waitcnt lgkmcnt(0)\n\ts_barrier":::"memory");
  #undef DMA_K
  #undef DMA_V
  #undef CMASK
  #undef START
  #undef RESC
  #undef ROT
}
constexpr int ATTN_LDS_BYTES=LDS_BYTES;

constexpr int SW_K=0, SW_V=6*8192, SW_WS=12*8192, SW_ST=SW_WS+2048, SWA_LDS_BYTES=SW_ST+NW*2048;
__device__ __forceinline__ void swa_unit(const bf16*Qb,const bf16*__restrict__ Kh,const bf16*__restrict__ Vh,bf16*Ob,int q0,const float*sink2v,char*shm){
  int tid_=threadIdx.x; asm volatile("":"+v"(tid_)); const int tid=tid_,lane=tid&63,r32=lane&31,hi=lane>>5; const int wid=__builtin_amdgcn_readfirstlane(tid>>6);
  const unsigned lds0=(unsigned)(uintptr_t)shm;
  const int nt=(q0==0)?4:6, kt0=q0/KVBLK-(nt-4);
  const bf16*ksrc=Kh+(long)(kt0*KVBLK+lane)*PQ+wid*8;
  const bf16*vsrc=Vh+(long)(kt0*KVBLK+16*(wid&3)+(lane>>2))*PQ+(wid>>2)*32+(lane&3)*8;
  for(int ti=0;ti<nt;++ti){
    glds16(ksrc+(long)ti*KVBLK*PQ,(unsigned)__builtin_amdgcn_readfirstlane(lds0+SW_K+ti*8192+wid*1024));
    glds16(vsrc+(long)ti*KVBLK*PQ,(unsigned)__builtin_amdgcn_readfirstlane(lds0+SW_V+ti*8192+wid*1024)); }
  asm volatile("s_waitcnt vmcnt(0) lgkmcnt(0)\n\ts_barrier":::"memory");
  float*wsf=(float*)(shm+SW_WS)+wid*64;
  const int qrel=wid*QBLK+r32, jlo=(wid>>1)-2;
  const int vbase=(int)(lds0+SW_V)+((lane>>4)&1)*32+(lane&3)*8+(4*hi+((lane&15)>>2))*64;
  for(int g=0;g<4;++g){
    const bf16*Qw=Qb+(long)(q0+wid*QBLK)*PQ+g*D;
    bf16x8 qr[4];
    #pragma unroll
    for(int d0=0;d0<4;++d0)qr[d0]=*reinterpret_cast<const bf16x8*>(&Qw[(long)r32*PQ+d0*16+hi*8]);
    float m=-INFINITY,l=0.f; f32x16 o[2]; o[0]=f32x16{}; o[1]=f32x16{};
    for(int jj=0;jj<3;++jj){ const int jb=jlo+jj, ti=jb+(nt-4); if(ti<0)continue;
      f32x16 p0,p1; const f32x16 z=f32x16{};
      qkt(p0,p1,shm+SW_K+ti*8192,qr,z,r32,hi);
      cmask<1>(p0,p1,jb,qrel,hi);
      const float rm=rowmax(p0,p1); const float mn=__builtin_fmaxf(__builtin_fmaxf(m,rm),-60.f); const float al=__builtin_amdgcn_exp2f(m-mn); m=mn;
      float s=0.f;
      #pragma unroll
      for(int r=0;r<16;++r){p0[r]=__builtin_amdgcn_exp2f(p0[r]-mn);p1[r]=__builtin_amdgcn_exp2f(p1[r]-mn);s+=p0[r]+p1[r];}
      l=l*al+s;
      if(hi==0)wsf[r32]=al; asm volatile("s_waitcnt lgkmcnt(0)":::"memory");
      #pragma unroll
      for(int d_=0;d_<2;++d_)
        #pragma unroll
        for(int r=0;r<16;++r)o[d_][r]*=wsf[crow(r,hi)];
      const u32x4 pw0=(u32x4){cvtpk_s(p0[0],p0[1]),cvtpk_s(p0[2],p0[3]),cvtpk_s(p0[4],p0[5]),cvtpk_s(p0[6],p0[7])};
      const u32x4 pw1=(u32x4){cvtpk_s(p0[8],p0[9]),cvtpk_s(p0[10],p0[11]),cvtpk_s(p0[12],p0[13]),cvtpk_s(p0[14],p0[15])};
      const u32x4 pw2=(u32x4){cvtpk_s(p1[0],p1[1]),cvtpk_s(p1[2],p1[3]),cvtpk_s(p1[4],p1[5]),cvtpk_s(p1[6],p1[7])};
      const u32x4 pw3=(u32x4){cvtpk_s(p1[8],p1[9]),cvtpk_s(p1[10],p1[11]),cvtpk_s(p1[12],p1[13]),cvtpk_s(p1[14],p1[15])};
      asm volatile("s_waitcnt lgkmcnt(0)":::"memory");
      pv(o,vbase+ti*8192,__builtin_bit_cast(bf16x8,pw0),__builtin_bit_cast(bf16x8,pw1),__builtin_bit_cast(bf16x8,pw2),__builtin_bit_cast(bf16x8,pw3));
    }
    {auto rr=__builtin_amdgcn_permlane32_swap(__float_as_uint(l),__float_as_uint(l),false,false);l=__uint_as_float(rr[0])+__uint_as_float(rr[1]);}
    l+=__builtin_amdgcn_exp2f(sink2v[g]-m);
    if(hi==0)wsf[32+r32]=l; asm volatile("s_waitcnt lgkmcnt(0)":::"memory");
    float rli[16];
    #pragma unroll
    for(int r=0;r<16;++r)rli[r]=__builtin_amdgcn_rcpf(wsf[32+crow(r,hi)]);
    bf16*Ow=Ob+(long)(q0+wid*QBLK)*PO+g*D;
    bf16*stg=(bf16*)(shm+SW_ST)+wid*1024;
    #pragma unroll
    for(int d0=0;d0<2;++d0){
      #pragma unroll
      for(int r=0;r<16;++r)stg[crow(r,hi)*32+r32]=__float2bfloat16(o[d0][r]*rli[r]);
      asm volatile("s_waitcnt lgkmcnt(0)":::"memory");
      #pragma unroll
      for(int i=0;i<2;++i){const int row=i*16+(lane>>2),ch=lane&3; const u32x4 v=*(const u32x4*)(stg+row*32+ch*8); ATTN_STORE16(Ow+(long)row*PO+d0*32+ch*8,v);}
      asm volatile("s_waitcnt lgkmcnt(0)":::"memory");
    }
  }
  asm volatile("s_waitcnt lgkmcnt(0)\n\ts_barrier":::"memory");
}
#undef SBAR
#undef WAIT_BAR
}
constexpr int NWAVES = 8;
constexpr int BATCH = 2, SEQ = 16384, D = 1024, T = BATCH * SEQ;
constexpr int IN_COLS = 2304, NEXP = 32, FF = 512, NASSIGN = 2 * T, NCHUNK = 256, CHUNK_TOK = T / NCHUNK;
constexpr int PSLOTS = (NASSIGN / 256 + NEXP) * 256;
constexpr int NBLK_MAX = PSLOTS / 256;
constexpr float RMS_EPS = 1e-6f;
static_assert(CHUNK_TOK == 128 && SEQ == pg8::SEQ_LEN && IN_COLS == pg8::QKV_LD, "shapes");
constexpr size_t MiB = 1u << 20;
constexpr size_t WS_CTL = 0, CTL_ZERO_BYTES = 1 * MiB;
constexpr size_t WS_WR = 1 * MiB;
constexpr size_t WS_TOK = WS_WR + 256 * 1024;
constexpr size_t WS_ROPE = 4 * MiB;
constexpr size_t WS_WIN = 8 * MiB;
constexpr size_t WS_WO = 13 * MiB;
constexpr size_t WS_WGU = 16 * MiB;
constexpr size_t WS_WD = 80 * MiB;
constexpr size_t WS_A = 112 * MiB;
constexpr size_t WS_MIX = 176 * MiB;
constexpr size_t WS_QKV = 240 * MiB;
constexpr size_t WS_HM = 384 * MiB;
constexpr size_t WS_END = 456 * MiB;
static_assert(WS_TOK + (size_t)(T * 2 * 4) * 2 + T * 4 + NCHUNK * 32 * 4 + 288 * 4 + (size_t)PSLOTS * 12 <= WS_ROPE, "routing tables");
static_assert(WS_WIN + (size_t)IN_COLS * D * 2 <= WS_WO && WS_WO + (size_t)D * D * 2 <= WS_WGU && WS_WGU + (size_t)NEXP * 1024 * D * 2 <= WS_WD && WS_WD + (size_t)NEXP * D * FF * 2 <= WS_A, "weights");
static_assert(WS_A + (size_t)T * D * 2 <= WS_MIX && WS_MIX + (size_t)T * D * 2 <= WS_QKV && WS_QKV + (size_t)T * IN_COLS * 2 <= WS_HM && WS_QKV + (size_t)PSLOTS * D * 2 <= WS_HM && WS_HM + (size_t)PSLOTS * FF * 2 <= WS_END, "activations");
static_assert(WS_A + (size_t)NASSIGN * D * 2 <= WS_QKV, "Y overlays A + MIX");
constexpr int CW_NBU = 64;
constexpr int CW_BAR = 4096;
constexpr int RING_OFF = 0, RING_BYTES = 131072;
constexpr int LDSCTL_OFF = RING_BYTES, MISC_OFF = LDSCTL_OFF + 320;
constexpr int LDS_BYTES = 147456;
static_assert(MISC_OFF + 128 <= LDS_BYTES, "LDS map");
#define GAS __attribute__((address_space(1)))
#define LAS __attribute__((address_space(3)))
typedef unsigned short bf16;
typedef unsigned v4u __attribute__((ext_vector_type(4)));
typedef float f32x4 __attribute__((ext_vector_type(4)));
typedef short bf16x8 __attribute__((ext_vector_type(8)));
typedef GAS unsigned gu32;
typedef GAS unsigned long long gu64;
#define RLX_AGENT __ATOMIC_RELAXED, __HIP_MEMORY_SCOPE_AGENT
#define LDS_WAIT() asm volatile("s_waitcnt lgkmcnt(0)" ::: "memory")
#define VM_WAIT() asm volatile("s_waitcnt vmcnt(0)" ::: "memory")
__device__ __forceinline__ unsigned long long rt() { return __builtin_amdgcn_s_memrealtime(); }
__device__ __forceinline__ unsigned f2bf(float f) { unsigned u = __builtin_bit_cast(unsigned, f); return (u + 0x7fffu + ((u >> 16) & 1u)) >> 16; }
__device__ __forceinline__ unsigned pk2(float lo, float hi) { return f2bf(lo) | (f2bf(hi) << 16); }

#define XB_TMO      128
#define XB_XCNT(j)  (256  + 64 * (j))
#define XB_XSUB(j)  (1280 + 64 * (j))
#define XB_XGEN(j)  (2304 + 64 * (j))
#define XB_TOP      3328
#define XB_TOPGEN   3392
#define XCD_BAR_WORDS 3456
#define XB_SPIN_CAP (1u << 18)

__device__ __forceinline__ unsigned xb_ld(unsigned* p)              { return __hip_atomic_load(p, __ATOMIC_RELAXED, __HIP_MEMORY_SCOPE_AGENT); }
__device__ __forceinline__ unsigned xb_add(unsigned* p, unsigned v) { return __hip_atomic_fetch_add(p, v, __ATOMIC_RELAXED, __HIP_MEMORY_SCOPE_AGENT); }
__device__ __forceinline__ unsigned xb_xcc_id() { return (unsigned)__builtin_amdgcn_s_getreg((3 << 11) | 20) & 0xFu; }
#define XB_SPIN(cond, bar) do { unsigned _sp = 0; while (cond) { __builtin_amdgcn_s_sleep(1); \
    if ((++_sp & 255u) == 0u) { if (xb_ld(&(bar)[XB_TMO])) break; if (_sp > XB_SPIN_CAP) { atomicAdd(&(bar)[XB_TMO], 1u); break; } } } } while (0)

struct XcdBarrier {
    unsigned* bar; unsigned x;
    volatile LAS unsigned* st;
};

__device__ __forceinline__ XcdBarrier xcd_barrier_post(unsigned* bar, volatile LAS unsigned* st) {
    XcdBarrier b; b.bar = bar; b.x = xb_xcc_id(); b.st = st;
    if (threadIdx.x == 0) (void)xb_add(&bar[XB_XCNT(b.x)], 1u);
    return b;
}
__device__ __forceinline__ void xcd_barrier_complete(unsigned* bar, unsigned x, unsigned& nloc, unsigned& nx) {
    const unsigned G = gridDim.x * gridDim.y * gridDim.z;
    unsigned sum, cnt, mine, sp = 0u;
    for (;;) {
        sum = 0u; cnt = 0u; mine = 0u;
#pragma unroll
        for (unsigned j = 0; j < 16; ++j) { const unsigned c = xb_ld(&bar[XB_XCNT(j)]); sum += c; cnt += (c > 0u) ? 1u : 0u; mine = (j == x) ? c : mine; }
        if (sum == G) break;
        __builtin_amdgcn_s_sleep(1);
        if ((++sp & 255u) == 0u) { if (xb_ld(&bar[XB_TMO])) break; if (sp > XB_SPIN_CAP) { atomicAdd(&bar[XB_TMO], 1u); break; } }
    }
    nloc = mine > 0u ? mine : 1u; nx = cnt > 0u ? cnt : 1u;
}

__device__ __forceinline__ void xcd_barrier(const XcdBarrier& b) {
    asm volatile("s_waitcnt vmcnt(0)" ::: "memory");
    __syncthreads();
    if (threadIdx.x == 0) {
        unsigned* bar = b.bar;
        __builtin_amdgcn_s_waitcnt(0);
        unsigned nloc = b.st[0], nx = b.st[1];
        if (nloc == 0u) { xcd_barrier_complete(bar, b.x, nloc, nx); b.st[0] = nloc; b.st[1] = nx; }
        const unsigned old = xb_add(&bar[XB_XSUB(b.x)], 1u);
        const unsigned gen = old / nloc;
        if (old + 1u == (gen + 1u) * nloc) {
            __builtin_amdgcn_fence(__ATOMIC_RELEASE, "agent");
            asm volatile("s_waitcnt vmcnt(0)" ::: "memory");
            const unsigned og = xb_add(&bar[XB_TOP], 1u);
            const unsigned tg = og / nx;
            if (og + 1u == (tg + 1u) * nx) xb_add(&bar[XB_TOPGEN], 1u);
            else XB_SPIN(xb_ld(&bar[XB_TOPGEN]) == tg, bar);
            __builtin_amdgcn_fence(__ATOMIC_ACQUIRE, "agent");
            xb_add(&bar[XB_XGEN(b.x)], 1u);
            asm volatile("s_waitcnt vmcnt(0)" ::: "memory");
        } else {
            XB_SPIN(xb_ld(&bar[XB_XGEN(b.x)]) == gen, bar);
            __builtin_amdgcn_fence(__ATOMIC_ACQUIRE, "agent");
            asm volatile("s_waitcnt vmcnt(0)" ::: "memory");
        }
    }
    __syncthreads();
}
struct Frame {
    LAS unsigned char* lds;
    volatile LAS unsigned* MISC;
    gu32* ctl;
    int tid, lane, wave;
    int vcu, G;
    const float* x; float* out;
    const float *g1, *w_in, *lq1, *lk1, *lq2, *lk2, *subg, *sinks, *w_out, *g2, *w_rg, *b_rg, *w_re, *b_re, *w_gate, *w_up, *w_down, *gf;
    bf16 *Win_t, *Wo_t, *Wgu_t, *Wd_t;
    bf16 *XN, *OD, *HB, *Y, *MIX, *QKV, *XS, *HM;
    float *Wr, *rope;
    int* tok_e; float* tok_g; float* tok_rstd; int* cnt; unsigned* blk_e; int* slot_dst; float* slot_gate; float* slot_rstd;
};
__device__ __forceinline__ float wave_sum(float v) {
#pragma unroll
    for (int o = 1; o < 64; o <<= 1) v += __shfl_xor(v, o);
    return v;
}
__device__ __forceinline__ void tr_item(const float* W, int ldn, int k0, int sc, const float* ksc, bf16* WT, int Kd, int drow0, LAS float* scr, int lane) {
#pragma unroll 8
    for (int i = 0; i < 32; ++i) { const int kk = 2 * i + (lane >> 5); float v = W[(size_t)(k0 + kk) * ldn + sc]; if (ksc) v *= ksc[k0 + kk]; scr[kk * 33 + (lane & 31)] = v; }
    LDS_WAIT(); asm volatile("" ::: "memory");
    const int c = lane & 7;
#pragma unroll
    for (int j = 0; j < 4; ++j) { const int n = (lane >> 3) + 8 * j; const LAS float* s = scr + (8 * c) * 33 + n;
        v4u o; o.x = pk2(s[0 * 33], s[1 * 33]); o.y = pk2(s[2 * 33], s[3 * 33]); o.z = pk2(s[4 * 33], s[5 * 33]); o.w = pk2(s[6 * 33], s[7 * 33]);
        *(GAS v4u*)(WT + (size_t)(drow0 + n) * Kd + k0 + 8 * c) = o; }
    LDS_WAIT(); asm volatile("" ::: "memory");
}
__device__ __forceinline__ int win_src_col(int n) {
    const bool isrope = (n < 1024) || (n >= 1536 && n < 2176);
    if (!isrope) return n;
    const int j = n & 63; return (n & ~63) + (j >> 1) + 32 * (j & 1);
}
__device__ __forceinline__ void p0_prologue(Frame& F) {
    LAS float* scr = (LAS float*)(F.lds + RING_OFF + F.wave * 16384);
    int lane_ = F.lane; asm volatile("" : "+v"(lane_)); const int gw = F.vcu * NWAVES + F.wave, NGW = F.G * NWAVES, lane = lane_;
    constexpr int I_IN = (IN_COLS / 32) * (D / 64), I_O = (D / 32) * (D / 64), I_GU = NEXP * (1024 / 32) * (D / 64), I_D = NEXP * (D / 32) * (FF / 64);
    constexpr int NITEMS = I_IN + I_O + I_GU + I_D;
    for (int it = gw; it < NITEMS; it += NGW) {
        int r = it;
        if (r < I_IN) { const int nb = r % (IN_COLS / 32), kb = r / (IN_COLS / 32); tr_item(F.w_in, IN_COLS, 64 * kb, win_src_col(32 * nb + (lane & 31)), nullptr, F.Win_t, D, 32 * nb, scr, lane); continue; } r -= I_IN;
        if (r < I_O) { const int nb = r % (D / 32), kb = r / (D / 32); tr_item(F.w_out, D, 64 * kb, 32 * nb + (lane & 31), nullptr, F.Wo_t, D, 32 * nb, scr, lane); continue; } r -= I_O;
        if (r < I_GU) { const int e = r / 512, q = r % 512, nb = q % 32, kb = q / 32;
            const float* src = (((nb >> 2) & 1) ? F.w_up : F.w_gate) + (size_t)e * D * FF; const int f0 = (nb >> 3) * 128 + (nb & 3) * 32;
            tr_item(src, FF, 64 * kb, f0 + (lane & 31), F.g2, F.Wgu_t + (size_t)e * 1024 * D, D, 32 * nb, scr, lane); continue; } r -= I_GU;
        { const int e = r / 256, q = r % 256, nb = q % 32, kb = q / 32;
            tr_item(F.w_down + (size_t)e * FF * D, D, 64 * kb, 32 * nb + (lane & 31), nullptr, F.Wd_t + (size_t)e * D * FF, FF, 32 * nb, scr, lane); }
    }
    for (int i = (gw * 64 + lane); i < 36 * D; i += NGW * 64) { const int j = i / D, k = i % D; F.Wr[i] = F.g2[k] * (j < 4 ? F.w_rg[k * 4 + j] : F.w_re[k * NEXP + (j - 4)]); }
    for (int i = (gw * 64 + lane); i < SEQ * 32; i += NGW * 64) { const int pos = i >> 5, fi = i & 31;
        double inv = 1.0; for (int q = 0; q < fi; ++q) inv *= 0.74989420933245582730;
        const double rev = (double)pos * inv * 0.15915494309189533577; const float fr = (float)(rev - __builtin_rint(rev));
        typedef float f32x2g __attribute__((ext_vector_type(2))); f32x2g cs; cs.x = __builtin_amdgcn_cosf(fr); cs.y = __builtin_amdgcn_sinf(fr); *(GAS f32x2g*)(F.rope + 2 * (size_t)i) = cs; }
    for (int m = gw; m < T; m += NGW) {
        const GAS f32x4* xr = (const GAS f32x4*)(F.x + (size_t)m * D) + lane; const GAS f32x4* gr = (const GAS f32x4*)F.g1 + lane;
        f32x4 v[4]; float s = 0.f;
#pragma unroll
        for (int j = 0; j < 4; ++j) { v[j] = xr[64 * j]; s += (v[j].x * v[j].x + v[j].y * v[j].y) + (v[j].z * v[j].z + v[j].w * v[j].w); }
        const float rstd = 1.0f / sqrtf(wave_sum(s) * (1.f / D) + RMS_EPS);
        GAS unsigned long long* o8 = (GAS unsigned long long*)(F.XN + (size_t)m * D) + lane;
#pragma unroll
        for (int j = 0; j < 4; ++j) { const f32x4 g = gr[64 * j]; o8[64 * j] = (unsigned long long)pk2(v[j].x * rstd * g.x, v[j].y * rstd * g.y) | ((unsigned long long)pk2(v[j].z * rstd * g.z, v[j].w * rstd * g.w) << 32); }
    }
}
__device__ __forceinline__ void p2_attention(Frame& F, char* lds) {
    using abf = attn_body::bf16;
#ifndef SKIP_DIFF
    for (int L = F.vcu; L < 32 * 64; L += F.G) {
        const int i = L >> 8, v = L & 255, hh = v >> 3, s = v & 7, qb = 16 * (i >> 1) + ((i & 1) ? 15 - s : s);
        const int vh = hh & 1, c = (hh >> 1) & 1, h = (hh >> 2) & 3, b = hh >> 4;
        const abf* base = (const abf*)F.QKV + (size_t)b * SEQ * IN_COLS;
        attn_body::attn_unit<0, 8>(base + h * 128 + c * 64, base + 512 + h * 128 + c * 64, base + 1024 + h * 128 + vh * 64,
                                   (abf*)F.OD + (size_t)b * SEQ * D + c * 512 + h * 128 + vh * 64, qb * 256, 0, 4 * qb + 4, 0.f, lds);
    }
#endif
#ifndef SKIP_SWA
    for (int L = F.vcu; L < 2 * 2 * 64; L += F.G) {
        const int qb = L & 63, kvh = (L >> 6) & 1, b = L >> 7;
        const abf* base = (const abf*)F.QKV + (size_t)b * SEQ * IN_COLS;
        float sk[4];
#pragma unroll
        for (int g = 0; g < 4; ++g) sk[g] = F.sinks[kvh * 4 + g] * 1.4426950408889634f;
        attn_body::swa_unit(base + 1536 + kvh * 256, base + 2048 + kvh * 64, base + 2176 + kvh * 64, (abf*)F.MIX + (size_t)b * SEQ * D + 512 + kvh * 256, qb * 256, sk, lds);
    }
#endif
}
__device__ __forceinline__ void p2b_combine(Frame& F) {
    int lane_ = F.lane; asm volatile("" : "+v"(lane_)); const int gw = F.vcu * NWAVES + F.wave, NGW = F.G * NWAVES, lane = lane_;
    const float lam = __expf(wave_sum(F.lq1[lane] * F.lk1[lane])) - __expf(wave_sum(F.lq2[lane] * F.lk2[lane])) + 0.2f;
    const f32x4 ga = *(const f32x4*)(F.subg + (lane & 15) * 8), gb = *(const f32x4*)(F.subg + (lane & 15) * 8 + 4);
    for (int m = gw; m < T; m += NGW) {
        const v4u a = *(const GAS v4u*)(F.OD + (size_t)m * D + 8 * lane), b = *(const GAS v4u*)(F.OD + (size_t)m * D + 512 + 8 * lane);
        float o[8]; float ss = 0.f;
#pragma unroll
        for (int q = 0; q < 4; ++q) { const unsigned ua = q == 0 ? a.x : q == 1 ? a.y : q == 2 ? a.z : a.w, ub = q == 0 ? b.x : q == 1 ? b.y : q == 2 ? b.z : b.w;
            o[2 * q] = __uint_as_float(ua << 16) - lam * __uint_as_float(ub << 16); o[2 * q + 1] = __uint_as_float(ua & 0xffff0000u) - lam * __uint_as_float(ub & 0xffff0000u);
            ss += o[2 * q] * o[2 * q] + o[2 * q + 1] * o[2 * q + 1]; }
        ss += __shfl_xor(ss, 1); ss += __shfl_xor(ss, 2); ss += __shfl_xor(ss, 4); ss += __shfl_xor(ss, 8);
        const float r = 0.8f / sqrtf(ss * (1.f / 128.f) + RMS_EPS);
        v4u w; w.x = pk2(o[0] * r * ga[0], o[1] * r * ga[1]); w.y = pk2(o[2] * r * ga[2], o[3] * r * ga[3]); w.z = pk2(o[4] * r * gb[0], o[5] * r * gb[1]); w.w = pk2(o[6] * r * gb[2], o[7] * r * gb[3]);
        *(GAS v4u*)(F.MIX + (size_t)m * D + 8 * lane) = w;
    }
}
__device__ __forceinline__ float reduce8(const float (&a)[8], int lane) {
    const bool b5 = lane & 32, b4 = lane & 16, b3 = lane & 8; float t[4], s[2];
#pragma unroll
    for (int i = 0; i < 4; ++i) { const float keep = b5 ? a[i + 4] : a[i], send = b5 ? a[i] : a[i + 4]; t[i] = keep + __shfl_xor(send, 32); }
#pragma unroll
    for (int i = 0; i < 2; ++i) { const float keep = b4 ? t[i + 2] : t[i], send = b4 ? t[i] : t[i + 2]; s[i] = keep + __shfl_xor(send, 16); }
    float q; { const float keep = b3 ? s[1] : s[0], send = b3 ? s[0] : s[1]; q = keep + __shfl_xor(send, 8); }
    q += __shfl_xor(q, 4); q += __shfl_xor(q, 2); q += __shfl_xor(q, 1);
    return q;
}
__device__ __forceinline__ float dot4(const f32x4 a, const f32x4 b) { return (a.x * b.x + a.y * b.y) + (a.z * b.z + a.w * b.w); }
__device__ __forceinline__ void p4a_router(Frame& F) {
    LAS int* lcnt = (LAS int*)(F.lds + RING_OFF);
    LAS float* lgs = (LAS float*)(F.lds + RING_OFF + 1024) + F.wave * 320;
    int lane_ = F.lane; asm volatile("" : "+v"(lane_)); const int lane = lane_;
    for (int ch = F.vcu; ch < NCHUNK; ch += F.G) {
        if (F.tid < 32) lcnt[F.tid] = 0;
        __syncthreads();
        for (int pass = 0; pass < 2; ++pass) {
            const int rbase = ch * CHUNK_TOK + F.wave * 16 + pass * 8;
            f32x4 v[8][4];
#pragma unroll
            for (int r = 0; r < 8; ++r)
#pragma unroll
                for (int j = 0; j < 4; ++j) v[r][j] = *((const GAS f32x4*)(F.out + (size_t)(rbase + r) * D) + lane + 64 * j);
            float a[8];
#pragma unroll
            for (int r = 0; r < 8; ++r) a[r] = (dot4(v[r][0], v[r][0]) + dot4(v[r][1], v[r][1])) + (dot4(v[r][2], v[r][2]) + dot4(v[r][3], v[r][3]));
            const float ssq = reduce8(a, lane);
#pragma unroll 1
            for (int jo = 0; jo < 36; ++jo) {
                f32x4 w[4];
#pragma unroll
                for (int j = 0; j < 4; ++j) w[j] = *((const GAS f32x4*)(F.Wr + (size_t)jo * D) + lane + 64 * j);
#pragma unroll
                for (int r = 0; r < 8; ++r) a[r] = (dot4(v[r][0], w[0]) + dot4(v[r][1], w[1])) + (dot4(v[r][2], w[2]) + dot4(v[r][3], w[3]));
                const float q = reduce8(a, lane);
                if ((lane & 7) == 0) lgs[(lane >> 3) * 40 + jo] = q;
            }
            LDS_WAIT(); asm volatile("" ::: "memory");
            const LAS float* lg = lgs + (lane >> 3) * 40;
            const float rstd = 1.0f / sqrtf(ssq * (1.f / D) + RMS_EPS);
            float g[4];
#pragma unroll
            for (int j = 0; j < 4; ++j) g[j] = lg[j] * rstd + F.b_rg[j];
            int gi = 0; float gm = g[0];
#pragma unroll
            for (int j = 1; j < 4; ++j) if (g[j] > gm) { gm = g[j]; gi = j; }
            float den = 0.f;
#pragma unroll
            for (int j = 0; j < 4; ++j) den += __expf(g[j] - gm);
            const float ptop = 1.0f / den;
            float el[8];
#pragma unroll
            for (int i = 0; i < 8; ++i) el[i] = lg[4 + gi * 8 + i] * rstd + F.b_re[gi * 8 + i];
            int i0 = 0; float v0 = el[0];
#pragma unroll
            for (int i = 1; i < 8; ++i) if (el[i] > v0) { v0 = el[i]; i0 = i; }
            int i1 = -1; float v1 = -INFINITY;
#pragma unroll
            for (int i = 0; i < 8; ++i) if (i != i0 && el[i] > v1) { v1 = el[i]; i1 = i; }
            const float e1w = __expf(v1 - v0), gt0 = ptop / (1.0f + e1w), gt1 = gt0 * e1w;
            if ((lane & 7) == 0) { const int t = rbase + (lane >> 3); const int e0 = gi * 8 + i0, e1 = gi * 8 + i1;
                F.tok_e[2 * t] = e0; F.tok_e[2 * t + 1] = e1; F.tok_g[2 * t] = gt0; F.tok_g[2 * t + 1] = gt1; F.tok_rstd[t] = rstd;
                atomicAdd((int*)&lcnt[e0], 1); atomicAdd((int*)&lcnt[e1], 1); }
            LDS_WAIT(); asm volatile("" ::: "memory");
        }
        __syncthreads();
        if (F.tid < 32) F.cnt[ch * 32 + F.tid] = lcnt[F.tid];
        __syncthreads();
    }
}
__device__ __forceinline__ void p4b_scatter(Frame& F) {
    LAS int* E = (LAS int*)(F.lds + RING_OFF);
    LAS int* SL = E + 256;
    LAS int* base = SL + 256;
    LAS int* padded = base + 32;
    LAS int* padlo = padded + 32;
    LAS int* padhi = padlo + 32;
    int tid_ = F.tid; asm volatile("" : "+v"(tid_)); const int tid = tid_, lane = tid & 63;
    for (int ch = F.vcu; ch < NCHUNK; ch += F.G) {
        int pre = 0, total = 0;
        if (tid < 256) E[tid] = F.tok_e[ch * 256 + tid];
        if (tid < 32) { for (int c2 = 0; c2 < NCHUNK; ++c2) { const int vv = F.cnt[c2 * 32 + tid]; total += vv; if (c2 < ch) pre += vv; } padded[tid] = (total + 255) & ~255; }
        __syncthreads();
        if (tid < 32) { int ps = 0; for (int e2 = 0; e2 < tid; ++e2) ps += padded[e2];
            base[tid] = ps + pre; padlo[tid] = ps + total; padhi[tid] = ps + padded[tid];
            if (ch == 0) { for (int rb = ps >> 8; rb < ((ps + padded[tid]) >> 8); ++rb) F.blk_e[rb] = (unsigned)tid; if (tid == 31) __hip_atomic_store(F.ctl + CW_NBU, (unsigned)((ps + padded[tid]) >> 8), RLX_AGENT); } }
        __syncthreads();
        if (tid < 256) { const int e = E[tid]; int rank = 0; for (int a2 = 0; a2 < tid; ++a2) rank += (E[a2] == e) ? 1 : 0;
            const int slot = base[e] + rank; SL[tid] = slot;
            F.slot_dst[slot] = ch * 256 + tid; F.slot_gate[slot] = F.tok_g[ch * 256 + tid]; F.slot_rstd[slot] = F.tok_rstd[ch * CHUNK_TOK + (tid >> 1)]; }
        __syncthreads();
        for (int i = 0; i < 16; ++i) { const int tl = F.wave * 16 + i; const size_t t = (size_t)ch * CHUNK_TOK + tl;
            const v4u a = *(const GAS v4u*)(F.HB + t * D + 8 * lane), b = *(const GAS v4u*)(F.HB + t * D + 512 + 8 * lane);
            const size_t s0 = (size_t)SL[2 * tl], s1 = (size_t)SL[2 * tl + 1];
            *(GAS v4u*)(F.XS + s0 * D + 8 * lane) = a; *(GAS v4u*)(F.XS + s0 * D + 512 + 8 * lane) = b;
            *(GAS v4u*)(F.XS + s1 * D + 8 * lane) = a; *(GAS v4u*)(F.XS + s1 * D + 512 + 8 * lane) = b; }
        if (ch < NEXP) { const int lo = padlo[ch], hi = padhi[ch];
            for (int s = lo + tid; s < hi; s += NWAVES * 64) { F.slot_dst[s] = -1; F.slot_gate[s] = 0.f; F.slot_rstd[s] = 0.f; }
            for (int s = lo + F.wave; s < hi; s += NWAVES) { const v4u z = {0u, 0u, 0u, 0u}; *(GAS v4u*)(F.XS + (size_t)s * D + 8 * lane) = z; *(GAS v4u*)(F.XS + (size_t)s * D + 512 + 8 * lane) = z; } }
        __syncthreads();
    }
}
__device__ __forceinline__ void p6_final(Frame& F) {
    int lane_ = F.lane; asm volatile("" : "+v"(lane_)); const int gw = F.vcu * NWAVES + F.wave, NGW = F.G * NWAVES, lane = lane_;
    for (int m = gw; m < T; m += NGW) {
        GAS f32x4* hr = (GAS f32x4*)(F.out + (size_t)m * D) + lane; const GAS f32x4* gr = (const GAS f32x4*)F.gf + lane;
        const GAS unsigned long long* y0 = (const GAS unsigned long long*)(F.Y + (size_t)(2 * m) * D) + lane; const GAS unsigned long long* y1 = (const GAS unsigned long long*)(F.Y + (size_t)(2 * m + 1) * D) + lane;
        f32x4 v[4]; float s = 0.f;
#pragma unroll
        for (int j = 0; j < 4; ++j) { v[j] = hr[64 * j]; const unsigned long long a = y0[64 * j], b = y1[64 * j];
            v[j].x += __uint_as_float((unsigned)a << 16) + __uint_as_float((unsigned)b << 16); v[j].y += __uint_as_float((unsigned)a & 0xffff0000u) + __uint_as_float((unsigned)b & 0xffff0000u);
            v[j].z += __uint_as_float((unsigned)(a >> 32) << 16) + __uint_as_float((unsigned)(b >> 32) << 16); v[j].w += __uint_as_float((unsigned)(a >> 32) & 0xffff0000u) + __uint_as_float((unsigned)(b >> 32) & 0xffff0000u);
            s += (v[j].x * v[j].x + v[j].y * v[j].y) + (v[j].z * v[j].z + v[j].w * v[j].w); }
        const float rstd = 1.0f / sqrtf(wave_sum(s) * (1.f / D) + RMS_EPS);
#pragma unroll
        for (int j = 0; j < 4; ++j) { const f32x4 g = gr[64 * j]; hr[64 * j] = (f32x4){v[j].x * rstd * g.x, v[j].y * rstd * g.y, v[j].z * rstd * g.z, v[j].w * rstd * g.w}; }
    }
}

struct Args { const float* in[19]; float* out; unsigned char* ws; };
__global__ void __launch_bounds__(NWAVES * 64, 2) hymba_fwd(Args args) {
    extern __shared__ __attribute__((aligned(16))) unsigned char lds[];
    Frame F;
    F.lds = (LAS unsigned char*)lds;
    F.MISC = (volatile LAS unsigned*)(F.lds + MISC_OFF);
    F.tid = threadIdx.x; F.lane = F.tid & 63; F.wave = __builtin_amdgcn_readfirstlane(F.tid >> 6);
    F.G = gridDim.x; { const int bx = blockIdx.x; F.vcu = (F.G % 8 == 0) ? (bx % 8) * (F.G / 8) + bx / 8 : bx; }
    unsigned char* ws = args.ws;
    F.ctl = (gu32*)(ws + WS_CTL);
    F.x = args.in[0]; F.g1 = args.in[1]; F.w_in = args.in[2]; F.lq1 = args.in[3]; F.lk1 = args.in[4]; F.lq2 = args.in[5]; F.lk2 = args.in[6]; F.subg = args.in[7]; F.sinks = args.in[8];
    F.w_out = args.in[9]; F.g2 = args.in[10]; F.w_rg = args.in[11]; F.b_rg = args.in[12]; F.w_re = args.in[13]; F.b_re = args.in[14]; F.w_gate = args.in[15]; F.w_up = args.in[16]; F.w_down = args.in[17]; F.gf = args.in[18];
    F.out = args.out;
    F.Win_t = (bf16*)(ws + WS_WIN); F.Wo_t = (bf16*)(ws + WS_WO); F.Wgu_t = (bf16*)(ws + WS_WGU); F.Wd_t = (bf16*)(ws + WS_WD);
    F.XN = (bf16*)(ws + WS_A); F.OD = F.XN; F.HB = F.XN; F.Y = F.XN; F.MIX = (bf16*)(ws + WS_MIX); F.QKV = (bf16*)(ws + WS_QKV); F.XS = F.QKV; F.HM = (bf16*)(ws + WS_HM);
    F.Wr = (float*)(ws + WS_WR); F.rope = (float*)(ws + WS_ROPE);
    { unsigned char* p = ws + WS_TOK; F.tok_e = (int*)p; p += (size_t)T * 8; F.tok_g = (float*)p; p += (size_t)T * 8; F.tok_rstd = (float*)p; p += (size_t)T * 4; F.cnt = (int*)p; p += NCHUNK * 32 * 4;
      F.blk_e = (unsigned*)p; p += 288 * 4; F.slot_dst = (int*)p; p += (size_t)PSLOTS * 4; F.slot_gate = (float*)p; p += (size_t)PSLOTS * 4; F.slot_rstd = (float*)p; }
    for (int u = F.tid; u < (LDS_BYTES - LDSCTL_OFF) / 4; u += NWAVES * 64) ((LAS unsigned*)(F.lds + LDSCTL_OFF))[u] = 0u;
    __syncthreads();
    XcdBarrier bar = xcd_barrier_post((unsigned*)(F.ctl + CW_BAR), F.MISC + 8);
#define GRID_BAR() xcd_barrier(bar)

#ifndef SKIP_P0
    p0_prologue(F);
#endif
    GRID_BAR();
#ifndef SKIP_P1
    { pg8::Gemm g{F.XN, F.Win_t, T, IN_COLS, D}; pg8::StaticOrder S; S.init(T, IN_COLS, F.G, (int)blockIdx.x);
      pg8::EpiQKV E{F.QKV, F.rope, attn_body::C2};
      pg8::gemm_phase<pg8::EpiQKV, pg8::StaticOrder, PG8_ALIGN, PG8_SP2>(F.lds + RING_OFF, g, S, E); }
#endif
    GRID_BAR();
#ifndef SKIP_P2
    p2_attention(F, (char*)lds + RING_OFF);
#endif
    GRID_BAR();
#ifndef SKIP_P2B
    p2b_combine(F);
#endif
    GRID_BAR();
#ifndef SKIP_P3
    { pg8::Gemm g{F.MIX, F.Wo_t, T, D, D}; pg8::StaticOrder S; S.init(T, D, F.G, (int)blockIdx.x);
      pg8::EpiResid E{F.x, F.out, F.HB};
      pg8::gemm_phase<pg8::EpiResid, pg8::StaticOrder, PG8_ALIGN, PG8_SP2>(F.lds + RING_OFF, g, S, E); }
#endif
    GRID_BAR();
#ifndef SKIP_P4A
    p4a_router(F);
#endif
    GRID_BAR();
#ifndef SKIP_P4B
    p4b_scatter(F);
#endif
    GRID_BAR();
    const int nbu = __builtin_amdgcn_readfirstlane((int)__hip_atomic_load(F.ctl + CW_NBU, RLX_AGENT));
#ifndef SKIP_P5A
    { pg8::Gemm g{F.XS, F.Wgu_t, PSLOTS, NEXP * 1024, D}; pg8::MoeSched S{F.blk_e, nbu * 4, F.G, (int)blockIdx.x};
      pg8::EpiGateUp E{F.HM, F.slot_rstd};
      pg8::gemm_phase<pg8::EpiGateUp, pg8::MoeSched, PG8_ALIGN, PG8_SP2>(F.lds + RING_OFF, g, S, E); }
#endif
    GRID_BAR();
#ifndef SKIP_P5B
    { pg8::Gemm g{F.HM, F.Wd_t, PSLOTS, NEXP * 1024, FF}; pg8::MoeSched S{F.blk_e, nbu * 4, F.G, (int)blockIdx.x};
      pg8::EpiDown E{F.Y, F.slot_dst, F.slot_gate};
      pg8::gemm_phase<pg8::EpiDown, pg8::MoeSched, PG8_ALIGN, PG8_SP2>(F.lds + RING_OFF, g, S, E); }
#endif
    GRID_BAR();
#ifndef SKIP_P6
    p6_final(F);
#endif
}

extern "C" void kernel_launch(void* const* d_in, const int* in_sizes, int n_in, void* d_out, int out_size, void* d_ws, size_t ws_size, hipStream_t stream) {
    static int grid = 0;
    if (grid == 0) {
        if (n_in != 19 || in_sizes[0] != T * D || out_size != T * D || ws_size < WS_END) { fprintf(stderr, "kernel_launch: unexpected shapes (n_in %d, in0 %d, out %d, ws %zu); nothing launched\n", n_in, n_in > 0 ? in_sizes[0] : -1, out_size, ws_size); grid = -1; return; }
        int dev = 0, cus = 0, per_cu = 0;
        if (hipGetDevice(&dev) != hipSuccess || hipDeviceGetAttribute(&cus, hipDeviceAttributeMultiprocessorCount, dev) != hipSuccess) { grid = -1; return; }
        if (hipFuncSetAttribute((const void*)hymba_fwd, hipFuncAttributeMaxDynamicSharedMemorySize, LDS_BYTES) != hipSuccess) { grid = -1; return; }
        if (hipOccupancyMaxActiveBlocksPerMultiprocessor(&per_cu, (const void*)hymba_fwd, NWAVES * 64, LDS_BYTES) != hipSuccess || per_cu < 1) { fprintf(stderr, "kernel_launch: occupancy query reports %d\n", per_cu); }
        (void)hipGetLastError();
        grid = cus;
    }
    if (grid < 0) return;
    if (hipMemsetAsync((char*)d_ws + WS_CTL, 0, CTL_ZERO_BYTES, stream) != hipSuccess) return;
    Args a{};
    for (int i = 0; i < 19; ++i) a.in[i] = (const float*)d_in[i];
    a.out = (float*)d_out; a.ws = (unsigned char*)d_ws;
    hipLaunchKernelGGL(hymba_fwd, dim3(grid), dim3(NWAVES * 64), LDS_BYTES, stream, a);
}
```

```cpp
#include <hip/hip_runtime.h>
#include <cstdio>
#include <cstdint>
namespace pg8 {
#define PG8_LAS __attribute__((address_space(3)))
typedef unsigned short bf16_t;
typedef short bf16x8 __attribute__((ext_vector_type(8)));
typedef float f32x4 __attribute__((ext_vector_type(4)));
typedef unsigned u32x4 __attribute__((ext_vector_type(4)));
constexpr int BM = 256, BK = 64, HALF = 128, HTB = HALF * BK * 2  , STAGE_BYTES = 8 * HTB, NXCD = 8, WGM = 2;

__host__ __device__ __forceinline__ int lds_byte(int r, int c) { const int st = (r >> 4) * 2 + (c >> 5), rr = r & 15, cc = c & 31, ob = rr * 64 + cc * 2; return st * 1024 + (ob ^ (((ob >> 9) & 1) << 5)); }
__host__ __device__ __forceinline__ void stage_rc(int b, int& R, int& C) { const int st = b / 1024, sb = b % 1024, swz = sb ^ (((sb >> 9) & 1) << 5); R = (st >> 1) * 16 + swz / 64; C = (st & 1) * 32 + (swz % 64) / 2; }
__host__ __device__ __forceinline__ int perm32(int rho) { const int n = rho >> 4, i = rho & 15; return 8 * (i >> 2) + 4 * n + (i & 3); }

struct Unit { int pm, pn; };
struct Gemm { const bf16_t* A; const bf16_t* Bt; int M, N, K; };

struct StaticOrder {
    int nM, nN, nwg, G, c;
    __host__ __device__ void init(int M, int N, int G_, int c_) { nM = M / BM; nN = N / BM; nwg = nM * nN; G = G_; c = c_; }
    __host__ __device__ bool next(int i, Unit& u) const {
        const long L = (long)i * G + c; if (L >= nwg) return false;
        int wgid = (int)L; { const int q = nwg / NXCD, r = nwg % NXCD, xcd = wgid % NXCD, off = wgid / NXCD; wgid = (xcd < r ? xcd * (q + 1) : r * (q + 1) + (xcd - r) * q) + off; }
        const int nig = WGM * nN, gid = wgid / nig, fm = gid * WGM, gsz = (nM - fm) < WGM ? (nM - fm) : WGM;
        u.pm = fm + ((wgid % nig) % gsz); u.pn = (wgid % nig) / gsz; return true;
    }
    __device__ __forceinline__ void a_ready(const Unit&) const {}
    __device__ __forceinline__ void done(const Unit&) const {}
};

__device__ __forceinline__ unsigned cvt_pk_bf16(float lo, float hi) { unsigned r; asm volatile("v_cvt_pk_bf16_f32 %0, %1, %2" : "=v"(r) : "v"(lo), "v"(hi)); return r; }
typedef float f32x2 __attribute__((ext_vector_type(2)));
__device__ __forceinline__ f32x2 gelu_pk(f32x2 v) {
    const f32x2 av = __builtin_elementwise_abs(v), d = av * 0.2316418882f + 1.0f;
    f32x2 t; t.x = __builtin_amdgcn_rcpf(d.x); t.y = __builtin_amdgcn_rcpf(d.y);
    f32x2 q = t * 0.5307027145f + (-0.7265760135f); q = q * t + 0.7107068705f; q = q * t + (-0.142248368f); q = q * t + 0.127414796f; q = q * t;
    const f32x2 s = (v * v) * (-0.72134752044f);
    f32x2 e; e.x = __builtin_amdgcn_exp2f(s.x); e.y = __builtin_amdgcn_exp2f(s.y);
    const f32x2 m = v * (q * e), r = v - m;
    f32x2 o; o.x = v.x < 0.f ? m.x : r.x; o.y = v.y < 0.f ? m.y : r.y; return o;
}

template <int ACT  > struct EpiBf16 {
    static constexpr bool PERM = true, AFTER_DRAIN = false; static_assert(ACT == 0 || ACT == 1, "EpiBf16: ACT is 0 (none) or 1 (gelu_pk)");
    bf16_t* O; int ldc; const float* bias; int split_cols; size_t split_stride; float scale0;
    __device__ __forceinline__ void operator()(const f32x4 (&acc)[2][2][4][2], const Unit& u, int wr, int wc, int fr, int fq) const {
        const int row0 = u.pm * BM + wr * 64 + fr; int colt = u.pn * BM; bf16_t* base = O;
        float sc = 1.f; if (split_cols) { const int t = colt / split_cols; base += (size_t)t * split_stride; colt -= t * split_cols; if (t == 0) sc = scale0; }
        const int col0 = colt + wc * 32 + 8 * fq, bcol0 = u.pn * BM + wc * 32 + 8 * fq;
        f32x4 bv[2][2];
#pragma unroll
        for (int bj = 0; bj < 2; ++bj)
#pragma unroll
            for (int n = 0; n < 2; ++n) bv[bj][n] = bias ? *(const f32x4*)(bias + bcol0 + bj * HALF + 4 * n) : (f32x4){0.f, 0.f, 0.f, 0.f};
#pragma unroll
        for (int ai = 0; ai < 2; ++ai)
#pragma unroll
            for (int m = 0; m < 4; ++m) { bf16_t* rowp = base + (size_t)(row0 + ai * HALF + m * 16) * ldc + col0;
#pragma unroll
                for (int bj = 0; bj < 2; ++bj) { f32x4 v0 = acc[ai][bj][m][0] + bv[bj][0], v1 = acc[ai][bj][m][1] + bv[bj][1];
                    if (ACT == 1) { f32x2 a = gelu_pk((f32x2){v0[0], v0[1]}), b = gelu_pk((f32x2){v0[2], v0[3]}), c = gelu_pk((f32x2){v1[0], v1[1]}), d = gelu_pk((f32x2){v1[2], v1[3]});
                        v0 = (f32x4){a.x, a.y, b.x, b.y}; v1 = (f32x4){c.x, c.y, d.x, d.y}; }
                    v0 = v0 * sc; v1 = v1 * sc; u32x4 w; w.x = cvt_pk_bf16(v0[0], v0[1]); w.y = cvt_pk_bf16(v0[2], v0[3]); w.z = cvt_pk_bf16(v1[0], v1[1]); w.w = cvt_pk_bf16(v1[2], v1[3]);
                    *(u32x4*)(rowp + bj * HALF) = w; } }
    }
};

constexpr int QKV_LD = 2304, SEQ_LEN = 16384;
struct EpiQKV {
    static constexpr bool PERM = true, AFTER_DRAIN = false;
    bf16_t* O; const float* rope; float qscale; int norope; unsigned* kmax;
    __device__ __forceinline__ void operator()(const f32x4 (&acc)[2][2][4][2], const Unit& u, int wr, int wc, int fr, int fq) const {
        const int row0 = u.pm * BM + wr * 64 + fr;
#pragma unroll
        for (int bj = 0; bj < 2; ++bj) {
            const int cb = u.pn * BM + bj * HALF, col0 = cb + wc * 32 + 8 * fq;
            const bool isrope = !norope && ((cb < 1024) || (cb >= 1536 && cb < 2176));
            const float sc = ((cb < 512) || (cb >= 1536 && cb < 2048)) ? qscale : 1.f;
            const int i0 = (col0 & 63) >> 1;
            const bool iskd = ((cb >= 512) && (cb < 1024)) || cb == 2048; float kmx = 0.f;
#pragma unroll
            for (int ai = 0; ai < 2; ++ai)
#pragma unroll
                for (int m = 0; m < 4; ++m) {
                    const int row = row0 + ai * HALF + m * 16;
                    f32x4 v0 = acc[ai][bj][m][0], v1 = acc[ai][bj][m][1];
                    if (isrope) {
                        const int pos = row & (SEQ_LEN - 1);
                        const f32x4* tp = (const f32x4*)(rope + ((size_t)pos * 32 + i0) * 2);
                        const f32x4 t0 = tp[0], t1 = tp[1];
                        f32x4 r0, r1;
                        r0[0] = v0[0] * t0[0] - v0[1] * t0[1]; r0[1] = v0[0] * t0[1] + v0[1] * t0[0];
                        r0[2] = v0[2] * t0[2] - v0[3] * t0[3]; r0[3] = v0[2] * t0[3] + v0[3] * t0[2];
                        r1[0] = v1[0] * t1[0] - v1[1] * t1[1]; r1[1] = v1[0] * t1[1] + v1[1] * t1[0];
                        r1[2] = v1[2] * t1[2] - v1[3] * t1[3]; r1[3] = v1[2] * t1[3] + v1[3] * t1[2];
                        v0 = r0; v1 = r1;
                    }
                    if (iskd) kmx = __builtin_fmaxf(kmx, (v0[0] * v0[0] + v0[1] * v0[1]) + (v0[2] * v0[2] + v0[3] * v0[3]) + (v1[0] * v1[0] + v1[1] * v1[1]) + (v1[2] * v1[2] + v1[3] * v1[3]));
                    v0 = v0 * sc; v1 = v1 * sc;
                    u32x4 w; w.x = cvt_pk_bf16(v0[0], v0[1]); w.y = cvt_pk_bf16(v0[2], v0[3]); w.z = cvt_pk_bf16(v1[0], v1[1]); w.w = cvt_pk_bf16(v1[2], v1[3]);
                    *(u32x4*)(O + (size_t)row * QKV_LD + col0) = w;
                }
            if (iskd) {
                kmx = __builtin_fmaxf(kmx, __builtin_bit_cast(float, __builtin_amdgcn_mov_dpp(__builtin_bit_cast(int, kmx), 0xB1, 0xF, 0xF, true)));
                kmx = __builtin_fmaxf(kmx, __builtin_bit_cast(float, __builtin_amdgcn_mov_dpp(__builtin_bit_cast(int, kmx), 0x4E, 0xF, 0xF, true)));
                kmx = __builtin_fmaxf(kmx, __builtin_bit_cast(float, __builtin_amdgcn_mov_dpp(__builtin_bit_cast(int, kmx), 0x141, 0xF, 0xF, true)));
                kmx = __builtin_fmaxf(kmx, __builtin_bit_cast(float, __builtin_amdgcn_mov_dpp(__builtin_bit_cast(int, kmx), 0x140, 0xF, 0xF, true)));
                const int slot = cb < 1024 ? (((u.pm >> 6) * 8 + ((cb + wc * 32 - 512) >> 6)) * 8) : (128 + ((u.pm >> 6) * 2 + (wc >> 1)) * 8);
                if (fr == 0) __hip_atomic_fetch_max(kmax + slot + (wc & 1) * 4 + fq, __builtin_bit_cast(unsigned, kmx), __ATOMIC_RELAXED, __HIP_MEMORY_SCOPE_AGENT); }
        }
    }
};
struct EpiResid {
    static constexpr bool PERM = true, AFTER_DRAIN = false;
    const float* x; bf16_t* hb;
    __device__ __forceinline__ void operator()(const f32x4 (&acc)[2][2][4][2], const Unit& u, int wr, int wc, int fr, int fq) const {
        const int row0 = u.pm * BM + wr * 64 + fr;
#pragma unroll
        for (int ai = 0; ai < 2; ++ai)
#pragma unroll
            for (int m = 0; m < 4; ++m) {
                const size_t ro = (size_t)(row0 + ai * HALF + m * 16) * 1024;
#pragma unroll
                for (int bj = 0; bj < 2; ++bj) {
                    const size_t o = ro + u.pn * BM + bj * HALF + wc * 32 + 8 * fq;
                    const f32x4 v0 = acc[ai][bj][m][0] + *(const f32x4*)(x + o), v1 = acc[ai][bj][m][1] + *(const f32x4*)(x + o + 4);
                    u32x4 w; w.x = cvt_pk_bf16(v0[0], v0[1]); w.y = cvt_pk_bf16(v0[2], v0[3]); w.z = cvt_pk_bf16(v1[0], v1[1]); w.w = cvt_pk_bf16(v1[2], v1[3]);
                    *(u32x4*)(hb + o) = w;
                }
            }
    }
};
__device__ __forceinline__ float silu_mul(float g, float up) { return g * __builtin_amdgcn_rcpf(1.0f + __builtin_amdgcn_exp2f(-1.4426950408889634f * g)) * up; }
struct EpiGateUp {
    static constexpr bool PERM = true, AFTER_DRAIN = false;
    bf16_t* hm; const float* slot_rstd;
    __device__ __forceinline__ void operator()(const f32x4 (&acc)[2][2][4][2], const Unit& u, int wr, int wc, int fr, int fq) const {
        const int row0 = u.pm * BM + wr * 64 + fr, f0 = (u.pn & 3) * 128 + wc * 32 + 8 * fq;
#pragma unroll
        for (int ai = 0; ai < 2; ++ai)
#pragma unroll
            for (int m = 0; m < 4; ++m) {
                const int row = row0 + ai * HALF + m * 16; const float rs = slot_rstd[row];
                const f32x4 g0 = acc[ai][0][m][0] * rs, g1 = acc[ai][0][m][1] * rs, u0 = acc[ai][1][m][0] * rs, u1 = acc[ai][1][m][1] * rs;
                u32x4 w; w.x = cvt_pk_bf16(silu_mul(g0[0], u0[0]), silu_mul(g0[1], u0[1])); w.y = cvt_pk_bf16(silu_mul(g0[2], u0[2]), silu_mul(g0[3], u0[3]));
                w.z = cvt_pk_bf16(silu_mul(g1[0], u1[0]), silu_mul(g1[1], u1[1])); w.w = cvt_pk_bf16(silu_mul(g1[2], u1[2]), silu_mul(g1[3], u1[3]));
                *(u32x4*)(hm + (size_t)row * 512 + f0) = w;
            }
    }
};
struct EpiDown {
    static constexpr bool PERM = true, AFTER_DRAIN = false;
    bf16_t* Y; const int* slot_dst; const float* slot_gate;
    __device__ __forceinline__ void operator()(const f32x4 (&acc)[2][2][4][2], const Unit& u, int wr, int wc, int fr, int fq) const {
        const int row0 = u.pm * BM + wr * 64 + fr, c0 = (u.pn & 3) * BM + wc * 32 + 8 * fq;
#pragma unroll
        for (int ai = 0; ai < 2; ++ai)
#pragma unroll
            for (int m = 0; m < 4; ++m) {
                const int row = row0 + ai * HALF + m * 16; const int dst = slot_dst[row]; const float gt = slot_gate[row];
                if (dst >= 0) {
#pragma unroll
                    for (int bj = 0; bj < 2; ++bj) { const f32x4 v0 = acc[ai][bj][m][0] * gt, v1 = acc[ai][bj][m][1] * gt;
                        u32x4 w; w.x = cvt_pk_bf16(v0[0], v0[1]); w.y = cvt_pk_bf16(v0[2], v0[3]); w.z = cvt_pk_bf16(v1[0], v1[1]); w.w = cvt_pk_bf16(v1[2], v1[3]);
                        *(u32x4*)(Y + (size_t)dst * 1024 + c0 + bj * HALF) = w; }
                }
            }
    }
};
struct MoeSched {
    const unsigned* blk_e; int nunits, G, c;
    __device__ __forceinline__ bool next(int i, Unit& u) const {
        const long L = (long)i * G + c; if (L >= nunits) return false;
        int wgid = (int)L; { const int q = nunits / NXCD, r = nunits % NXCD, xcd = wgid % NXCD, off = wgid / NXCD; wgid = (xcd < r ? xcd * (q + 1) : r * (q + 1) + (xcd - r) * q) + off; }
        const int rb = wgid >> 2, j = wgid & 3;
        const int e = __builtin_amdgcn_readfirstlane((int)__hip_atomic_load(blk_e + rb, __ATOMIC_RELAXED, __HIP_MEMORY_SCOPE_AGENT));
        u.pm = rb; u.pn = e * 4 + j; return true;
    }
    __device__ __forceinline__ void a_ready(const Unit&) const {}
    __device__ __forceinline__ void done(const Unit&) const {}
};
template <class Epi, class Sched, bool ALIGN_EPI = false, bool SP2 = false, bool GATHER = false>
__device__ __forceinline__ void gemm_phase(PG8_LAS unsigned char* lds, const Gemm g, const Sched& S, const Epi& E, PG8_LAS const int* rowtab = nullptr) {
    static_assert(!GATHER || SP2, "GATHER is wired into the SP2 loop only");
    int tid_ = threadIdx.x; asm volatile("" : "+v"(tid_));
    const int tid = tid_, wid = __builtin_amdgcn_readfirstlane(tid >> 6), lane = tid & 63, wr = wid >> 2, wc = wid & 3, fr = lane & 15, fq = lane >> 4;
    const int K = g.K, nt = K / BK;
    unsigned voffA[2], voffB[2];
#pragma unroll
    for (int i = 0; i < 2; ++i) { int R, C; stage_rc(tid * 16 + i * 8192, R, C); const int Rb = Epi::PERM ? ((R & ~31) + perm32(R & 31)) : R;
        voffA[i] = (unsigned)(R * K + C) * 2u; voffB[i] = (unsigned)(Rb * K + C) * 2u; }
    const size_t kstep = (size_t)(BK * 2);
    const size_t hstep = (size_t)HALF * K * 2;
    const size_t tstep = 2 * hstep;
    const unsigned ldsw = (unsigned)wid * 1024u;
    const int aoff = lds_byte(wr * 64 + fr, fq * 8), boff = lds_byte(wc * 32 + fr, fq * 8);
#define PG8_SA(b, h) (((b) * 2 + (h)) * HTB)
#define PG8_SB(b, h) ((4 + (b) * 2 + (h)) * HTB)
#define PG8_STAGE(bufoff, gbase, voff) do { _Pragma("unroll") for (int _i = 0; _i < 2; ++_i) \
        __builtin_amdgcn_global_load_lds((const unsigned*)((const char*)(gbase) + (voff)[_i]), (PG8_LAS unsigned*)(lds + (bufoff) + ldsw + _i * 8192), 16, 0, 0); } while (0)
#define PG8_LDA(dst, b, h) do { _Pragma("unroll") for (int m = 0; m < 4; ++m) _Pragma("unroll") for (int k = 0; k < 2; ++k) dst[m][k] = *(const PG8_LAS bf16x8*)(lds + PG8_SA(b, h) + aoff + m * 2048 + k * 1024); } while (0)
#define PG8_LDB(dst, b, h) do { _Pragma("unroll") for (int n = 0; n < 2; ++n) _Pragma("unroll") for (int k = 0; k < 2; ++k) dst[n][k] = *(const PG8_LAS bf16x8*)(lds + PG8_SB(b, h) + boff + n * 2048 + k * 1024); } while (0)
#define PG8_MMA(ai, bj, At, Bt) do { __builtin_amdgcn_s_setprio(1); _Pragma("unroll") for (int m = 0; m < 4; ++m) _Pragma("unroll") for (int n = 0; n < 2; ++n) _Pragma("unroll") for (int k = 0; k < 2; ++k) \
        acc[ai][bj][m][n] = __builtin_amdgcn_mfma_f32_16x16x32_bf16(Bt[n][k], At[m][k], acc[ai][bj][m][n], 0, 0, 0); __builtin_amdgcn_s_setprio(0); } while (0)
#define PG8_WAIT_V(n) asm volatile("s_waitcnt vmcnt(" #n ")" ::: "memory")
#define PG8_WAIT_L(n) asm volatile("s_waitcnt lgkmcnt(" #n ")" ::: "memory")
#define PG8_BAR __builtin_amdgcn_s_barrier()
#define PG8_SCHED __builtin_amdgcn_sched_barrier(0)
    Unit cur, nxt; int ui = 0;
    if (!S.next(0, cur)) return;
    f32x4 acc[2][2][4][2];
#pragma unroll
    for (int a = 0; a < 2; ++a)
#pragma unroll
        for (int b = 0; b < 2; ++b)
#pragma unroll
            for (int m = 0; m < 4; ++m)
#pragma unroll
                for (int n = 0; n < 2; ++n) acc[a][b][m][n] = (f32x4){0.f, 0.f, 0.f, 0.f};
    bf16x8 At[4][2], B0[2][2], B1[2][2];
    const char* cA = GATHER ? (const char*)g.A : (const char*)g.A + (size_t)cur.pm * tstep; const char* cB = (const char*)g.Bt + (size_t)cur.pn * tstep;
    const size_t hstepA = GATHER ? 0 : hstep;
    unsigned gc[2][2], gn[2][2];
#define PG8_GLOAD(uidx, o) do { _Pragma("unroll") for (int _h = 0; _h < 2; ++_h) _Pragma("unroll") for (int _i = 0; _i < 2; ++_i) { int R_, C_; stage_rc(tid * 16 + _i * 8192, R_, C_); \
        o[_h][_i] = (unsigned)(rowtab[(uidx) * 256 + _h * HALF + R_] * K + C_) * 2u; } } while (0)
    if constexpr (GATHER) { PG8_GLOAD(0, gc); } else { gc[0][0] = gc[1][0] = voffA[0]; gc[0][1] = gc[1][1] = voffA[1]; }
#define PG8_ACUR(bufoff, half, kt) PG8_STAGE(bufoff, cA + (half) * hstepA + (size_t)(kt) * kstep, gc[half])
    S.a_ready(cur);
    if constexpr (SP2) {
        PG8_STAGE(PG8_SB(0, 0), cB, voffB); PG8_STAGE(PG8_SB(0, 1), cB + hstep, voffB); PG8_ACUR(PG8_SA(0, 0), 0, 0); PG8_ACUR(PG8_SA(0, 1), 1, 0);
        if (wr == 1) PG8_BAR;
        PG8_WAIT_V(2); PG8_BAR;
        PG8_STAGE(PG8_SB(1, 0), cB + kstep, voffB); PG8_ACUR(PG8_SA(1, 0), 0, 1); PG8_STAGE(PG8_SB(1, 1), cB + hstep + kstep, voffB);
        PG8_WAIT_V(6); PG8_BAR;
    } else {
        PG8_STAGE(PG8_SB(0, 0), cB, voffB); PG8_STAGE(PG8_SA(0, 0), cA, voffA); PG8_STAGE(PG8_SB(0, 1), cB + hstep, voffB); PG8_STAGE(PG8_SA(0, 1), cA + hstep, voffA);
        if (wr == 1) PG8_BAR;
        PG8_WAIT_V(4); PG8_BAR;
        PG8_STAGE(PG8_SB(1, 0), cB + kstep, voffB); PG8_STAGE(PG8_SA(1, 0), cA + kstep, voffA); PG8_STAGE(PG8_SB(1, 1), cB + hstep + kstep, voffB);
        PG8_WAIT_V(6); PG8_BAR;
    }
    for (;;) {
        const bool has_next = S.next(ui + 1, nxt);
        const char* nA = GATHER ? cA : (has_next ? (const char*)g.A + (size_t)nxt.pm * tstep : cA); const char* nB = has_next ? (const char*)g.Bt + (size_t)nxt.pn * tstep : cB;
        if constexpr (GATHER) { if (has_next) { PG8_GLOAD(ui + 1, gn); } else { gn[0][0] = gc[0][0]; gn[0][1] = gc[0][1]; gn[1][0] = gc[1][0]; gn[1][1] = gc[1][1]; } }
        else { gn[0][0] = gc[0][0]; gn[0][1] = gc[0][1]; gn[1][0] = gc[1][0]; gn[1][1] = gc[1][1]; }
        for (int t = 0; t < nt; t += 2) {
            const bool last = (t == nt - 2);
            const char* a1 = cA + (size_t)(t + 1) * kstep;
            const char* a2 = last ? nA : cA + (size_t)(t + 2) * kstep; const char* b2 = last ? nB : cB + (size_t)(t + 2) * kstep;
            const char* a3 = a2 + kstep; const char* b3 = b2 + kstep;
            unsigned o2[2][2];
            o2[0][0] = last ? gn[0][0] : gc[0][0]; o2[0][1] = last ? gn[0][1] : gc[0][1]; o2[1][0] = last ? gn[1][0] : gc[1][0]; o2[1][1] = last ? gn[1][1] : gc[1][1];
            if (last && has_next) S.a_ready(nxt);
            if constexpr (SP2) {
            PG8_LDB(B0, 0, 0); PG8_LDB(B1, 0, 1); PG8_SCHED; PG8_LDA(At, 0, 0); PG8_STAGE(PG8_SA(1, 1), a1 + hstepA, gc[1]);
            PG8_WAIT_V(8); PG8_WAIT_L(0); PG8_BAR; PG8_MMA(0, 0, At, B0); PG8_MMA(0, 1, At, B1); PG8_BAR; PG8_SCHED;
            PG8_LDA(At, 0, 1); PG8_STAGE(PG8_SB(0, 0), b2, voffB); PG8_STAGE(PG8_SB(0, 1), b2 + hstep, voffB); PG8_STAGE(PG8_SA(0, 0), a2, o2[0]);
            PG8_WAIT_V(8); PG8_WAIT_L(0); PG8_BAR; PG8_MMA(1, 0, At, B0); PG8_MMA(1, 1, At, B1); PG8_BAR; PG8_SCHED;
            PG8_LDB(B0, 1, 0); PG8_LDB(B1, 1, 1); PG8_SCHED; PG8_LDA(At, 1, 0); PG8_STAGE(PG8_SA(0, 1), a2 + hstepA, o2[1]);
            PG8_WAIT_V(8); PG8_WAIT_L(0); PG8_BAR; PG8_MMA(0, 0, At, B0); PG8_MMA(0, 1, At, B1); PG8_BAR; PG8_SCHED;
            PG8_LDA(At, 1, 1); PG8_STAGE(PG8_SB(1, 0), b3, voffB); PG8_STAGE(PG8_SB(1, 1), b3 + hstep, voffB); PG8_STAGE(PG8_SA(1, 0), a3, o2[0]);
            PG8_WAIT_V(8); PG8_WAIT_L(0); PG8_BAR; PG8_MMA(1, 0, At, B0); PG8_MMA(1, 1, At, B1); PG8_BAR; PG8_SCHED;
            } else {
            PG8_LDB(B0, 0, 0); PG8_SCHED; PG8_LDA(At, 0, 0); PG8_STAGE(PG8_SA(1, 1), a1 + hstep, voffA);
            PG8_WAIT_L(8); PG8_BAR; PG8_WAIT_L(0); PG8_MMA(0, 0, At, B0); PG8_BAR; PG8_SCHED;
            PG8_LDB(B1, 0, 1); PG8_STAGE(PG8_SB(0, 0), b2, voffB);
            PG8_BAR; PG8_WAIT_L(0); PG8_MMA(0, 1, At, B1); PG8_BAR;
            PG8_LDA(At, 0, 1); PG8_STAGE(PG8_SA(0, 0), a2, voffA);
            PG8_BAR; PG8_WAIT_L(0); PG8_MMA(1, 0, At, B0); PG8_BAR; PG8_SCHED;
            PG8_STAGE(PG8_SB(0, 1), b2 + hstep, voffB);
            PG8_WAIT_V(6); PG8_BAR; PG8_MMA(1, 1, At, B1); PG8_BAR;
            PG8_LDB(B0, 1, 0); PG8_SCHED; PG8_LDA(At, 1, 0); PG8_STAGE(PG8_SA(0, 1), a2 + hstep, voffA);
            PG8_WAIT_L(8); PG8_BAR; PG8_WAIT_L(0); PG8_MMA(0, 0, At, B0); PG8_BAR; PG8_SCHED;
            PG8_LDB(B1, 1, 1); PG8_STAGE(PG8_SB(1, 0), b3, voffB);
            PG8_BAR; PG8_WAIT_L(0); PG8_MMA(0, 1, At, B1); PG8_BAR;
            PG8_LDA(At, 1, 1); PG8_STAGE(PG8_SA(1, 0), a3, voffA);
            PG8_BAR; PG8_WAIT_L(0); PG8_MMA(1, 0, At, B0); PG8_BAR; PG8_SCHED;
            PG8_STAGE(PG8_SB(1, 1), b3 + hstep, voffB);
            PG8_WAIT_V(6); PG8_BAR; PG8_MMA(1, 1, At, B1); PG8_BAR;
            }
        }
        if constexpr (ALIGN_EPI) { if (wr == 0) PG8_BAR; }
        if constexpr (!Epi::AFTER_DRAIN) { E(acc, cur, wr, wc, fr, fq); S.done(cur); }
        if (!has_next) break;
#pragma unroll
        for (int a = 0; a < 2; ++a)
#pragma unroll
            for (int b = 0; b < 2; ++b)
#pragma unroll
                for (int m = 0; m < 4; ++m)
#pragma unroll
                    for (int n = 0; n < 2; ++n) acc[a][b][m][n] = (f32x4){0.f, 0.f, 0.f, 0.f};
        cur = nxt; cA = nA; cB = nB; ++ui; gc[0][0] = gn[0][0]; gc[0][1] = gn[0][1]; gc[1][0] = gn[1][0]; gc[1][1] = gn[1][1];
        if constexpr (ALIGN_EPI) { if (wr == 1) PG8_BAR; }
    }
    PG8_WAIT_V(0);
    if constexpr (!ALIGN_EPI) { if (wr == 0) PG8_BAR; }
    PG8_BAR;
    if constexpr (Epi::AFTER_DRAIN) { E.fused(acc, cur, wr, wc, fr, fq, lds, wid, lane); S.done(cur); }
#undef PG8_SA
#undef PG8_SB
#undef PG8_STAGE
#undef PG8_GLOAD
#undef PG8_ACUR
#undef PG8_LDA
#undef PG8_LDB
#undef PG8_MMA
#undef PG8_WAIT_V
#undef PG8_WAIT_L
#undef PG8_BAR
#undef PG8_SCHED
}
}

#ifndef PG8_SP2
#define PG8_SP2 true
#endif
#ifndef PG8_ALIGN
#define PG8_ALIGN true
#endif
#include <hip/hip_bf16.h>
#include <cmath>
namespace attn_body {
using bf16=__hip_bfloat16;
using bf16x8=__attribute__((ext_vector_type(8)))short;
using s16x4=__attribute__((ext_vector_type(4)))short;
using f32x16=__attribute__((ext_vector_type(16)))float;
using u32x4=__attribute__((ext_vector_type(4)))unsigned;
constexpr int D=64,PQ=2304,PO=1024,WIN=128;
constexpr int NW=8,QBLK=32,QB=QBLK*NW,KVBLK=64;
constexpr int ATTN_UNIT_ROWS=QB;
__device__ __forceinline__ int crow(int r,int hi){return (r&3)+8*(r>>2)+4*hi;}
#define SBAR() __builtin_amdgcn_sched_barrier(0)
template<int MODE> __device__ __forceinline__ void cmask(f32x16&p0,f32x16&p1,int jb,int qrel,int hi){
  const float NEG=-INFINITY; int kb=64*jb+4*hi;
  #pragma unroll
  for(int r=0;r<16;++r){int kv=kb+(r&3)+8*(r>>2);
    if(MODE==1){ if((unsigned)(qrel-kv)>=(unsigned)WIN)p0[r]=NEG; if((unsigned)(qrel-kv-32)>=(unsigned)WIN)p1[r]=NEG; }
    else { if(kv>qrel)p0[r]=NEG; if(kv+32>qrel)p1[r]=NEG; } }
}

constexpr int NSLOT=3, SLOTB=8192;
constexpr int LDS_K=0, LDS_V=NSLOT*SLOTB, LDS_WS=2*NSLOT*SLOTB, LDS_OST=LDS_WS+NW*64*4, LDS_BYTES=LDS_OST+NW*4096;
constexpr float C2=0.125f*1.4426950408889634f;
__device__ __forceinline__ void glds16(const void*gsrc,unsigned lds_dst){unsigned keep;
  asm volatile("s_mov_b32 %0, m0\n\ts_mov_b32 m0, %2\n\ts_nop 0\n\tglobal_load_lds_dwordx4 %1, off\n\ts_mov_b32 m0, %0":"=&s"(keep):"v"(gsrc),"s"(lds_dst):"memory");}
__device__ __forceinline__ float max3f(float a,float b,float c){float r;asm("v_max3_f32 %0, %1, %2, %3":"=v"(r):"v"(a),"v"(b),"v"(c));return r;}
__device__ __forceinline__ float max2f(float a,float b){float r;asm("v_max_f32_e32 %0, %1, %2":"=v"(r):"v"(a),"v"(b));return r;}
__device__ __forceinline__ float fadd_s(float a,float b){float r;asm("v_add_f32_e32 %0, %1, %2":"=v"(r):"v"(a),"v"(b));return r;}
__device__ __forceinline__ float fsub_s(float a,float b){float r;asm("v_sub_f32_e32 %0, %1, %2":"=v"(r):"v"(a),"v"(b));return r;}
typedef float f32x2_t __attribute__((ext_vector_type(2))); typedef __bf16 bf16x2_t __attribute__((ext_vector_type(2)));
__device__ __forceinline__ unsigned cvtpk_s(float lo,float hi){f32x2_t v={lo,hi};bf16x2_t b=__builtin_convertvector(v,bf16x2_t);return __builtin_bit_cast(unsigned,b);}
#define WAIT_BAR(N) asm volatile("s_waitcnt vmcnt(" #N ") lgkmcnt(0)\n\ts_barrier":::"memory")

__device__ __forceinline__ void qkt(f32x16&p0,f32x16&p1,const char*Kslot,const bf16x8*qr,const f32x16&negm,int r32,int hi){
  const char*kb=Kslot+hi*1024+r32*16;
  #pragma unroll
  for(int d0=0;d0<4;++d0){
    const bf16x8 b0=*reinterpret_cast<const bf16x8*>(kb+d0*2048);
    const bf16x8 b1=*reinterpret_cast<const bf16x8*>(kb+d0*2048+512);
    if(d0==0){p0=__builtin_amdgcn_mfma_f32_32x32x16_bf16(b0,qr[0],negm,0,0,0);p1=__builtin_amdgcn_mfma_f32_32x32x16_bf16(b1,qr[0],negm,0,0,0);}
    else{p0=__builtin_amdgcn_mfma_f32_32x32x16_bf16(b0,qr[d0],p0,0,0,0);p1=__builtin_amdgcn_mfma_f32_32x32x16_bf16(b1,qr[d0],p1,0,0,0);}}
}
typedef __attribute__((address_space(3))) const char* lds_cptr;
typedef short v4i16_t __attribute__((ext_vector_type(4)));
__device__ __forceinline__ void kload8(bf16x8*kf,lds_cptr kp){
  kf[0]=*(const __attribute__((address_space(3))) bf16x8*)(kp);      kf[1]=*(const __attribute__((address_space(3))) bf16x8*)(kp+512);
  kf[2]=*(const __attribute__((address_space(3))) bf16x8*)(kp+2048); kf[3]=*(const __attribute__((address_space(3))) bf16x8*)(kp+2560);
  kf[4]=*(const __attribute__((address_space(3))) bf16x8*)(kp+4096); kf[5]=*(const __attribute__((address_space(3))) bf16x8*)(kp+4608);
  kf[6]=*(const __attribute__((address_space(3))) bf16x8*)(kp+6144); kf[7]=*(const __attribute__((address_space(3))) bf16x8*)(kp+6656);
}
__device__ __forceinline__ void kload2(bf16x8*kf,lds_cptr kp,int j){ kf[2*j]=*(const __attribute__((address_space(3))) bf16x8*)(kp+j*2048); kf[2*j+1]=*(const __attribute__((address_space(3))) bf16x8*)(kp+j*2048+512); }
__device__ __forceinline__ s16x4 vtr(lds_cptr p){ return __builtin_bit_cast(s16x4,__builtin_amdgcn_ds_read_tr16_b64_v4i16((__attribute__((address_space(3))) v4i16_t*)p)); }
__device__ __forceinline__ float rowmax(const f32x16&p0,const f32x16&p1){
  float a=max3f(p0[0],p0[1],p1[0]),b=max3f(p0[2],p0[3],p1[1]);a=max3f(a,p1[2],p1[3]);
  #pragma unroll
  for(int r=4;r<16;r+=4){a=max3f(a,p0[r],p0[r+1]);b=max3f(b,p0[r+2],p0[r+3]);a=max3f(a,p1[r],p1[r+1]);b=max3f(b,p1[r+2],p1[r+3]);}
  const float m=max2f(a,b);
  auto rr=__builtin_amdgcn_permlane32_swap(__float_as_uint(m),__float_as_uint(m),false,false);
  return max2f(__uint_as_float(rr[0]),__uint_as_float(rr[1]));
}
__device__ __forceinline__ void pv(f32x16*o,int vb,bf16x8 pa0,bf16x8 pa1,bf16x8 pa2,bf16x8 pa3){
  #pragma unroll
  for(int d0=0;d0<2;++d0){s16x4 lo[4],hi[4];
    #pragma unroll
    for(int ks=0;ks<4;++ks){
      asm volatile("ds_read_b64_tr_b16 %0,%1 offset:%c2":"=&v"(lo[ks]):"v"(vb),"i"(d0*4096+ks*1024):"memory");
      asm volatile("ds_read_b64_tr_b16 %0,%1 offset:%c2":"=&v"(hi[ks]):"v"(vb),"i"(d0*4096+ks*1024+512):"memory");}
    asm volatile("s_waitcnt lgkmcnt(0)":::"memory");SBAR();
    #define PK(k) (bf16x8){lo[k][0],lo[k][1],lo[k][2],lo[k][3],hi[k][0],hi[k][1],hi[k][2],hi[k][3]}
    o[d0]=__builtin_amdgcn_mfma_f32_32x32x16_bf16(pa0,PK(0),o[d0],0,0,0);
    o[d0]=__builtin_amdgcn_mfma_f32_32x32x16_bf16(pa1,PK(1),o[d0],0,0,0);
    o[d0]=__builtin_amdgcn_mfma_f32_32x32x16_bf16(pa2,PK(2),o[d0],0,0,0);
    o[d0]=__builtin_amdgcn_mfma_f32_32x32x16_bf16(pa3,PK(3),o[d0],0,0,0);
    #undef PK
  }
}

#ifndef ATTN_STORE16
#define ATTN_STORE16(p,v) (*(u32x4*)(p)=(v))
#endif
template<int MODE,int THRL> __device__ __forceinline__ void attn_unit(const bf16*Qh,const bf16*__restrict__ Kh,const bf16*__restrict__ Vh,bf16*Oh,int q0,int kt0,const int NT,float sink2,char*shm){
  int tid_=threadIdx.x; asm volatile("":"+v"(tid_)); const int tid=tid_,lane=tid&63,r32=lane&31,hi=lane>>5; const int wid=__builtin_amdgcn_readfirstlane(tid>>6);
  const bf16*Qw=Qh+(long)(q0+wid*QBLK)*PQ;
  const unsigned lds0=(unsigned)(uintptr_t)shm;
  float*wsf=(float*)(shm+LDS_WS)+wid*64;
  const bf16*ksrc=Kh+(long)(kt0*KVBLK+lane)*PQ+wid*8;
  const bf16*vsrc=Vh+(long)(kt0*KVBLK+16*(wid&3)+(lane>>2))*PQ+(wid>>2)*32+(lane&3)*8;
  const unsigned kdst=lds0+LDS_K+wid*1024, vdst=lds0+LDS_V+wid*1024;
  #define DMA_K(t,slot) glds16(ksrc+(long)(t)*KVBLK*PQ,(unsigned)__builtin_amdgcn_readfirstlane(kdst+(slot)))
  #define DMA_V(t,slot) glds16(vsrc+(long)(t)*KVBLK*PQ,(unsigned)__builtin_amdgcn_readfirstlane(vdst+(slot)))
  const int vb0=(int)(lds0+LDS_V)+((lane>>4)&1)*32+(lane&3)*8+(4*hi+((lane&15)>>2))*64;
  const char*Kbase=shm+LDS_K; bf16x8 kf[8];
  const lds_cptr shm3=(lds_cptr)shm; const lds_cptr kp0=shm3+LDS_K+hi*1024+r32*16; const lds_cptr vp0=shm3+LDS_V+((lane>>4)&1)*32+(lane&3)*8+(4*hi+((lane&15)>>2))*64;
  DMA_K(0,0);DMA_V(0,0);DMA_K(1,SLOTB);
  bf16x8 qr[4];
  #pragma unroll
  for(int d0=0;d0<4;++d0)qr[d0]=*reinterpret_cast<const bf16x8*>(&Qw[(long)r32*PQ+d0*16+hi*8]);
  float mhat=0.f,l_reg=0.f;f32x16 o[2];o[0]=f32x16{};o[1]=f32x16{};f32x16 negm=f32x16{};asm volatile("":"+v"(negm));
  const int qrel=wid*QBLK+r32;
  #define CMASK(P0,P1,t) do{int jb_=(t)-(NT-4); if(MODE==1||jb_>=0)cmask<MODE>(P0,P1,jb_,qrel,hi);}while(0)
  bool resc=false;
  #define START(P0,P1) do{ const float rm=rowmax(P0,P1); resc=false; \
    { const float dl=(MODE==1)?__builtin_fmaxf(rm,-60.f):rm; mhat=fadd_s(mhat,dl); \
      _Pragma("unroll") for(int r=0;r<16;++r){P0[r]=fsub_s(P0[r],dl);P1[r]=fsub_s(P1[r],dl);} \
      _Pragma("unroll") for(int r=0;r<16;++r)negm[r]=-mhat; asm volatile("":"+v"(negm)); } \
    _Pragma("unroll") for(int r=0;r<16;++r)P0[r]=__builtin_amdgcn_exp2f(P0[r]); }while(0)
  #define RESC() do{ if(resc){ asm volatile("s_waitcnt lgkmcnt(0)":::"memory"); \
      _Pragma("unroll") for(int d_=0;d_<2;++d_) _Pragma("unroll") for(int r=0;r<16;++r)o[d_][r]*=wsf[crow(r,hi)]; } }while(0)
  f32x16 pA0,pA1,pB0,pB1;
  int sl_prev=0,sl_cur=0,sl_next=SLOTB;
  #define ROT() do{sl_prev=sl_cur;sl_cur=sl_next;sl_next=(sl_next==(NSLOT-1)*SLOTB)?0:sl_next+SLOTB;}while(0)
  DMA_K(2,2*SLOTB);
  WAIT_BAR(3);
  qkt(pA0,pA1,Kbase,qr,negm,r32,hi);asm volatile("s_nop 15\n\ts_nop 7":"+v"(pA0),"+v"(pA1));CMASK(pA0,pA1,0);
  START(pA0,pA1);
  _Pragma("unroll") for(int r=0;r<16;++r)pA1[r]=__builtin_amdgcn_exp2f(pA1[r]);
  WAIT_BAR(0);
  DMA_K(3,0);DMA_V(1,SLOTB);
  ROT();
  kload8(kf,kp0+sl_cur);
  WAIT_BAR(2);
  s16x4 vlo[8],vhi[8]; u32x4 pw0,pw1,pw2,pw3;
  #define PKW(P,B) cvtpk_s(P[B],P[B+1])
  #define PAF(k) __builtin_bit_cast(bf16x8,pw##k)
  #define VFR(i) (bf16x8){vlo[i][0],vlo[i][1],vlo[i][2],vlo[i][3],vhi[i][0],vhi[i][1],vhi[i][2],vhi[i][3]}
  #define PIN(x) asm volatile("":"+v"(x))
  #define MX3(a,b,c) __builtin_fmaxf(__builtin_fmaxf((a),(b)),(c))
  #define GAPA(MF,A0,A1,A2,A3,W0,W1,PW) do{ MF; sacc+=A0; sacc+=A1; sacc+=A2; sacc+=A3; PIN(sacc); W0; W1; PIN(PW); SBAR(); }while(0)
  #define EX(v) __builtin_amdgcn_exp2f(v)
  #define GAPB(MF,X,B) do{ MF; X[B]=EX(X[B]); X[B+1]=EX(X[B+1]); X[B+2]=EX(X[B+2]); X[B+3]=EX(X[B+3]); PIN(X); SBAR(); }while(0)
  #define VRD(i) do{ vlo[i]=vtr(vp_+(((i)>>2)*4096+((i)&3)*1024)); vhi[i]=vtr(vp_+(((i)>>2)*4096+((i)&3)*1024+512)); }while(0)
  #define KRD(G,j) do{ if(G){ kload2(kf,kp0+sl_next,j); SBAR(); } }while(0)
  #define STEP(C0,C1,P0,P1,t,GK,GV,GL) do{ SBAR(); \
    const lds_cptr vp_=vp0+sl_prev; \
    VRD(0); SBAR(); float sacc=(P0[0]+P0[1]); \
    GAPA(C0=__builtin_amdgcn_mfma_f32_32x32x16_bf16(kf[0],qr[0],negm,0,0,0), P0[2],P0[3],P0[4],P0[5],     pw0[0]=PKW(P0,0), pw0[1]=PKW(P0,2), pw0); \
    VRD(4); SBAR(); GAPA(C1=__builtin_amdgcn_mfma_f32_32x32x16_bf16(kf[1],qr[0],negm,0,0,0), P0[6],P0[7],P0[8],P0[9],     pw0[2]=PKW(P0,4), pw0[3]=PKW(P0,6), pw0); \
    VRD(1); SBAR(); GAPA(C0=__builtin_amdgcn_mfma_f32_32x32x16_bf16(kf[2],qr[1],C0,0,0,0),   P0[10],P0[11],P0[12],P0[13], pw1[0]=PKW(P0,8), pw1[1]=PKW(P0,10), pw1); \
    VRD(5); SBAR(); GAPA(C1=__builtin_amdgcn_mfma_f32_32x32x16_bf16(kf[3],qr[1],C1,0,0,0),   P0[14],P0[15],P1[0],P1[1],   pw1[2]=PKW(P0,12),pw1[3]=PKW(P0,14), pw1); \
    VRD(2); SBAR(); GAPA(C0=__builtin_amdgcn_mfma_f32_32x32x16_bf16(kf[4],qr[2],C0,0,0,0),   P1[2],P1[3],P1[4],P1[5],     pw2[0]=PKW(P1,0), pw2[1]=PKW(P1,2), pw2); \
    VRD(6); SBAR(); GAPA(C1=__builtin_amdgcn_mfma_f32_32x32x16_bf16(kf[5],qr[2],C1,0,0,0),   P1[6],P1[7],P1[8],P1[9],     pw2[2]=PKW(P1,4), pw2[3]=PKW(P1,6), pw2); \
    VRD(3); SBAR(); GAPA(C0=__builtin_amdgcn_mfma_f32_32x32x16_bf16(kf[6],qr[3],C0,0,0,0),   P1[10],P1[11],P1[12],P1[13], pw3[0]=PKW(P1,8), pw3[1]=PKW(P1,10), pw3); \
    VRD(7); SBAR(); GAPA(C1=__builtin_amdgcn_mfma_f32_32x32x16_bf16(kf[7],qr[3],C1,0,0,0),   P1[14],P1[15],0.f,0.f,       pw3[2]=PKW(P1,12),pw3[3]=PKW(P1,14), pw3); \
    l_reg+=sacc; \
    if(GK){DMA_K((t)+3,sl_cur);} if(GV){DMA_V((t)+1,sl_next);} \
    CMASK(C0,C1,t); \
    { float a=MX3(C0[0],C0[1],C1[0]),b=MX3(C0[2],C0[3],C1[1]); a=MX3(a,C1[2],C1[3]); \
      _Pragma("unroll") for(int r=4;r<16;r+=4){a=MX3(a,C0[r],C0[r+1]);b=MX3(b,C0[r+2],C0[r+3]);a=MX3(a,C1[r],C1[r+1]);b=MX3(b,C1[r+2],C1[r+3]);} \
      float rm=__builtin_fmaxf(a,b); { auto rr=__builtin_amdgcn_permlane32_swap(__float_as_uint(rm),__float_as_uint(rm),false,false); rm=__builtin_fmaxf(__uint_as_float(rr[0]),__uint_as_float(rr[1])); } \
      resc=false; \
      if(__builtin_expect(__any(rm>(float)THRL),0)){ const float dl=__builtin_fmaxf(rm,0.f); mhat+=dl; \
        _Pragma("unroll") for(int r=0;r<16;++r){C0[r]-=dl;C1[r]-=dl;} \
        _Pragma("unroll") for(int r=0;r<16;++r)negm[r]=-mhat; asm volatile("":"+v"(negm)); \
        const float f=__builtin_amdgcn_exp2f(-dl); l_reg*=f; if(hi==0)wsf[r32]=f; resc=true; } } \
    SBAR(); \
    GAPB(o[0]=__builtin_amdgcn_mfma_f32_32x32x16_bf16(PAF(0),VFR(0),o[0],0,0,0), C0,0); \
    GAPB(o[1]=__builtin_amdgcn_mfma_f32_32x32x16_bf16(PAF(0),VFR(4),o[1],0,0,0), C0,4); \
    KRD(GL,0); GAPB(o[0]=__builtin_amdgcn_mfma_f32_32x32x16_bf16(PAF(1),VFR(1),o[0],0,0,0), C0,8); \
    KRD(GL,1); GAPB(o[1]=__builtin_amdgcn_mfma_f32_32x32x16_bf16(PAF(1),VFR(5),o[1],0,0,0), C0,12); \
    KRD(GL,2); GAPB(o[0]=__builtin_amdgcn_mfma_f32_32x32x16_bf16(PAF(2),VFR(2),o[0],0,0,0), C1,0); \
    KRD(GL,3); GAPB(o[1]=__builtin_amdgcn_mfma_f32_32x32x16_bf16(PAF(2),VFR(6),o[1],0,0,0), C1,4); \
    GAPB(o[0]=__builtin_amdgcn_mfma_f32_32x32x16_bf16(PAF(3),VFR(3),o[0],0,0,0), C1,8); \
    GAPB(o[1]=__builtin_amdgcn_mfma_f32_32x32x16_bf16(PAF(3),VFR(7),o[1],0,0,0), C1,12); \
    }while(0)
  int t=1;
  #undef CMASK
  #define CMASK(P0,P1,t) do{}while(0)
  for(;t+5<NT;t+=2){
    STEP(pB0,pB1,pA0,pA1,t,true,true,true);     WAIT_BAR(2); RESC(); ROT();
    STEP(pA0,pA1,pB0,pB1,t+1,true,true,true);   WAIT_BAR(2); RESC(); ROT();
  }
  #undef CMASK
  #define CMASK(P0,P1,t) do{int jb_=(t)-(NT-4); if(MODE==1||jb_>=0)cmask<MODE>(P0,P1,jb_,qrel,hi);}while(0)
  #define ENDW(tt) do{ if((tt)+3<NT){WAIT_BAR(2);} else if((tt)+2<NT){WAIT_BAR(1);} else {WAIT_BAR(0);} }while(0)
  for(;t+1<NT;t+=2){
    STEP(pB0,pB1,pA0,pA1,t,(t+3<NT),(t+1<NT),(t+1<NT));       ENDW(t);   RESC(); ROT();
    STEP(pA0,pA1,pB0,pB1,t+1,(t+4<NT),(t+2<NT),(t+2<NT));     ENDW(t+1); RESC(); ROT();
  }
  STEP(pB0,pB1,pA0,pA1,NT-1,false,false,false); RESC();
  { float sacc=pB0[0]+pB0[1]; _Pragma("unroll") for(int r=2;r<16;++r)sacc+=pB0[r]; _Pragma("unroll") for(int r=0;r<16;++r)sacc+=pB1[r]; l_reg+=sacc;
    pw0=(u32x4){PKW(pB0,0),PKW(pB0,2),PKW(pB0,4),PKW(pB0,6)};pw1=(u32x4){PKW(pB0,8),PKW(pB0,10),PKW(pB0,12),PKW(pB0,14)};pw2=(u32x4){PKW(pB1,0),PKW(pB1,2),PKW(pB1,4),PKW(pB1,6)};pw3=(u32x4){PKW(pB1,8),PKW(pB1,10),PKW(pB1,12),PKW(pB1,14)};
    SBAR(); pv(o,vb0+sl_cur,PAF(0),PAF(1),PAF(2),PAF(3)); }
  #undef PKW
  #undef PAF
  #undef VFR
  #undef PIN
  #undef MX3
  #undef GAPA
  #undef GAPB
  #undef EX
  #undef VRD
  #undef KRD
  #undef STEP
  #undef ENDW
  {auto rr=__builtin_amdgcn_permlane32_swap(__float_as_uint(l_reg),__float_as_uint(l_reg),false,false);l_reg=__uint_as_float(rr[0])+__uint_as_float(rr[1]);}
  if(MODE==1)l_reg+=__builtin_amdgcn_exp2f(sink2-mhat);
  if(hi==0)wsf[32+r32]=l_reg;asm volatile("s_waitcnt lgkmcnt(0)":::"memory");
  float rli[16];
  #pragma unroll
  for(int r=0;r<16;++r)rli[r]=__builtin_amdgcn_rcpf(wsf[32+crow(r,hi)]);
  bf16*Ow=Oh+(long)(q0+wid*QBLK)*PO;
  { bf16*stg=(bf16*)(shm+LDS_OST)+wid*2048;
    #pragma unroll
    for(int r=0;r<16;++r){const int orow=crow(r,hi);
      #pragma unroll
      for(int d0=0;d0<2;++d0)stg[orow*64+d0*32+r32]=__float2bfloat16(o[d0][r]*rli[r]);}
    asm volatile("s_waitcnt lgkmcnt(0)":::"memory");
    #pragma unroll
    for(int i=0;i<4;++i){const int row=i*8+(lane>>3),ch=lane&7; const u32x4 v=*(const u32x4*)(stg+row*64+ch*8); ATTN_STORE16(Ow+(long)row*PO+ch*8,v);} }
  asm volatile("s_waitcnt lgkmcnt(0)\n\ts_barrier":::"memory");
  #undef DMA_K
  #undef DMA_V
  #undef CMASK
  #undef START
  #undef RESC
  #undef ROT
}
constexpr int ATTN_LDS_BYTES=LDS_BYTES;

constexpr int SW_K=0, SW_V=6*8192, SW_WS=12*8192, SW_ST=SW_WS+2048, SWA_LDS_BYTES=SW_ST+NW*2048;
template<int ABL=0> __device__ __forceinline__ void swa_unit(const bf16*Qb,const bf16*__restrict__ Kh,const bf16*__restrict__ Vh,bf16*Ob,const unsigned*kmx,int q0,const float*sink2v,char*shm){
  int tid_=threadIdx.x; asm volatile("":"+v"(tid_)); const int tid=tid_,lane=tid&63,r32=lane&31,hi=lane>>5; const int wid=__builtin_amdgcn_readfirstlane(tid>>6);
  const unsigned lds0=(unsigned)(uintptr_t)shm;
  const int nt=(q0==0)?4:6, kt0=q0/KVBLK-(nt-4);
  const bf16*ksrc=Kh+(long)(kt0*KVBLK+lane)*PQ+wid*8;
  const bf16*vsrc=Vh+(long)(kt0*KVBLK+16*(wid&3)+(lane>>2))*PQ+(wid>>2)*32+(lane&3)*8;
  for(int ti=0;ti<nt;++ti){
    glds16(ksrc+(long)ti*KVBLK*PQ,(unsigned)__builtin_amdgcn_readfirstlane(lds0+SW_K+ti*8192+wid*1024));
    glds16(vsrc+(long)ti*KVBLK*PQ,(unsigned)__builtin_amdgcn_readfirstlane(lds0+SW_V+ti*8192+wid*1024)); }
  const bf16*Qw=Qb+(long)(q0+wid*QBLK+r32)*PQ+hi*8;
  bf16x8 qa[4],qb[4];
  #pragma unroll
  for(int d0=0;d0<4;++d0){qa[d0]=*reinterpret_cast<const bf16x8*>(Qw+d0*16);qb[d0]=*reinterpret_cast<const bf16x8*>(Qw+D+d0*16);}
  float kb2=0.f;
  #pragma unroll
  for(int g_=0;g_<8;++g_)kb2+=__uint_as_float(kmx[g_]);
  asm volatile("s_waitcnt vmcnt(0) lgkmcnt(0)\n\ts_barrier":::"memory");
  float*wsf=(float*)(shm+SW_WS)+wid*64;
  const u32x4 a1w=(u32x4){hi==0?0x3F803F80u:0u,0u,0u,0u};
  const int kb0=8*(q0>>8)+wid-4;
  const lds_cptr shm3=(lds_cptr)shm;
  const lds_cptr kpl=shm3+SW_K+hi*1024+r32*16;
  const lds_cptr vpl=shm3+SW_V+((lane>>4)&1)*32+(lane&3)*8+(4*hi+((lane&15)>>2))*64;
  #pragma unroll
  for(int g=0;g<4;g+=2){
    float mA,mB; f32x16 cbA,cbB;
    { float qsA=0.f,qsB=0.f;
      #pragma unroll
      for(int d0=0;d0<4;++d0){ const u32x4 va=__builtin_bit_cast(u32x4,qa[d0]),vb_=__builtin_bit_cast(u32x4,qb[d0]);
        #pragma unroll
        for(int e_=0;e_<4;++e_){ const float a_=__uint_as_float(va[e_]<<16),c_=__uint_as_float(va[e_]&0xffff0000u),d_=__uint_as_float(vb_[e_]<<16),f_=__uint_as_float(vb_[e_]&0xffff0000u); qsA+=a_*a_+c_*c_; qsB+=d_*d_+f_*f_; } }
      { auto rr=__builtin_amdgcn_permlane32_swap(__float_as_uint(qsA),__float_as_uint(qsA),false,false); qsA=__uint_as_float(rr[0])+__uint_as_float(rr[1]); }
      { auto rr=__builtin_amdgcn_permlane32_swap(__float_as_uint(qsB),__float_as_uint(qsB),false,false); qsB=__uint_as_float(rr[0])+__uint_as_float(rr[1]); }
      mA=sqrtf(qsA*kb2)*1.01f+1e-3f-64.f; mB=sqrtf(qsB*kb2)*1.01f+1e-3f-64.f;
      u32x4 bw=(u32x4){0u,0u,0u,0u};
      { const float nm_=-mA; const unsigned h_=cvtpk_s(nm_,0.f)&0xffffu; const float r_=nm_-__uint_as_float(h_<<16); const unsigned l_=cvtpk_s(r_,0.f)&0xffffu; bw[0]=(hi==0)?(h_|(l_<<16)):0u; }
      cbA=__builtin_amdgcn_mfma_f32_32x32x16_bf16(__builtin_bit_cast(bf16x8,a1w),__builtin_bit_cast(bf16x8,bw),f32x16{},0,0,0);
      { const float nm_=-mB; const unsigned h_=cvtpk_s(nm_,0.f)&0xffffu; const float r_=nm_-__uint_as_float(h_<<16); const unsigned l_=cvtpk_s(r_,0.f)&0xffffu; bw[0]=(hi==0)?(h_|(l_<<16)):0u; }
      cbB=__builtin_amdgcn_mfma_f32_32x32x16_bf16(__builtin_bit_cast(bf16x8,a1w),__builtin_bit_cast(bf16x8,bw),f32x16{},0,0,0); }
    float lA=0.f,lB=0.f; f32x16 oA[2],oB[2]; oA[0]=f32x16{};oA[1]=f32x16{};oB[0]=f32x16{};oB[1]=f32x16{};
    for(int j=0;j<5;++j){ const int kb=kb0+j; if(kb<0)continue; if(ABL==1)continue;
      const int ti=(kb>>1)-kt0, half=kb&1;
      f32x16 sA=cbA,sB=cbB;
      { const lds_cptr kp=kpl+ti*8192+half*512;
        #pragma unroll
        for(int d0=0;d0<4;++d0){ const bf16x8 kf=*(const __attribute__((address_space(3))) bf16x8*)(kp+d0*2048);
          sA=__builtin_amdgcn_mfma_f32_32x32x16_bf16(kf,qa[d0],sA,0,0,0); sB=__builtin_amdgcn_mfma_f32_32x32x16_bf16(kf,qb[d0],sB,0,0,0); } }
      if(j==0){
        #pragma unroll
        for(int r=0;r<16;++r){ const int i_=(r&3)+8*(r>>2)+4*hi; if(i_<=r32){sA[r]=-INFINITY;sB[r]=-INFINITY;} } }
      if(j==4){
        #pragma unroll
        for(int r=0;r<16;++r){ const int i_=(r&3)+8*(r>>2)+4*hi; if(i_>r32){sA[r]=-INFINITY;sB[r]=-INFINITY;} } }
      #pragma unroll
      for(int r=0;r<16;++r){ sA[r]=__builtin_amdgcn_exp2f(sA[r]); sB[r]=__builtin_amdgcn_exp2f(sB[r]); lA+=sA[r]; lB+=sB[r]; }
      u32x4 pa[2],pb[2];
      #pragma unroll
      for(int k=0;k<2;++k){
        pa[k]=(u32x4){cvtpk_s(sA[8*k],sA[8*k+1]),cvtpk_s(sA[8*k+2],sA[8*k+3]),cvtpk_s(sA[8*k+4],sA[8*k+5]),cvtpk_s(sA[8*k+6],sA[8*k+7])};
        pb[k]=(u32x4){cvtpk_s(sB[8*k],sB[8*k+1]),cvtpk_s(sB[8*k+2],sB[8*k+3]),cvtpk_s(sB[8*k+4],sB[8*k+5]),cvtpk_s(sB[8*k+6],sB[8*k+7])}; }
      { const lds_cptr vp=vpl+ti*8192+half*2048;
        #pragma unroll
        for(int d0=0;d0<2;++d0)
          #pragma unroll
          for(int k=0;k<2;++k){ const s16x4 lo=vtr(vp+d0*4096+k*1024), hh=vtr(vp+d0*4096+k*1024+512);
            const bf16x8 vf=(bf16x8){lo[0],lo[1],lo[2],lo[3],hh[0],hh[1],hh[2],hh[3]};
            oA[d0]=__builtin_amdgcn_mfma_f32_32x32x16_bf16(__builtin_bit_cast(bf16x8,pa[k]),vf,oA[d0],0,0,0);
            oB[d0]=__builtin_amdgcn_mfma_f32_32x32x16_bf16(__builtin_bit_cast(bf16x8,pb[k]),vf,oB[d0],0,0,0); } }
    }
    if(g==0){
      #pragma unroll
      for(int d0=0;d0<4;++d0){qa[d0]=*reinterpret_cast<const bf16x8*>(Qw+2*D+d0*16);qb[d0]=*reinterpret_cast<const bf16x8*>(Qw+3*D+d0*16);} }
    #pragma unroll
    for(int hsel=0;hsel<2;++hsel){
      float l=hsel?lB:lA; const float m=hsel?mB:mA; const f32x16*o=hsel?oB:oA;
      {auto rr=__builtin_amdgcn_permlane32_swap(__float_as_uint(l),__float_as_uint(l),false,false);l=__uint_as_float(rr[0])+__uint_as_float(rr[1]);}
      l+=__builtin_amdgcn_exp2f(sink2v[g+hsel]-m);
      if(hi==0)wsf[32+r32]=l; asm volatile("s_waitcnt lgkmcnt(0)":::"memory");
      float rli[16];
      #pragma unroll
      for(int r=0;r<16;++r)rli[r]=__builtin_amdgcn_rcpf(wsf[32+crow(r,hi)]);
      bf16*Ow=Ob+(long)(q0+wid*QBLK)*PO+(g+hsel)*D;
      bf16*stg=(bf16*)(shm+SW_ST)+wid*1024;
      #pragma unroll
      for(int d0=0;d0<2;++d0){
        #pragma unroll
        for(int r=0;r<16;++r)stg[crow(r,hi)*32+r32]=__float2bfloat16(o[d0][r]*rli[r]);
        asm volatile("s_waitcnt lgkmcnt(0)":::"memory");
        #pragma unroll
        for(int i=0;i<2;++i){const int row=i*16+(lane>>2),ch=lane&3; const u32x4 v=*(const u32x4*)(stg+row*32+ch*8); ATTN_STORE16(Ow+(long)row*PO+d0*32+ch*8,v);}
        asm volatile("s_waitcnt lgkmcnt(0)":::"memory");
      }
    }
  }
  asm volatile("s_waitcnt lgkmcnt(0)\n\ts_barrier":::"memory");
}

constexpr int W_SLK=8192, W_SLV=16384, W_LDS_K=0, W_LDS_V=NSLOT*W_SLK, W_LDS_WS=W_LDS_V+NSLOT*W_SLV, W_LDS_OST=W_LDS_WS+NW*64*4, W_LDS_BYTES=W_LDS_OST+NW*4096;
template<int THRL> __device__ __forceinline__ void attn_unit_w(const bf16*Qh,const bf16*__restrict__ Kh,const bf16*__restrict__ Vh,bf16*Oh,const unsigned*kmx,int q0,const int NT,char*shm){
  int tid_=threadIdx.x; asm volatile("":"+v"(tid_)); const int tid=tid_,lane=tid&63,r32=lane&31,hi=lane>>5; const int wid=__builtin_amdgcn_readfirstlane(tid>>6);
  const bf16*Qw=Qh+(long)(q0+wid*QBLK)*PQ;
  const unsigned lds0=(unsigned)(uintptr_t)shm;
  float*wsf=(float*)(shm+W_LDS_WS)+wid*64;
  const bf16*ksrc=Kh+(long)lane*PQ+wid*8;
  const bf16*vsrc=Vh+(long)(16*(wid&3)+(lane>>2))*PQ+(wid>>2)*32+(lane&3)*8;
  const unsigned kdst=lds0+W_LDS_K+wid*1024, vdst=lds0+W_LDS_V+wid*1024;
  #define DMA_K(t,slot) glds16(ksrc+(long)(t)*KVBLK*PQ,(unsigned)__builtin_amdgcn_readfirstlane(kdst+(slot)))
  #define DMA_V(t,slot) do{ glds16(vsrc+(long)(t)*KVBLK*PQ,(unsigned)__builtin_amdgcn_readfirstlane(vdst+2*(slot))); glds16(vsrc+64+(long)(t)*KVBLK*PQ,(unsigned)__builtin_amdgcn_readfirstlane(vdst+2*(slot)+8192)); }while(0)
  const char*Kbase=shm+W_LDS_K; bf16x8 kf[8];
  const lds_cptr shm3=(lds_cptr)shm; const lds_cptr kp0=shm3+W_LDS_K+hi*1024+r32*16; const lds_cptr vp0=shm3+W_LDS_V+((lane>>4)&1)*32+(lane&3)*8+(4*hi+((lane&15)>>2))*64;
  const int vb0=(int)(lds0+W_LDS_V)+((lane>>4)&1)*32+(lane&3)*8+(4*hi+((lane&15)>>2))*64;
  DMA_K(0,0);DMA_V(0,0);DMA_K(1,W_SLK);
  bf16x8 qr[4];
  #pragma unroll
  for(int d0=0;d0<4;++d0)qr[d0]=*reinterpret_cast<const bf16x8*>(&Qw[(long)r32*PQ+d0*16+hi*8]);
  float mhat=0.f,l_reg=0.f;f32x16 o[4];o[0]=f32x16{};o[1]=f32x16{};o[2]=f32x16{};o[3]=f32x16{};const f32x16 zacc=f32x16{};
  const u32x4 a1w=(u32x4){hi==0?0x3F803F80u:0u,0u,0u,0u}; u32x4 bmw=(u32x4){0u,0u,0u,0u}; f32x16 cb;
  #define SETBM() do{ const float nm_=-mhat; const unsigned h_=cvtpk_s(nm_,0.f)&0xffffu; const float r_=nm_-__uint_as_float(h_<<16); const unsigned l_=cvtpk_s(r_,0.f)&0xffffu; bmw[0]=(hi==0)?(h_|(l_<<16)):0u; }while(0)
  #define BIASMF() __builtin_amdgcn_mfma_f32_32x32x16_bf16(__builtin_bit_cast(bf16x8,a1w),__builtin_bit_cast(bf16x8,bmw),zacc,0,0,0)
  const int qrel=wid*QBLK+r32;
  { float kb2=0.f; _Pragma("unroll") for(int g=0;g<8;++g)kb2+=__uint_as_float(kmx[g]);
    float qs=0.f; _Pragma("unroll") for(int d0=0;d0<4;++d0){ const u32x4 qv=__builtin_bit_cast(u32x4,qr[d0]); _Pragma("unroll") for(int e_=0;e_<4;++e_){ const float a_=__uint_as_float(qv[e_]<<16),b_=__uint_as_float(qv[e_]&0xffff0000u); qs+=a_*a_+b_*b_; } }
    { auto rr=__builtin_amdgcn_permlane32_swap(__float_as_uint(qs),__float_as_uint(qs),false,false); qs=__uint_as_float(rr[0])+__uint_as_float(rr[1]); }
    mhat=sqrtf(qs*kb2)*1.01f+1e-3f-64.f; }
  SETBM(); cb=BIASMF();
  #define CMASK(P0,P1,t) do{int jb_=(t)-(NT-4); if(jb_>=0)cmask<0>(P0,P1,jb_,qrel,hi);}while(0)
  #define START(P0,P1) do{ _Pragma("unroll") for(int r=0;r<16;++r)P0[r]=__builtin_amdgcn_exp2f(P0[r]); }while(0)
  f32x16 pA0,pA1,pB0,pB1;
  int sl_prev=0,sl_cur=0,sl_next=W_SLK;
  #define ROT() do{sl_prev=sl_cur;sl_cur=sl_next;sl_next=(sl_next==(NSLOT-1)*W_SLK)?0:sl_next+W_SLK;}while(0)
  DMA_K(2,2*W_SLK);
  WAIT_BAR(4);
  qkt(pA0,pA1,Kbase,qr,cb,r32,hi);asm volatile("s_nop 15\n\ts_nop 7":"+v"(pA0),"+v"(pA1));CMASK(pA0,pA1,0);
  START(pA0,pA1);
  _Pragma("unroll") for(int r=0;r<16;++r)pA1[r]=__builtin_amdgcn_exp2f(pA1[r]);
  WAIT_BAR(0);
  DMA_K(3,0);DMA_V(1,W_SLK);
  ROT();
  kload8(kf,kp0+sl_cur);
  WAIT_BAR(3);
  s16x4 vlo[4],vhi[4]; u32x4 pw0,pw1,pw2,pw3;
  #define PKW(P,B) cvtpk_s(P[B],P[B+1])
  #define PAF(k) __builtin_bit_cast(bf16x8,pw##k)
  #define VFR(i) (bf16x8){vlo[i][0],vlo[i][1],vlo[i][2],vlo[i][3],vhi[i][0],vhi[i][1],vhi[i][2],vhi[i][3]}
  #define PIN(x) asm volatile("":"+v"(x))
  #define MX3(a,b,c) __builtin_fmaxf(__builtin_fmaxf((a),(b)),(c))
  #define GAPA(MF,A0,A1,A2,A3,W0,W1,PW) do{ MF; sacc+=A0; sacc+=A1; sacc+=A2; sacc+=A3; PIN(sacc); W0; W1; PIN(PW); SBAR(); }while(0)
  #define EX(v) __builtin_amdgcn_exp2f(v)
  #define GAPB(MF,X,B) do{ MF; X[B]=EX(X[B]); X[B+1]=EX(X[B+1]); PIN(X); SBAR(); }while(0)
  #define VRD(j) do{ vlo[(j)&3]=vtr(vp_+(((j)&3)*4096+((j)>>2)*1024)); vhi[(j)&3]=vtr(vp_+(((j)&3)*4096+((j)>>2)*1024+512)); SBAR(); }while(0)
  #define KRD(G,j) do{ if(G){ kload2(kf,kp0+sl_next,j); SBAR(); } }while(0)
  #define STEP(C0,C1,P0,P1,t,GK,GV,GL) do{ SBAR(); \
    const lds_cptr vp_=vp0+2*sl_prev; \
    float sacc=(P0[0]+P0[1]); \
    GAPA(C0=__builtin_amdgcn_mfma_f32_32x32x16_bf16(kf[0],qr[0],cb,0,0,0), P0[2],P0[3],P0[4],P0[5],     pw0[0]=PKW(P0,0), pw0[1]=PKW(P0,2), pw0); \
    GAPA(C1=__builtin_amdgcn_mfma_f32_32x32x16_bf16(kf[1],qr[0],cb,0,0,0), P0[6],P0[7],P0[8],P0[9],     pw0[2]=PKW(P0,4), pw0[3]=PKW(P0,6), pw0); \
    GAPA(C0=__builtin_amdgcn_mfma_f32_32x32x16_bf16(kf[2],qr[1],C0,0,0,0),   P0[10],P0[11],P0[12],P0[13], pw1[0]=PKW(P0,8), pw1[1]=PKW(P0,10), pw1); \
    GAPA(C1=__builtin_amdgcn_mfma_f32_32x32x16_bf16(kf[3],qr[1],C1,0,0,0),   P0[14],P0[15],P1[0],P1[1],   pw1[2]=PKW(P0,12),pw1[3]=PKW(P0,14), pw1); \
    GAPA(C0=__builtin_amdgcn_mfma_f32_32x32x16_bf16(kf[4],qr[2],C0,0,0,0),   P1[2],P1[3],P1[4],P1[5],     pw2[0]=PKW(P1,0), pw2[1]=PKW(P1,2), pw2); \
    VRD(0); GAPA(C1=__builtin_amdgcn_mfma_f32_32x32x16_bf16(kf[5],qr[2],C1,0,0,0),   P1[6],P1[7],P1[8],P1[9],     pw2[2]=PKW(P1,4), pw2[3]=PKW(P1,6), pw2); \
    VRD(1); GAPA(C0=__builtin_amdgcn_mfma_f32_32x32x16_bf16(kf[6],qr[3],C0,0,0,0),   P1[10],P1[11],P1[12],P1[13], pw3[0]=PKW(P1,8), pw3[1]=PKW(P1,10), pw3); \
    VRD(2); GAPA(C1=__builtin_amdgcn_mfma_f32_32x32x16_bf16(kf[7],qr[3],C1,0,0,0),   P1[14],P1[15],0.f,0.f,       pw3[2]=PKW(P1,12),pw3[3]=PKW(P1,14), pw3); \
    l_reg+=sacc; \
    if(GK){DMA_K((t)+3,sl_cur);} if(GV){DMA_V((t)+1,sl_next);} \
    CMASK(C0,C1,t); \
    SBAR(); \
    VRD(3); do{ o[0]=__builtin_amdgcn_mfma_f32_32x32x16_bf16(PAF(0),VFR(0),o[0],0,0,0); C0[0]=EX(C0[0]); C0[1]=EX(C0[1]); PIN(C0); SBAR(); }while(0); \
    VRD(4); do{ o[1]=__builtin_amdgcn_mfma_f32_32x32x16_bf16(PAF(0),VFR(1),o[1],0,0,0); C0[2]=EX(C0[2]); C0[3]=EX(C0[3]); PIN(C0); SBAR(); }while(0); \
    VRD(5); do{ o[2]=__builtin_amdgcn_mfma_f32_32x32x16_bf16(PAF(0),VFR(2),o[2],0,0,0); C0[4]=EX(C0[4]); C0[5]=EX(C0[5]); PIN(C0); SBAR(); }while(0); \
    VRD(6); do{ o[3]=__builtin_amdgcn_mfma_f32_32x32x16_bf16(PAF(0),VFR(3),o[3],0,0,0); C0[6]=EX(C0[6]); C0[7]=EX(C0[7]); PIN(C0); SBAR(); }while(0); \
    VRD(7); do{ o[0]=__builtin_amdgcn_mfma_f32_32x32x16_bf16(PAF(1),VFR(0),o[0],0,0,0); C0[8]=EX(C0[8]); C0[9]=EX(C0[9]); PIN(C0); SBAR(); }while(0); \
    VRD(8); do{ o[1]=__builtin_amdgcn_mfma_f32_32x32x16_bf16(PAF(1),VFR(1),o[1],0,0,0); C0[10]=EX(C0[10]); C0[11]=EX(C0[11]); PIN(C0); SBAR(); }while(0); \
    VRD(9); do{ o[2]=__builtin_amdgcn_mfma_f32_32x32x16_bf16(PAF(1),VFR(2),o[2],0,0,0); C0[12]=EX(C0[12]); C0[13]=EX(C0[13]); PIN(C0); SBAR(); }while(0); \
    VRD(10); do{ o[3]=__builtin_amdgcn_mfma_f32_32x32x16_bf16(PAF(1),VFR(3),o[3],0,0,0); C0[14]=EX(C0[14]); C0[15]=EX(C0[15]); PIN(C0); SBAR(); }while(0); \
    VRD(11); KRD(GL,0); do{ o[0]=__builtin_amdgcn_mfma_f32_32x32x16_bf16(PAF(2),VFR(0),o[0],0,0,0); C1[0]=EX(C1[0]); C1[1]=EX(C1[1]); PIN(C1); SBAR(); }while(0); \
    VRD(12); do{ o[1]=__builtin_amdgcn_mfma_f32_32x32x16_bf16(PAF(2),VFR(1),o[1],0,0,0); C1[2]=EX(C1[2]); C1[3]=EX(C1[3]); PIN(C1); SBAR(); }while(0); \
    VRD(13); KRD(GL,1); do{ o[2]=__builtin_amdgcn_mfma_f32_32x32x16_bf16(PAF(2),VFR(2),o[2],0,0,0); C1[4]=EX(C1[4]); C1[5]=EX(C1[5]); PIN(C1); SBAR(); }while(0); \
    VRD(14); do{ o[3]=__builtin_amdgcn_mfma_f32_32x32x16_bf16(PAF(2),VFR(3),o[3],0,0,0); C1[6]=EX(C1[6]); C1[7]=EX(C1[7]); PIN(C1); SBAR(); }while(0); \
    VRD(15); KRD(GL,2); do{ o[0]=__builtin_amdgcn_mfma_f32_32x32x16_bf16(PAF(3),VFR(0),o[0],0,0,0); C1[8]=EX(C1[8]); C1[9]=EX(C1[9]); PIN(C1); SBAR(); }while(0); \
    do{ o[1]=__builtin_amdgcn_mfma_f32_32x32x16_bf16(PAF(3),VFR(1),o[1],0,0,0); C1[10]=EX(C1[10]); C1[11]=EX(C1[11]); PIN(C1); SBAR(); }while(0); \
    KRD(GL,3); do{ o[2]=__builtin_amdgcn_mfma_f32_32x32x16_bf16(PAF(3),VFR(2),o[2],0,0,0); C1[12]=EX(C1[12]); C1[13]=EX(C1[13]); PIN(C1); SBAR(); }while(0); \
    do{ o[3]=__builtin_amdgcn_mfma_f32_32x32x16_bf16(PAF(3),VFR(3),o[3],0,0,0); C1[14]=EX(C1[14]); C1[15]=EX(C1[15]); PIN(C1); SBAR(); }while(0); \
    }while(0)
  int t=1;
  #undef CMASK
  #define CMASK(P0,P1,t) do{}while(0)
  for(;t+5<NT;t+=2){
    STEP(pB0,pB1,pA0,pA1,t,true,true,true);     WAIT_BAR(3); ROT();
    STEP(pA0,pA1,pB0,pB1,t+1,true,true,true);   WAIT_BAR(3); ROT();
  }
  #undef CMASK
  #define CMASK(P0,P1,t) do{int jb_=(t)-(NT-4); if(jb_>=0)cmask<0>(P0,P1,jb_,qrel,hi);}while(0)
  #define ENDW(tt) do{ if((tt)+3<NT){WAIT_BAR(3);} else if((tt)+2<NT){WAIT_BAR(2);} else {WAIT_BAR(0);} }while(0)
  for(;t+1<NT;t+=2){
    STEP(pB0,pB1,pA0,pA1,t,(t+3<NT),(t+1<NT),(t+1<NT));       ENDW(t);   ROT();
    STEP(pA0,pA1,pB0,pB1,t+1,(t+4<NT),(t+2<NT),(t+2<NT));     ENDW(t+1); ROT();
  }
  STEP(pB0,pB1,pA0,pA1,NT-1,false,false,false);
  { float sacc=pB0[0]+pB0[1]; _Pragma("unroll") for(int r=2;r<16;++r)sacc+=pB0[r]; _Pragma("unroll") for(int r=0;r<16;++r)sacc+=pB1[r]; l_reg+=sacc;
    pw0=(u32x4){PKW(pB0,0),PKW(pB0,2),PKW(pB0,4),PKW(pB0,6)};pw1=(u32x4){PKW(pB0,8),PKW(pB0,10),PKW(pB0,12),PKW(pB0,14)};pw2=(u32x4){PKW(pB1,0),PKW(pB1,2),PKW(pB1,4),PKW(pB1,6)};pw3=(u32x4){PKW(pB1,8),PKW(pB1,10),PKW(pB1,12),PKW(pB1,14)};
    SBAR(); pv(o,vb0+2*sl_cur,PAF(0),PAF(1),PAF(2),PAF(3)); pv(o+2,vb0+2*sl_cur+8192,PAF(0),PAF(1),PAF(2),PAF(3)); }
  #undef PKW
  #undef PAF
  #undef VFR
  #undef PIN
  #undef MX3
  #undef GAPA
  #undef GAPB
  #undef EX
  #undef VRD
  #undef KRD
  #undef STEP
  #undef ENDW
  {auto rr=__builtin_amdgcn_permlane32_swap(__float_as_uint(l_reg),__float_as_uint(l_reg),false,false);l_reg=__uint_as_float(rr[0])+__uint_as_float(rr[1]);}
  if(hi==0)wsf[32+r32]=l_reg;asm volatile("s_waitcnt lgkmcnt(0)":::"memory");
  float rli[16];
  #pragma unroll
  for(int r=0;r<16;++r)rli[r]=__builtin_amdgcn_rcpf(wsf[32+crow(r,hi)]);
  bf16*Ow=Oh+(long)(q0+wid*QBLK)*PO;
  { bf16*stg=(bf16*)(shm+W_LDS_OST)+wid*2048;
    #pragma unroll
    for(int hf=0;hf<2;++hf){
      #pragma unroll
      for(int r=0;r<16;++r){const int orow=crow(r,hi);
        #pragma unroll
        for(int d0=0;d0<2;++d0)stg[orow*64+d0*32+r32]=__float2bfloat16(o[2*hf+d0][r]*rli[r]);}
      asm volatile("s_waitcnt lgkmcnt(0)":::"memory");
      #pragma unroll
      for(int i=0;i<4;++i){const int row=i*8+(lane>>3),ch=lane&7; const u32x4 v=*(const u32x4*)(stg+row*64+ch*8); ATTN_STORE16(Ow+(long)row*PO+hf*64+ch*8,v);}
      asm volatile("s_waitcnt lgkmcnt(0)":::"memory");
    } }
  asm volatile("s_waitcnt lgkmcnt(0)\n\ts_barrier":::"memory");
  #undef DMA_K
  #undef DMA_V
  #undef CMASK
  #undef START
  #undef ROT
  #undef SETBM
  #undef BIASMF
}
#undef SBAR
#undef WAIT_BAR
}
constexpr int NWAVES = 8;
constexpr int BATCH = 2, SEQ = 16384, D = 1024, T = BATCH * SEQ;
constexpr int IN_COLS = 2304, NEXP = 32, FF = 512, NASSIGN = 2 * T, NCHUNK = 256, CHUNK_TOK = T / NCHUNK;
constexpr int PSLOTS = (NASSIGN / 256 + NEXP) * 256;
constexpr int NBLK_MAX = PSLOTS / 256;
constexpr float RMS_EPS = 1e-6f;
static_assert(CHUNK_TOK == 128 && SEQ == pg8::SEQ_LEN && IN_COLS == pg8::QKV_LD, "shapes");
constexpr size_t MiB = 1u << 20;
constexpr size_t WS_CTL = 0, CTL_ZERO_BYTES = 1 * MiB;
constexpr size_t WS_WR = 1 * MiB;
constexpr size_t WS_TOK = WS_WR + 256 * 1024;
constexpr size_t WS_ROPE = 4 * MiB;
constexpr size_t WS_WIN = 8 * MiB;
constexpr size_t WS_WO = 13 * MiB;
constexpr size_t WS_WGU = 16 * MiB;
constexpr size_t WS_WD = 80 * MiB;
constexpr size_t WS_A = 112 * MiB;
constexpr size_t WS_MIX = 176 * MiB;
constexpr size_t WS_QKV = 240 * MiB;
constexpr size_t WS_HM = 384 * MiB;
constexpr size_t WS_END = 456 * MiB;
static_assert(WS_TOK + (size_t)(T * 2 * 4) * 2 + T * 4 + NCHUNK * 32 * 4 + 288 * 4 + (size_t)PSLOTS * 16 <= WS_ROPE, "routing tables");
static_assert(WS_WIN + (size_t)IN_COLS * D * 2 <= WS_WO && WS_WO + (size_t)D * D * 2 <= WS_WGU && WS_WGU + (size_t)NEXP * 1024 * D * 2 <= WS_WD && WS_WD + (size_t)NEXP * D * FF * 2 <= WS_A, "weights");
static_assert(WS_A + (size_t)T * D * 2 <= WS_MIX && WS_MIX + (size_t)T * D * 2 <= WS_QKV && WS_QKV + (size_t)T * IN_COLS * 2 <= WS_HM && WS_QKV + (size_t)PSLOTS * D * 2 <= WS_HM && WS_HM + (size_t)PSLOTS * FF * 2 <= WS_END, "activations");
static_assert(WS_MIX + (size_t)NASSIGN * D * 2 <= WS_HM, "Y (P5b-P6) overlays MIX and the head of XS, both dead after P5a; HB stays live in WS_A until P6");
constexpr int CW_KMAX = 128;
constexpr int CW_NBU = 64;
constexpr int CW_BAR = 4096;
constexpr int RING_OFF = 0, RING_BYTES = 131072;
constexpr int LDSCTL_OFF = RING_BYTES, MISC_OFF = LDSCTL_OFF + 320;
constexpr int LDS_BYTES = 147456;
constexpr int ROWTAB_OFF = MISC_OFF + 128, ROWTAB_UNITS = 6;
static_assert(ROWTAB_OFF + ROWTAB_UNITS * 1024 <= LDS_BYTES, "LDS map");
#define GAS __attribute__((address_space(1)))
#define LAS __attribute__((address_space(3)))
typedef unsigned short bf16;
typedef unsigned v4u __attribute__((ext_vector_type(4)));
typedef float f32x4 __attribute__((ext_vector_type(4)));
typedef short bf16x8 __attribute__((ext_vector_type(8)));
typedef GAS unsigned gu32;
typedef GAS unsigned long long gu64;
#define RLX_AGENT __ATOMIC_RELAXED, __HIP_MEMORY_SCOPE_AGENT
#define LDS_WAIT() asm volatile("s_waitcnt lgkmcnt(0)" ::: "memory")
#define VM_WAIT() asm volatile("s_waitcnt vmcnt(0)" ::: "memory")
__device__ __forceinline__ unsigned long long rt() { return __builtin_amdgcn_s_memrealtime(); }
__device__ __forceinline__ unsigned f2bf(float f) { unsigned u = __builtin_bit_cast(unsigned, f); return (u + 0x7fffu + ((u >> 16) & 1u)) >> 16; }
__device__ __forceinline__ unsigned pk2(float lo, float hi) { return f2bf(lo) | (f2bf(hi) << 16); }

#define XB_TMO      128
#define XB_XCNT(j)  (256  + 64 * (j))
#define XB_XSUB(j)  (1280 + 64 * (j))
#define XB_XGEN(j)  (2304 + 64 * (j))
#define XB_TOP      3328
#define XB_TOPGEN   3392
#define XCD_BAR_WORDS 3456
#define XB_SPIN_CAP (1u << 18)

__device__ __forceinline__ unsigned xb_ld(unsigned* p)              { return __hip_atomic_load(p, __ATOMIC_RELAXED, __HIP_MEMORY_SCOPE_AGENT); }
__device__ __forceinline__ unsigned xb_add(unsigned* p, unsigned v) { return __hip_atomic_fetch_add(p, v, __ATOMIC_RELAXED, __HIP_MEMORY_SCOPE_AGENT); }
__device__ __forceinline__ unsigned xb_xcc_id() { return (unsigned)__builtin_amdgcn_s_getreg((3 << 11) | 20) & 0xFu; }
#define XB_SPIN(cond, bar) do { unsigned _sp = 0; while (cond) { __builtin_amdgcn_s_sleep(1); \
    if ((++_sp & 255u) == 0u) { if (xb_ld(&(bar)[XB_TMO])) break; if (_sp > XB_SPIN_CAP) { atomicAdd(&(bar)[XB_TMO], 1u); break; } } } } while (0)

struct XcdBarrier {
    unsigned* bar; unsigned x;
    volatile LAS unsigned* st;
};

__device__ __forceinline__ XcdBarrier xcd_barrier_post(unsigned* bar, volatile LAS unsigned* st) {
    XcdBarrier b; b.bar = bar; b.x = xb_xcc_id(); b.st = st;
    if (threadIdx.x == 0) (void)xb_add(&bar[XB_XCNT(b.x)], 1u);
    return b;
}
__device__ __forceinline__ void xcd_barrier_complete(unsigned* bar, unsigned x, unsigned& nloc, unsigned& nx) {
    const unsigned G = gridDim.x * gridDim.y * gridDim.z;
    unsigned sum, cnt, mine, sp = 0u;
    for (;;) {
        sum = 0u; cnt = 0u; mine = 0u;
#pragma unroll
        for (unsigned j = 0; j < 16; ++j) { const unsigned c = xb_ld(&bar[XB_XCNT(j)]); sum += c; cnt += (c > 0u) ? 1u : 0u; mine = (j == x) ? c : mine; }
        if (sum == G) break;
        __builtin_amdgcn_s_sleep(1);
        if ((++sp & 255u) == 0u) { if (xb_ld(&bar[XB_TMO])) break; if (sp > XB_SPIN_CAP) { atomicAdd(&bar[XB_TMO], 1u); break; } }
    }
    nloc = mine > 0u ? mine : 1u; nx = cnt > 0u ? cnt : 1u;
}

__device__ __forceinline__ void xcd_barrier(const XcdBarrier& b) {
    asm volatile("s_waitcnt vmcnt(0)" ::: "memory");
    __syncthreads();
    if (threadIdx.x == 0) {
        unsigned* bar = b.bar;
        __builtin_amdgcn_s_waitcnt(0);
        unsigned nloc = b.st[0], nx = b.st[1];
        if (nloc == 0u) { xcd_barrier_complete(bar, b.x, nloc, nx); b.st[0] = nloc; b.st[1] = nx; }
        const unsigned old = xb_add(&bar[XB_XSUB(b.x)], 1u);
        const unsigned gen = old / nloc;
        if (old + 1u == (gen + 1u) * nloc) {
            __builtin_amdgcn_fence(__ATOMIC_RELEASE, "agent");
            asm volatile("s_waitcnt vmcnt(0)" ::: "memory");
            const unsigned og = xb_add(&bar[XB_TOP], 1u);
            const unsigned tg = og / nx;
            if (og + 1u == (tg + 1u) * nx) xb_add(&bar[XB_TOPGEN], 1u);
            else XB_SPIN(xb_ld(&bar[XB_TOPGEN]) == tg, bar);
            __builtin_amdgcn_fence(__ATOMIC_ACQUIRE, "agent");
            xb_add(&bar[XB_XGEN(b.x)], 1u);
            asm volatile("s_waitcnt vmcnt(0)" ::: "memory");
        } else {
            XB_SPIN(xb_ld(&bar[XB_XGEN(b.x)]) == gen, bar);
            __builtin_amdgcn_fence(__ATOMIC_ACQUIRE, "agent");
            asm volatile("s_waitcnt vmcnt(0)" ::: "memory");
        }
    }
    __syncthreads();
}
struct Frame {
    LAS unsigned char* lds;
    volatile LAS unsigned* MISC;
    gu32* ctl;
    int tid, lane, wave;
    int vcu, G;
    const float* x; float* out;
    const float *g1, *w_in, *lq1, *lk1, *lq2, *lk2, *subg, *sinks, *w_out, *g2, *w_rg, *b_rg, *w_re, *b_re, *w_gate, *w_up, *w_down, *gf;
    bf16 *Win_t, *Wo_t, *Wgu_t, *Wd_t;
    bf16 *XN, *OD, *HB, *Y, *MIX, *QKV, *XS, *HM;
    float *Wr, *rope;
    int* tok_e; float* tok_g; float* tok_rstd; int* cnt; unsigned* blk_e; int* slot_dst; float* slot_gate; float* slot_rstd; int* slot_tok;
};
__device__ __forceinline__ float wave_sum(float v) {
#pragma unroll
    for (int o = 1; o < 64; o <<= 1) v += __shfl_xor(v, o);
    return v;
}
__device__ __forceinline__ void tr_item(const float* W, int ldn, int k0, int sc, const float* ksc, bf16* WT, int Kd, int drow0, LAS float* scr, int lane) {
#pragma unroll 8
    for (int i = 0; i < 32; ++i) { const int kk = 2 * i + (lane >> 5); float v = W[(size_t)(k0 + kk) * ldn + sc]; if (ksc) v *= ksc[k0 + kk]; scr[kk * 33 + (lane & 31)] = v; }
    LDS_WAIT(); asm volatile("" ::: "memory");
    const int c = lane & 7;
#pragma unroll
    for (int j = 0; j < 4; ++j) { const int n = (lane >> 3) + 8 * j; const LAS float* s = scr + (8 * c) * 33 + n;
        v4u o; o.x = pk2(s[0 * 33], s[1 * 33]); o.y = pk2(s[2 * 33], s[3 * 33]); o.z = pk2(s[4 * 33], s[5 * 33]); o.w = pk2(s[6 * 33], s[7 * 33]);
        *(GAS v4u*)(WT + (size_t)(drow0 + n) * Kd + k0 + 8 * c) = o; }
    LDS_WAIT(); asm volatile("" ::: "memory");
}
__device__ __forceinline__ void tr_item_w(const float* W, int ldn, int k0, int n0, const float* ksc, bf16* WT, int Kd, int drow0, LAS float* scr, int lane) {
    const int r = lane >> 3, c4 = (lane & 7) * 4;
    f32x4 v[8];
#pragma unroll
    for (int i = 0; i < 8; ++i) v[i] = *(const GAS f32x4*)(W + (size_t)(k0 + 8 * i + r) * ldn + n0 + c4);
    if (ksc) {
#pragma unroll
        for (int i = 0; i < 8; ++i) v[i] = v[i] * ksc[k0 + 8 * i + r]; }
#pragma unroll
    for (int i = 0; i < 8; ++i) { LAS float* d = scr + (8 * i + r) * 33 + c4; d[0] = v[i].x; d[1] = v[i].y; d[2] = v[i].z; d[3] = v[i].w; }
    LDS_WAIT(); asm volatile("" ::: "memory");
    const int c = lane & 7;
#pragma unroll
    for (int j = 0; j < 4; ++j) { const int n = (lane >> 3) + 8 * j; const LAS float* s = scr + (8 * c) * 33 + n;
        v4u o; o.x = pk2(s[0 * 33], s[1 * 33]); o.y = pk2(s[2 * 33], s[3 * 33]); o.z = pk2(s[4 * 33], s[5 * 33]); o.w = pk2(s[6 * 33], s[7 * 33]);
        *(GAS v4u*)(WT + (size_t)(drow0 + n) * Kd + k0 + 8 * c) = o; }
    LDS_WAIT(); asm volatile("" ::: "memory");
}
__device__ __forceinline__ int win_src_col(int n) {
    const bool isrope = (n < 1024) || (n >= 1536 && n < 2176);
    if (!isrope) return n;
    const int j = n & 63; return (n & ~63) + (j >> 1) + 32 * (j & 1);
}
constexpr int I_IN = (IN_COLS / 32) * (D / 64), I_O = (D / 32) * (D / 64), I_GU = NEXP * (1024 / 32) * (D / 64), I_D = NEXP * (D / 32) * (FF / 64), I_MOE = I_GU + I_D;
constexpr int MOE_TAIL_ITEMS = 17408;
__device__ __forceinline__ void moe_weight_items(Frame& F, int lo, int hi, int w, int nw) {
    LAS float* scr = (LAS float*)(F.lds + RING_OFF + F.wave * 16384);
    int lane_ = F.lane; asm volatile("" : "+v"(lane_)); const int lane = lane_;
    for (int it = lo + w; it < hi; it += nw) {
        int r = it;
        if (r < I_GU) { const int e = r / 512, q = r % 512, nb = q % 32, kb = q / 32;
            const float* src = (((nb >> 2) & 1) ? F.w_up : F.w_gate) + (size_t)e * D * FF; const int f0 = (nb >> 3) * 128 + (nb & 3) * 32;
            tr_item_w(src, FF, 64 * kb, f0, F.g2, F.Wgu_t + (size_t)e * 1024 * D, D, 32 * nb, scr, lane); continue; } r -= I_GU;
        { const int e = r / 256, q = r % 256, nb = q % 32, kb = q / 32;
            tr_item_w(F.w_down + (size_t)e * FF * D, D, 64 * kb, 32 * nb, nullptr, F.Wd_t + (size_t)e * D * FF, FF, 32 * nb, scr, lane); }
    }
}
__device__ __forceinline__ void p0_prologue(Frame& F) {
    LAS float* scr = (LAS float*)(F.lds + RING_OFF + F.wave * 16384);
    int lane_ = F.lane; asm volatile("" : "+v"(lane_)); const int gw = F.vcu * NWAVES + F.wave, NGW = F.G * NWAVES, lane = lane_;
    for (int it = gw; it < I_IN + I_O; it += NGW) {
        int r = it;
        if (r < I_IN) { const int nb = r % (IN_COLS / 32), kb = r / (IN_COLS / 32); tr_item(F.w_in, IN_COLS, 64 * kb, win_src_col(32 * nb + (lane & 31)), nullptr, F.Win_t, D, 32 * nb, scr, lane); continue; } r -= I_IN;
        { const int nb = r % (D / 32), kb = r / (D / 32); tr_item_w(F.w_out, D, 64 * kb, 32 * nb, nullptr, F.Wo_t, D, 32 * nb, scr, lane); }
    }
    if (F.G != 256) moe_weight_items(F, 0, I_MOE, gw, NGW);
    for (int i = (gw * 64 + lane); i < 3 * 8 * 4 * 64; i += NGW * 64) { const int ln = i & 63, q = (i >> 6) & 3, S = (i >> 8) & 7, blk = i >> 11, j = 16 * blk + (ln & 15), k0 = 128 * S + 32 * (ln >> 4) + 8 * q;
        unsigned hi[8], lo[8];
#pragma unroll
        for (int e = 0; e < 8; ++e) { const int k = k0 + e; const float w = j < 4 ? F.g2[k] * F.w_rg[k * 4 + j] : j < 36 ? F.g2[k] * F.w_re[k * NEXP + (j - 4)] : 0.f;
            hi[e] = f2bf(w); lo[e] = f2bf(w - __uint_as_float(hi[e] << 16)); }
        v4u oh, ol; oh.x = hi[0] | (hi[1] << 16); oh.y = hi[2] | (hi[3] << 16); oh.z = hi[4] | (hi[5] << 16); oh.w = hi[6] | (hi[7] << 16);
        ol.x = lo[0] | (lo[1] << 16); ol.y = lo[2] | (lo[3] << 16); ol.z = lo[4] | (lo[5] << 16); ol.w = lo[6] | (lo[7] << 16);
        *((GAS v4u*)F.Wr + i) = oh; *((GAS v4u*)F.Wr + 3 * 8 * 4 * 64 + i) = ol; }
    for (int i = (gw * 64 + lane); i < SEQ * 32; i += NGW * 64) { const int pos = i >> 5, fi = i & 31;
        double inv = 1.0; for (int q = 0; q < fi; ++q) inv *= 0.74989420933245582730;
        const double rev = (double)pos * inv * 0.15915494309189533577; const float fr = (float)(rev - __builtin_rint(rev));
        typedef float f32x2g __attribute__((ext_vector_type(2))); f32x2g cs; cs.x = __builtin_amdgcn_cosf(fr); cs.y = __builtin_amdgcn_sinf(fr); *(GAS f32x2g*)(F.rope + 2 * (size_t)i) = cs; }
    { f32x4 g[4];
#pragma unroll
      for (int j = 0; j < 4; ++j) g[j] = *((const GAS f32x4*)F.g1 + lane + 64 * j);
      for (int m = 2 * gw; m < T; m += 2 * NGW) {
        const GAS f32x4* xr = (const GAS f32x4*)(F.x + (size_t)m * D) + lane;
        f32x4 v[8]; float s0 = 0.f, s1 = 0.f;
#pragma unroll
        for (int j = 0; j < 8; ++j) v[j] = xr[64 * j];
#pragma unroll
        for (int j = 0; j < 4; ++j) { s0 += (v[j].x * v[j].x + v[j].y * v[j].y) + (v[j].z * v[j].z + v[j].w * v[j].w); s1 += (v[4 + j].x * v[4 + j].x + v[4 + j].y * v[4 + j].y) + (v[4 + j].z * v[4 + j].z + v[4 + j].w * v[4 + j].w); }
        const float r0 = 1.0f / sqrtf(wave_sum(s0) * (1.f / D) + RMS_EPS), r1 = 1.0f / sqrtf(wave_sum(s1) * (1.f / D) + RMS_EPS);
        GAS unsigned long long* o8 = (GAS unsigned long long*)(F.XN + (size_t)m * D) + lane;
#pragma unroll
        for (int j = 0; j < 8; ++j) { const f32x4 gg = g[j & 3]; const float rs = j < 4 ? r0 : r1;
            o8[64 * j] = (unsigned long long)pk2(v[j].x * rs * gg.x, v[j].y * rs * gg.y) | ((unsigned long long)pk2(v[j].z * rs * gg.z, v[j].w * rs * gg.w) << 32); }
      } }
}
#ifndef SWA_ABL
#define SWA_ABL 0
#endif
template <int PART> __device__ __forceinline__ void p2_attention(Frame& F, char* lds) {
    using abf = attn_body::bf16;
#ifndef SKIP_DIFF
    if (PART != 2) for (int L = F.vcu; L < 16 * 64; L += F.G) {
        const int i = L >> 8, v = L & 255, hh = v >> 4, s = v & 15, qb = 32 * (i >> 1) + ((i & 1) ? 31 - s : s);
        const int c = hh & 1, h = (hh >> 1) & 3, b = hh >> 3;
        const abf* base = (const abf*)F.QKV + (size_t)b * SEQ * IN_COLS;
        attn_body::attn_unit_w<8>(base + h * 128 + c * 64, base + 512 + h * 128 + c * 64, base + 1024 + h * 128,
                                  (abf*)F.OD + (size_t)b * SEQ * D + c * 512 + h * 128, (const unsigned*)(F.ctl + CW_KMAX) + (b * 8 + h * 2 + c) * 8, qb * 256, 4 * qb + 4, lds);
        if (F.G == 256 && PART == 0 && i < 3) { constexpr int NREST = I_MOE - MOE_TAIL_ITEMS, SL = (NREST + 2) / 3;
            const int lo_ = i * SL, hi_ = (i + 1) * SL < NREST ? (i + 1) * SL : NREST; moe_weight_items(F, lo_, hi_, F.vcu * NWAVES + F.wave, F.G * NWAVES); __syncthreads(); }
    }
#endif
#ifndef SKIP_SWA
    if (PART != 1) for (int L = F.vcu; L < 2 * 2 * 64; L += F.G) {
        const int qb = L & 63, kvh = (L >> 6) & 1, b = L >> 7;
        const abf* base = (const abf*)F.QKV + (size_t)b * SEQ * IN_COLS;
        float sk[4];
#pragma unroll
        for (int g = 0; g < 4; ++g) sk[g] = F.sinks[kvh * 4 + g] * 1.4426950408889634f;
        attn_body::swa_unit<(PART == 2) ? SWA_ABL : 0>(base + 1536 + kvh * 256, base + 2048 + kvh * 64, base + 2176 + kvh * 64, (abf*)F.MIX + (size_t)b * SEQ * D + 512 + kvh * 256, (const unsigned*)(F.ctl + CW_KMAX) + 128 + (b * 2 + kvh) * 8, qb * 256, sk, lds);
    }
#endif
}
__device__ __forceinline__ void p2b_combine(Frame& F) {
    int lane_ = F.lane; asm volatile("" : "+v"(lane_)); const int gw = F.vcu * NWAVES + F.wave, NGW = F.G * NWAVES, lane = lane_;
    const float lam = __expf(wave_sum(F.lq1[lane] * F.lk1[lane])) - __expf(wave_sum(F.lq2[lane] * F.lk2[lane])) + 0.2f;
    const f32x4 ga = *(const f32x4*)(F.subg + (lane & 15) * 8), gb = *(const f32x4*)(F.subg + (lane & 15) * 8 + 4);
    for (int m = gw; m < T; m += NGW) {
        const v4u a = *(const GAS v4u*)(F.OD + (size_t)m * D + 8 * lane), b = *(const GAS v4u*)(F.OD + (size_t)m * D + 512 + 8 * lane);
        float o[8]; float ss = 0.f;
#pragma unroll
        for (int q = 0; q < 4; ++q) { const unsigned ua = q == 0 ? a.x : q == 1 ? a.y : q == 2 ? a.z : a.w, ub = q == 0 ? b.x : q == 1 ? b.y : q == 2 ? b.z : b.w;
            o[2 * q] = __uint_as_float(ua << 16) - lam * __uint_as_float(ub << 16); o[2 * q + 1] = __uint_as_float(ua & 0xffff0000u) - lam * __uint_as_float(ub & 0xffff0000u);
            ss += o[2 * q] * o[2 * q] + o[2 * q + 1] * o[2 * q + 1]; }
        ss += __shfl_xor(ss, 1); ss += __shfl_xor(ss, 2); ss += __shfl_xor(ss, 4); ss += __shfl_xor(ss, 8);
        const float r = 0.8f / sqrtf(ss * (1.f / 128.f) + RMS_EPS);
        v4u w; w.x = pk2(o[0] * r * ga[0], o[1] * r * ga[1]); w.y = pk2(o[2] * r * ga[2], o[3] * r * ga[3]); w.z = pk2(o[4] * r * gb[0], o[5] * r * gb[1]); w.w = pk2(o[6] * r * gb[2], o[7] * r * gb[3]);
        *(GAS v4u*)(F.MIX + (size_t)m * D + 8 * lane) = w;
    }
}
__device__ __forceinline__ void p4a_router(Frame& F) {
    typedef float f32x4m __attribute__((ext_vector_type(4)));
    LAS int* lcnt = (LAS int*)(F.lds + RING_OFF);
    LAS float* lgs = (LAS float*)(F.lds + RING_OFF + 1024) + F.wave * 768;
    int lane_ = F.lane; asm volatile("" : "+v"(lane_)); const int lane = lane_, n = lane & 15, g = lane >> 4;
    const GAS v4u* Wh = (const GAS v4u*)F.Wr; const GAS v4u* Wl = Wh + 3 * 8 * 4 * 64;
    for (int ch = F.vcu; ch < NCHUNK; ch += F.G) {
        if (F.tid < 32) lcnt[F.tid] = 0;
        __syncthreads();
        const int t = ch * CHUNK_TOK + F.wave * 16 + n;
        const bf16* hrow = F.HB + (size_t)t * D + 32 * g;
        f32x4m acc[3]; acc[0] = (f32x4m){0.f, 0.f, 0.f, 0.f}; acc[1] = acc[0]; acc[2] = acc[0];
        float ss = 0.f;
#pragma unroll 2
        for (int S = 0; S < 8; ++S) {
            v4u hb[4];
#pragma unroll
            for (int q = 0; q < 4; ++q) hb[q] = *(const GAS v4u*)(hrow + 128 * S + 8 * q);
#pragma unroll
            for (int q = 0; q < 4; ++q) {
#pragma unroll
                for (int e = 0; e < 4; ++e) { const unsigned u = e == 0 ? hb[q].x : e == 1 ? hb[q].y : e == 2 ? hb[q].z : hb[q].w; const float a = __uint_as_float(u << 16), c = __uint_as_float(u & 0xffff0000u); ss += a * a + c * c; }
#pragma unroll
                for (int blk = 0; blk < 3; ++blk) { const int fi = ((blk * 8 + S) * 4 + q) * 64 + lane;
                    const v4u wh = Wh[fi], wl = Wl[fi];
                    acc[blk] = __builtin_amdgcn_mfma_f32_16x16x32_bf16(__builtin_bit_cast(bf16x8, wh), __builtin_bit_cast(bf16x8, hb[q]), acc[blk], 0, 0, 0);
                    acc[blk] = __builtin_amdgcn_mfma_f32_16x16x32_bf16(__builtin_bit_cast(bf16x8, wl), __builtin_bit_cast(bf16x8, hb[q]), acc[blk], 0, 0, 0); }
            }
        }
        ss += __shfl_xor(ss, 16); ss += __shfl_xor(ss, 32);
#pragma unroll
        for (int blk = 0; blk < 3; ++blk)
#pragma unroll
            for (int r = 0; r < 4; ++r) lgs[n * 48 + 16 * blk + 4 * g + r] = acc[blk][r];
        LDS_WAIT(); asm volatile("" ::: "memory");
        const LAS float* lg = lgs + n * 48;
        const float rstd = 1.0f / sqrtf(ss * (1.f / D) + RMS_EPS);
        float gl[4];
#pragma unroll
        for (int j = 0; j < 4; ++j) gl[j] = lg[j] * rstd + F.b_rg[j];
        int gi = 0; float gm = gl[0];
#pragma unroll
        for (int j = 1; j < 4; ++j) if (gl[j] > gm) { gm = gl[j]; gi = j; }
        float den = 0.f;
#pragma unroll
        for (int j = 0; j < 4; ++j) den += __expf(gl[j] - gm);
        const float ptop = 1.0f / den;
        float el[8];
#pragma unroll
        for (int i = 0; i < 8; ++i) el[i] = lg[4 + gi * 8 + i] * rstd + F.b_re[gi * 8 + i];
        int i0 = 0; float v0 = el[0];
#pragma unroll
        for (int i = 1; i < 8; ++i) if (el[i] > v0) { v0 = el[i]; i0 = i; }
        int i1 = -1; float v1 = -INFINITY;
#pragma unroll
        for (int i = 0; i < 8; ++i) if (i != i0 && el[i] > v1) { v1 = el[i]; i1 = i; }
        const float e1w = __expf(v1 - v0), gt0 = ptop / (1.0f + e1w), gt1 = gt0 * e1w;
        if (g == 0) { const int e0 = gi * 8 + i0, e1 = gi * 8 + i1;
            F.tok_e[2 * t] = e0; F.tok_e[2 * t + 1] = e1; F.tok_g[2 * t] = gt0; F.tok_g[2 * t + 1] = gt1; F.tok_rstd[t] = rstd;
            atomicAdd((int*)&lcnt[e0], 1); atomicAdd((int*)&lcnt[e1], 1); }
        __syncthreads();
        if (F.tid < 32) F.cnt[ch * 32 + F.tid] = lcnt[F.tid];
        __syncthreads();
    }
}
__device__ __forceinline__ void p4b_scatter(Frame& F) {
    LAS int* E = (LAS int*)(F.lds + RING_OFF);
    LAS int* SL = E + 256;
    LAS int* base = SL + 256;
    LAS int* padded = base + 32;
    LAS int* padlo = padded + 32;
    LAS int* padhi = padlo + 32;
    LAS int* ptot = padhi + 32; LAS int* ppre = ptot + 512;
    int tid_ = F.tid; asm volatile("" : "+v"(tid_)); const int tid = tid_;
    for (int ch = F.vcu; ch < NCHUNK; ch += F.G) {
        int pre = 0, total = 0;
        if (tid < 256) E[tid] = F.tok_e[ch * 256 + tid];
        { const int e_ = tid & 31, part = tid >> 5; int tsum = 0, psum = 0;
#pragma unroll
          for (int q = 0; q < 16; ++q) { const int c2 = part * 16 + q; const int vv = F.cnt[c2 * 32 + e_]; tsum += vv; psum += (c2 < ch) ? vv : 0; }
          ptot[part * 32 + e_] = tsum; ppre[part * 32 + e_] = psum; }
        __syncthreads();
        if (tid < 32) {
#pragma unroll
            for (int q = 0; q < 16; ++q) { total += ptot[q * 32 + tid]; pre += ppre[q * 32 + tid]; }
            padded[tid] = (total + 255) & ~255; }
        __syncthreads();
        if (tid < 32) { int ps = 0; for (int e2 = 0; e2 < tid; ++e2) ps += padded[e2];
            base[tid] = ps + pre; padlo[tid] = ps + total; padhi[tid] = ps + padded[tid];
            if (ch == 0) { for (int rb = ps >> 8; rb < ((ps + padded[tid]) >> 8); ++rb) F.blk_e[rb] = (unsigned)tid; if (tid == 31) __hip_atomic_store(F.ctl + CW_NBU, (unsigned)((ps + padded[tid]) >> 8), RLX_AGENT); } }
        __syncthreads();
        if (tid < 256) { const int e = E[tid]; int rank = 0; for (int a2 = 0; a2 < tid; ++a2) rank += (E[a2] == e) ? 1 : 0;
            const int slot = base[e] + rank; SL[tid] = slot;
            F.slot_dst[slot] = ch * 256 + tid; F.slot_tok[slot] = ch * CHUNK_TOK + (tid >> 1); F.slot_gate[slot] = F.tok_g[ch * 256 + tid]; F.slot_rstd[slot] = F.tok_rstd[ch * CHUNK_TOK + (tid >> 1)]; }
        __syncthreads();
        if (ch < NEXP) { const int lo = padlo[ch], hi = padhi[ch];
            for (int s = lo + tid; s < hi; s += NWAVES * 64) { F.slot_dst[s] = -1; F.slot_tok[s] = 0; F.slot_gate[s] = 0.f; F.slot_rstd[s] = 0.f; } }
        __syncthreads();
    }
}
__device__ __forceinline__ void p6_final(Frame& F) {
    int lane_ = F.lane; asm volatile("" : "+v"(lane_)); const int gw = F.vcu * NWAVES + F.wave, NGW = F.G * NWAVES, lane = lane_;
    f32x4 g[4];
#pragma unroll
    for (int j = 0; j < 4; ++j) g[j] = *((const GAS f32x4*)F.gf + 2 * lane + (j & 1) + 128 * (j >> 1));
    for (int m = gw; m < T; m += NGW) {
        const GAS v4u* hr = (const GAS v4u*)(F.HB + (size_t)m * D) + lane; const GAS v4u* y0 = (const GAS v4u*)(F.Y + (size_t)(2 * m) * D) + lane; const GAS v4u* y1 = (const GAS v4u*)(F.Y + (size_t)(2 * m + 1) * D) + lane;
        v4u a[2], b[2], c[2];
#pragma unroll
        for (int j = 0; j < 2; ++j) { a[j] = hr[64 * j]; b[j] = y0[64 * j]; c[j] = y1[64 * j]; }
        float v[16]; float s = 0.f;
#pragma unroll
        for (int j = 0; j < 2; ++j)
#pragma unroll
            for (int q = 0; q < 4; ++q) { const unsigned ua = q == 0 ? a[j].x : q == 1 ? a[j].y : q == 2 ? a[j].z : a[j].w, ub = q == 0 ? b[j].x : q == 1 ? b[j].y : q == 2 ? b[j].z : b[j].w, uc = q == 0 ? c[j].x : q == 1 ? c[j].y : q == 2 ? c[j].z : c[j].w;
                const float lo = __uint_as_float(ua << 16) + __uint_as_float(ub << 16) + __uint_as_float(uc << 16), hi = __uint_as_float(ua & 0xffff0000u) + __uint_as_float(ub & 0xffff0000u) + __uint_as_float(uc & 0xffff0000u);
                v[8 * j + 2 * q] = lo; v[8 * j + 2 * q + 1] = hi; s += lo * lo + hi * hi; }
        const float rstd = 1.0f / sqrtf(wave_sum(s) * (1.f / D) + RMS_EPS);
        GAS f32x4* orow = (GAS f32x4*)(F.out + (size_t)m * D) + 2 * lane;
#pragma unroll
        for (int j = 0; j < 2; ++j) { const f32x4 g0 = g[2 * j], g1 = g[2 * j + 1];
            orow[128 * j] = (f32x4){v[8 * j] * rstd * g0.x, v[8 * j + 1] * rstd * g0.y, v[8 * j + 2] * rstd * g0.z, v[8 * j + 3] * rstd * g0.w};
            orow[128 * j + 1] = (f32x4){v[8 * j + 4] * rstd * g1.x, v[8 * j + 5] * rstd * g1.y, v[8 * j + 6] * rstd * g1.z, v[8 * j + 7] * rstd * g1.w}; }
    }
}

struct Args { const float* in[19]; float* out; unsigned char* ws; };
__global__ void __launch_bounds__(NWAVES * 64, 2) hymba_fwd(Args args) {
    extern __shared__ __attribute__((aligned(16))) unsigned char lds[];
    Frame F;
    F.lds = (LAS unsigned char*)lds;
    F.MISC = (volatile LAS unsigned*)(F.lds + MISC_OFF);
    F.tid = threadIdx.x; F.lane = F.tid & 63; F.wave = __builtin_amdgcn_readfirstlane(F.tid >> 6);
    F.G = gridDim.x; { const int bx = blockIdx.x; F.vcu = (F.G % 8 == 0) ? (bx % 8) * (F.G / 8) + bx / 8 : bx; }
    unsigned char* ws = args.ws;
    F.ctl = (gu32*)(ws + WS_CTL);
    F.x = args.in[0]; F.g1 = args.in[1]; F.w_in = args.in[2]; F.lq1 = args.in[3]; F.lk1 = args.in[4]; F.lq2 = args.in[5]; F.lk2 = args.in[6]; F.subg = args.in[7]; F.sinks = args.in[8];
    F.w_out = args.in[9]; F.g2 = args.in[10]; F.w_rg = args.in[11]; F.b_rg = args.in[12]; F.w_re = args.in[13]; F.b_re = args.in[14]; F.w_gate = args.in[15]; F.w_up = args.in[16]; F.w_down = args.in[17]; F.gf = args.in[18];
    F.out = args.out;
    F.Win_t = (bf16*)(ws + WS_WIN); F.Wo_t = (bf16*)(ws + WS_WO); F.Wgu_t = (bf16*)(ws + WS_WGU); F.Wd_t = (bf16*)(ws + WS_WD);
    F.XN = (bf16*)(ws + WS_A); F.OD = F.XN; F.HB = F.XN; F.MIX = (bf16*)(ws + WS_MIX); F.Y = F.MIX; F.QKV = (bf16*)(ws + WS_QKV); F.XS = F.QKV; F.HM = (bf16*)(ws + WS_HM);
    F.Wr = (float*)(ws + WS_WR); F.rope = (float*)(ws + WS_ROPE);
    { unsigned char* p = ws + WS_TOK; F.tok_e = (int*)p; p += (size_t)T * 8; F.tok_g = (float*)p; p += (size_t)T * 8; F.tok_rstd = (float*)p; p += (size_t)T * 4; F.cnt = (int*)p; p += NCHUNK * 32 * 4;
      F.blk_e = (unsigned*)p; p += 288 * 4; F.slot_dst = (int*)p; p += (size_t)PSLOTS * 4; F.slot_gate = (float*)p; p += (size_t)PSLOTS * 4; F.slot_rstd = (float*)p; p += (size_t)PSLOTS * 4; F.slot_tok = (int*)p; }
    for (int u = F.tid; u < (LDS_BYTES - LDSCTL_OFF) / 4; u += NWAVES * 64) ((LAS unsigned*)(F.lds + LDSCTL_OFF))[u] = 0u;
    __syncthreads();
    XcdBarrier bar = xcd_barrier_post((unsigned*)(F.ctl + CW_BAR), F.MISC + 8);
#define GRID_BAR() xcd_barrier(bar)

#define RUN_P0() p0_prologue(F)
#define RUN_P1() do { pg8::Gemm g{F.XN, F.Win_t, T, IN_COLS, D}; pg8::StaticOrder S; S.init(T, IN_COLS, F.G, (int)blockIdx.x); \
      pg8::EpiQKV E{F.QKV, F.rope, attn_body::C2, 0, (unsigned*)(F.ctl + CW_KMAX)}; \
      pg8::gemm_phase<pg8::EpiQKV, pg8::StaticOrder, PG8_ALIGN, PG8_SP2>(F.lds + RING_OFF, g, S, E); \
      if (F.G == 256 && blockIdx.x >= 128) moe_weight_items(F, I_MOE - MOE_TAIL_ITEMS, I_MOE, ((int)blockIdx.x - 128) * NWAVES + F.wave, 128 * NWAVES); } while (0)
#define RUN_P2() p2_attention<0>(F, (char*)lds + RING_OFF)
#define RUN_P2B() p2b_combine(F)
#define RUN_P3() do { pg8::Gemm g{F.MIX, F.Wo_t, T, D, D}; pg8::StaticOrder S; S.init(T, D, F.G, (int)blockIdx.x); \
      pg8::EpiResid E{F.x, F.HB}; \
      pg8::gemm_phase<pg8::EpiResid, pg8::StaticOrder, PG8_ALIGN, PG8_SP2>(F.lds + RING_OFF, g, S, E); } while (0)
#define RUN_P4A() p4a_router(F)
#define RUN_P4B() p4b_scatter(F)
#define RUN_P5A() do { const int nbu = __builtin_amdgcn_readfirstlane((int)__hip_atomic_load(F.ctl + CW_NBU, RLX_AGENT)); \
      pg8::Gemm g{F.HB, F.Wgu_t, PSLOTS, NEXP * 1024, D}; pg8::MoeSched S{F.blk_e, nbu * 4, F.G, (int)blockIdx.x}; \
      LAS int* rowtab = (LAS int*)(F.lds + ROWTAB_OFF); pg8::Unit uu; \
      for (int ui = 0; ui < ROWTAB_UNITS && S.next(ui, uu); ++ui) if (F.tid < 256) rowtab[ui * 256 + F.tid] = F.slot_tok[uu.pm * 256 + F.tid];     \
      __syncthreads(); \
      pg8::EpiGateUp E{F.HM, F.slot_rstd}; \
      pg8::gemm_phase<pg8::EpiGateUp, pg8::MoeSched, PG8_ALIGN, true, true>(F.lds + RING_OFF, g, S, E, rowtab); } while (0)
#define RUN_P5B() do { const int nbu = __builtin_amdgcn_readfirstlane((int)__hip_atomic_load(F.ctl + CW_NBU, RLX_AGENT)); \
      pg8::Gemm g{F.HM, F.Wd_t, PSLOTS, NEXP * 1024, FF}; pg8::MoeSched S{F.blk_e, nbu * 4, F.G, (int)blockIdx.x}; \
      pg8::EpiDown E{F.Y, F.slot_dst, F.slot_gate}; \
      pg8::gemm_phase<pg8::EpiDown, pg8::MoeSched, PG8_ALIGN, PG8_SP2>(F.lds + RING_OFF, g, S, E); } while (0)
#ifdef DUP_P0
    RUN_P0(); GRID_BAR();
#endif
    RUN_P0(); GRID_BAR();
#ifdef DUP_P1
    { pg8::Gemm g{F.XN, F.Win_t, T, IN_COLS, D}; pg8::StaticOrder S; S.init(T, IN_COLS, F.G, (int)blockIdx.x);
      pg8::EpiQKV E{F.QKV, F.rope, attn_body::C2, DUP_P1, (unsigned*)(F.ctl + CW_KMAX)};
      pg8::gemm_phase<pg8::EpiQKV, pg8::StaticOrder, PG8_ALIGN, PG8_SP2>(F.lds + RING_OFF, g, S, E); }
    GRID_BAR();
#endif
    RUN_P1(); GRID_BAR();
#ifdef DUP_P2
    p2_attention<DUP_P2>(F, (char*)lds + RING_OFF); GRID_BAR();
#endif
    RUN_P2(); GRID_BAR();
#ifdef DUP_P2B
    RUN_P2B(); GRID_BAR();
#endif
    RUN_P2B(); GRID_BAR();
#ifdef DUP_P3
    RUN_P3(); GRID_BAR();
#endif
    RUN_P3(); GRID_BAR();
#ifdef DUP_P4A
    RUN_P4A(); GRID_BAR();
#endif
    RUN_P4A(); GRID_BAR();
#ifdef DUP_P4B
    RUN_P4B(); GRID_BAR();
#endif
    RUN_P4B(); GRID_BAR();
#ifdef DUP_P5A
    RUN_P5A(); GRID_BAR();
#endif
    RUN_P5A(); GRID_BAR();
#ifdef DUP_P5B
    RUN_P5B(); GRID_BAR();
#endif
    RUN_P5B(); GRID_BAR();
#ifndef SKIP_P6
    p6_final(F);
#endif
}

extern "C" void kernel_launch(void* const* d_in, const int* in_sizes, int n_in, void* d_out, int out_size, void* d_ws, size_t ws_size, hipStream_t stream) {
    static int grid = 0;
    if (grid == 0) {
        if (n_in != 19 || in_sizes[0] != T * D || out_size != T * D || ws_size < WS_END) { fprintf(stderr, "kernel_launch: unexpected shapes (n_in %d, in0 %d, out %d, ws %zu); nothing launched\n", n_in, n_in > 0 ? in_sizes[0] : -1, out_size, ws_size); grid = -1; return; }
        int dev = 0, cus = 0, per_cu = 0;
        if (hipGetDevice(&dev) != hipSuccess || hipDeviceGetAttribute(&cus, hipDeviceAttributeMultiprocessorCount, dev) != hipSuccess) { grid = -1; return; }
        if (hipFuncSetAttribute((const void*)hymba_fwd, hipFuncAttributeMaxDynamicSharedMemorySize, LDS_BYTES) != hipSuccess) { grid = -1; return; }
        if (hipOccupancyMaxActiveBlocksPerMultiprocessor(&per_cu, (const void*)hymba_fwd, NWAVES * 64, LDS_BYTES) != hipSuccess || per_cu < 1) { fprintf(stderr, "kernel_launch: occupancy query reports %d\n", per_cu); }
        (void)hipGetLastError();
        grid = cus;
    }
    if (grid < 0) return;
    if (hipMemsetAsync((char*)d_ws + WS_CTL, 0, CTL_ZERO_BYTES, stream) != hipSuccess) return;
    Args a{};
    for (int i = 0; i < 19; ++i) a.in[i] = (const float*)d_in[i];
    a.out = (float*)d_out; a.ws = (unsigned char*)d_ws;
    hipLaunchKernelGGL(hymba_fwd, dim3(grid), dim3(NWAVES * 64), LDS_BYTES, stream, a);
}
```

```cpp
#include <hip/hip_runtime.h>
#include <cstdio>
#include <cstdint>
namespace pg8 {
#define PG8_LAS __attribute__((address_space(3)))
typedef unsigned short bf16_t;
typedef short bf16x8 __attribute__((ext_vector_type(8)));
typedef float f32x4 __attribute__((ext_vector_type(4)));
typedef unsigned u32x4 __attribute__((ext_vector_type(4)));
constexpr int BM = 256, BK = 64, HALF = 128, HTB = HALF * BK * 2  , STAGE_BYTES = 8 * HTB, NXCD = 8, WGM = 2;

__host__ __device__ __forceinline__ int lds_byte(int r, int c) { const int st = (r >> 4) * 2 + (c >> 5), rr = r & 15, cc = c & 31, ob = rr * 64 + cc * 2; return st * 1024 + (ob ^ (((ob >> 9) & 1) << 5)); }
__host__ __device__ __forceinline__ void stage_rc(int b, int& R, int& C) { const int st = b / 1024, sb = b % 1024, swz = sb ^ (((sb >> 9) & 1) << 5); R = (st >> 1) * 16 + swz / 64; C = (st & 1) * 32 + (swz % 64) / 2; }
__host__ __device__ __forceinline__ int perm32(int rho) { const int n = rho >> 4, i = rho & 15; return 8 * (i >> 2) + 4 * n + (i & 3); }

struct Unit { int pm, pn; };
struct Gemm { const bf16_t* A; const bf16_t* Bt; int M, N, K; };

struct StaticOrder {
    int nM, nN, nwg, G, c;
    __host__ __device__ void init(int M, int N, int G_, int c_) { nM = M / BM; nN = N / BM; nwg = nM * nN; G = G_; c = c_; }
    __host__ __device__ bool next(int i, Unit& u) const {
        const long L = (long)i * G + c; if (L >= nwg) return false;
        int wgid = (int)L; { const int q = nwg / NXCD, r = nwg % NXCD, xcd = wgid % NXCD, off = wgid / NXCD; wgid = (xcd < r ? xcd * (q + 1) : r * (q + 1) + (xcd - r) * q) + off; }
        const int nig = WGM * nN, gid = wgid / nig, fm = gid * WGM, gsz = (nM - fm) < WGM ? (nM - fm) : WGM;
        u.pm = fm + ((wgid % nig) % gsz); u.pn = (wgid % nig) / gsz; return true;
    }
    __device__ __forceinline__ void a_ready(const Unit&) const {}
    __device__ __forceinline__ void done(const Unit&) const {}
};

__device__ __forceinline__ unsigned cvt_pk_bf16(float lo, float hi) { unsigned r; asm volatile("v_cvt_pk_bf16_f32 %0, %1, %2" : "=v"(r) : "v"(lo), "v"(hi)); return r; }
typedef float f32x2 __attribute__((ext_vector_type(2)));
__device__ __forceinline__ f32x2 gelu_pk(f32x2 v) {
    const f32x2 av = __builtin_elementwise_abs(v), d = av * 0.2316418882f + 1.0f;
    f32x2 t; t.x = __builtin_amdgcn_rcpf(d.x); t.y = __builtin_amdgcn_rcpf(d.y);
    f32x2 q = t * 0.5307027145f + (-0.7265760135f); q = q * t + 0.7107068705f; q = q * t + (-0.142248368f); q = q * t + 0.127414796f; q = q * t;
    const f32x2 s = (v * v) * (-0.72134752044f);
    f32x2 e; e.x = __builtin_amdgcn_exp2f(s.x); e.y = __builtin_amdgcn_exp2f(s.y);
    const f32x2 m = v * (q * e), r = v - m;
    f32x2 o; o.x = v.x < 0.f ? m.x : r.x; o.y = v.y < 0.f ? m.y : r.y; return o;
}

template <int ACT  > struct EpiBf16 {
    static constexpr bool PERM = true, AFTER_DRAIN = false; static_assert(ACT == 0 || ACT == 1, "EpiBf16: ACT is 0 (none) or 1 (gelu_pk)");
    bf16_t* O; int ldc; const float* bias; int split_cols; size_t split_stride; float scale0;
    __device__ __forceinline__ void operator()(const f32x4 (&acc)[2][2][4][2], const Unit& u, int wr, int wc, int fr, int fq) const {
        const int row0 = u.pm * BM + wr * 64 + fr; int colt = u.pn * BM; bf16_t* base = O;
        float sc = 1.f; if (split_cols) { const int t = colt / split_cols; base += (size_t)t * split_stride; colt -= t * split_cols; if (t == 0) sc = scale0; }
        const int col0 = colt + wc * 32 + 8 * fq, bcol0 = u.pn * BM + wc * 32 + 8 * fq;
        f32x4 bv[2][2];
#pragma unroll
        for (int bj = 0; bj < 2; ++bj)
#pragma unroll
            for (int n = 0; n < 2; ++n) bv[bj][n] = bias ? *(const f32x4*)(bias + bcol0 + bj * HALF + 4 * n) : (f32x4){0.f, 0.f, 0.f, 0.f};
#pragma unroll
        for (int ai = 0; ai < 2; ++ai)
#pragma unroll
            for (int m = 0; m < 4; ++m) { bf16_t* rowp = base + (size_t)(row0 + ai * HALF + m * 16) * ldc + col0;
#pragma unroll
                for (int bj = 0; bj < 2; ++bj) { f32x4 v0 = acc[ai][bj][m][0] + bv[bj][0], v1 = acc[ai][bj][m][1] + bv[bj][1];
                    if (ACT == 1) { f32x2 a = gelu_pk((f32x2){v0[0], v0[1]}), b = gelu_pk((f32x2){v0[2], v0[3]}), c = gelu_pk((f32x2){v1[0], v1[1]}), d = gelu_pk((f32x2){v1[2], v1[3]});
                        v0 = (f32x4){a.x, a.y, b.x, b.y}; v1 = (f32x4){c.x, c.y, d.x, d.y}; }
                    v0 = v0 * sc; v1 = v1 * sc; u32x4 w; w.x = cvt_pk_bf16(v0[0], v0[1]); w.y = cvt_pk_bf16(v0[2], v0[3]); w.z = cvt_pk_bf16(v1[0], v1[1]); w.w = cvt_pk_bf16(v1[2], v1[3]);
                    *(u32x4*)(rowp + bj * HALF) = w; } }
    }
};

constexpr int QKV_LD = 2304, SEQ_LEN = 16384;
struct EpiQKV {
    static constexpr bool PERM = true, AFTER_DRAIN = false;
    bf16_t* O; const float* rope; float qscale; int norope; unsigned* kmax;
    __device__ __forceinline__ void operator()(const f32x4 (&acc)[2][2][4][2], const Unit& u, int wr, int wc, int fr, int fq) const {
        const int row0 = u.pm * BM + wr * 64 + fr;
#pragma unroll
        for (int bj = 0; bj < 2; ++bj) {
            const int cb = u.pn * BM + bj * HALF, col0 = cb + wc * 32 + 8 * fq;
            const bool isrope = !norope && ((cb < 1024) || (cb >= 1536 && cb < 2176));
            const float sc = ((cb < 512) || (cb >= 1536 && cb < 2048)) ? qscale : 1.f;
            const int i0 = (col0 & 63) >> 1;
            const bool iskd = ((cb >= 512) && (cb < 1024)) || cb == 2048; float kmx = 0.f;
#pragma unroll
            for (int ai = 0; ai < 2; ++ai)
#pragma unroll
                for (int m = 0; m < 4; ++m) {
                    const int row = row0 + ai * HALF + m * 16;
                    f32x4 v0 = acc[ai][bj][m][0], v1 = acc[ai][bj][m][1];
                    if (isrope) {
                        const int pos = row & (SEQ_LEN - 1);
                        const f32x4* tp = (const f32x4*)(rope + ((size_t)pos * 32 + i0) * 2);
                        const f32x4 t0 = tp[0], t1 = tp[1];
                        f32x4 r0, r1;
                        r0[0] = v0[0] * t0[0] - v0[1] * t0[1]; r0[1] = v0[0] * t0[1] + v0[1] * t0[0];
                        r0[2] = v0[2] * t0[2] - v0[3] * t0[3]; r0[3] = v0[2] * t0[3] + v0[3] * t0[2];
                        r1[0] = v1[0] * t1[0] - v1[1] * t1[1]; r1[1] = v1[0] * t1[1] + v1[1] * t1[0];
                        r1[2] = v1[2] * t1[2] - v1[3] * t1[3]; r1[3] = v1[2] * t1[3] + v1[3] * t1[2];
                        v0 = r0; v1 = r1;
                    }
                    if (iskd) kmx = __builtin_fmaxf(kmx, (v0[0] * v0[0] + v0[1] * v0[1]) + (v0[2] * v0[2] + v0[3] * v0[3]) + (v1[0] * v1[0] + v1[1] * v1[1]) + (v1[2] * v1[2] + v1[3] * v1[3]));
                    v0 = v0 * sc; v1 = v1 * sc;
                    u32x4 w; w.x = cvt_pk_bf16(v0[0], v0[1]); w.y = cvt_pk_bf16(v0[2], v0[3]); w.z = cvt_pk_bf16(v1[0], v1[1]); w.w = cvt_pk_bf16(v1[2], v1[3]);
                    *(u32x4*)(O + (size_t)row * QKV_LD + col0) = w;
                }
            if (iskd) {
                kmx = __builtin_fmaxf(kmx, __builtin_bit_cast(float, __builtin_amdgcn_mov_dpp(__builtin_bit_cast(int, kmx), 0xB1, 0xF, 0xF, true)));
                kmx = __builtin_fmaxf(kmx, __builtin_bit_cast(float, __builtin_amdgcn_mov_dpp(__builtin_bit_cast(int, kmx), 0x4E, 0xF, 0xF, true)));
                kmx = __builtin_fmaxf(kmx, __builtin_bit_cast(float, __builtin_amdgcn_mov_dpp(__builtin_bit_cast(int, kmx), 0x141, 0xF, 0xF, true)));
                kmx = __builtin_fmaxf(kmx, __builtin_bit_cast(float, __builtin_amdgcn_mov_dpp(__builtin_bit_cast(int, kmx), 0x140, 0xF, 0xF, true)));
                const int slot = cb < 1024 ? (((u.pm >> 6) * 8 + ((cb + wc * 32 - 512) >> 6)) * 8) : (128 + ((u.pm >> 6) * 2 + (wc >> 1)) * 8);
                if (fr == 0) __hip_atomic_fetch_max(kmax + slot + (wc & 1) * 4 + fq, __builtin_bit_cast(unsigned, kmx), __ATOMIC_RELAXED, __HIP_MEMORY_SCOPE_AGENT); }
        }
    }
};
struct EpiResid {
    static constexpr bool PERM = true, AFTER_DRAIN = false;
    const float* x; bf16_t* hb;
    __device__ __forceinline__ void operator()(const f32x4 (&acc)[2][2][4][2], const Unit& u, int wr, int wc, int fr, int fq) const {
        const int row0 = u.pm * BM + wr * 64 + fr;
#pragma unroll
        for (int ai = 0; ai < 2; ++ai)
#pragma unroll
            for (int m = 0; m < 4; ++m) {
                const size_t ro = (size_t)(row0 + ai * HALF + m * 16) * 1024;
#pragma unroll
                for (int bj = 0; bj < 2; ++bj) {
                    const size_t o = ro + u.pn * BM + bj * HALF + wc * 32 + 8 * fq;
                    const f32x4 v0 = acc[ai][bj][m][0] + *(const f32x4*)(x + o), v1 = acc[ai][bj][m][1] + *(const f32x4*)(x + o + 4);
                    u32x4 w; w.x = cvt_pk_bf16(v0[0], v0[1]); w.y = cvt_pk_bf16(v0[2], v0[3]); w.z = cvt_pk_bf16(v1[0], v1[1]); w.w = cvt_pk_bf16(v1[2], v1[3]);
                    *(u32x4*)(hb + o) = w;
                }
            }
    }
};
__device__ __forceinline__ float silu_mul(float g, float up) { return g * __builtin_amdgcn_rcpf(1.0f + __builtin_amdgcn_exp2f(-1.4426950408889634f * g)) * up; }
struct EpiGateUp {
    static constexpr bool PERM = true, AFTER_DRAIN = false;
    bf16_t* hm; const float* slot_rstd;
    __device__ __forceinline__ void operator()(const f32x4 (&acc)[2][2][4][2], const Unit& u, int wr, int wc, int fr, int fq) const {
        const int row0 = u.pm * BM + wr * 64 + fr, f0 = (u.pn & 3) * 128 + wc * 32 + 8 * fq;
#pragma unroll
        for (int ai = 0; ai < 2; ++ai)
#pragma unroll
            for (int m = 0; m < 4; ++m) {
                const int row = row0 + ai * HALF + m * 16; const float rs = slot_rstd[row];
                const f32x4 g0 = acc[ai][0][m][0] * rs, g1 = acc[ai][0][m][1] * rs, u0 = acc[ai][1][m][0] * rs, u1 = acc[ai][1][m][1] * rs;
                u32x4 w; w.x = cvt_pk_bf16(silu_mul(g0[0], u0[0]), silu_mul(g0[1], u0[1])); w.y = cvt_pk_bf16(silu_mul(g0[2], u0[2]), silu_mul(g0[3], u0[3]));
                w.z = cvt_pk_bf16(silu_mul(g1[0], u1[0]), silu_mul(g1[1], u1[1])); w.w = cvt_pk_bf16(silu_mul(g1[2], u1[2]), silu_mul(g1[3], u1[3]));
                *(u32x4*)(hm + (size_t)row * 512 + f0) = w;
            }
    }
};
struct EpiDown {
    static constexpr bool PERM = true, AFTER_DRAIN = false;
    bf16_t* Y; const int* slot_dst; const float* slot_gate;
    __device__ __forceinline__ void operator()(const f32x4 (&acc)[2][2][4][2], const Unit& u, int wr, int wc, int fr, int fq) const {
        const int row0 = u.pm * BM + wr * 64 + fr, c0 = (u.pn & 3) * BM + wc * 32 + 8 * fq;
#pragma unroll
        for (int ai = 0; ai < 2; ++ai)
#pragma unroll
            for (int m = 0; m < 4; ++m) {
                const int row = row0 + ai * HALF + m * 16; const int dst = slot_dst[row]; const float gt = slot_gate[row];
                if (dst >= 0) {
#pragma unroll
                    for (int bj = 0; bj < 2; ++bj) { const f32x4 v0 = acc[ai][bj][m][0] * gt, v1 = acc[ai][bj][m][1] * gt;
                        u32x4 w; w.x = cvt_pk_bf16(v0[0], v0[1]); w.y = cvt_pk_bf16(v0[2], v0[3]); w.z = cvt_pk_bf16(v1[0], v1[1]); w.w = cvt_pk_bf16(v1[2], v1[3]);
                        *(u32x4*)(Y + (size_t)dst * 1024 + c0 + bj * HALF) = w; }
                }
            }
    }
};
struct MoeSched {
    const unsigned* blk_e; int nunits, G, c;
    __device__ __forceinline__ bool next(int i, Unit& u) const {
        const long L = (long)i * G + c; if (L >= nunits) return false;
        int wgid = (int)L; { const int q = nunits / NXCD, r = nunits % NXCD, xcd = wgid % NXCD, off = wgid / NXCD; wgid = (xcd < r ? xcd * (q + 1) : r * (q + 1) + (xcd - r) * q) + off; }
        const int rb = wgid >> 2, j = wgid & 3;
        const int e = __builtin_amdgcn_readfirstlane((int)__hip_atomic_load(blk_e + rb, __ATOMIC_RELAXED, __HIP_MEMORY_SCOPE_AGENT));
        u.pm = rb; u.pn = e * 4 + j; return true;
    }
    __device__ __forceinline__ void a_ready(const Unit&) const {}
    __device__ __forceinline__ void done(const Unit&) const {}
};
template <class Epi, class Sched, bool ALIGN_EPI = false, bool SP2 = false, bool GATHER = false>
__device__ __forceinline__ void gemm_phase(PG8_LAS unsigned char* lds, const Gemm g, const Sched& S, const Epi& E, PG8_LAS const int* rowtab = nullptr) {
    static_assert(!GATHER || SP2, "GATHER is wired into the SP2 loop only");
    int tid_ = threadIdx.x; asm volatile("" : "+v"(tid_));
    const int tid = tid_, wid = __builtin_amdgcn_readfirstlane(tid >> 6), lane = tid & 63, wr = wid >> 2, wc = wid & 3, fr = lane & 15, fq = lane >> 4;
    const int K = g.K, nt = K / BK;
    unsigned voffA[2], voffB[2];
#pragma unroll
    for (int i = 0; i < 2; ++i) { int R, C; stage_rc(tid * 16 + i * 8192, R, C); const int Rb = Epi::PERM ? ((R & ~31) + perm32(R & 31)) : R;
        voffA[i] = (unsigned)(R * K + C) * 2u; voffB[i] = (unsigned)(Rb * K + C) * 2u; }
    const size_t kstep = (size_t)(BK * 2);
    const size_t hstep = (size_t)HALF * K * 2;
    const size_t tstep = 2 * hstep;
    const unsigned ldsw = (unsigned)wid * 1024u;
    const int aoff = lds_byte(wr * 64 + fr, fq * 8), boff = lds_byte(wc * 32 + fr, fq * 8);
#define PG8_SA(b, h) (((b) * 2 + (h)) * HTB)
#define PG8_SB(b, h) ((4 + (b) * 2 + (h)) * HTB)
#define PG8_STAGE(bufoff, gbase, voff) do { _Pragma("unroll") for (int _i = 0; _i < 2; ++_i) \
        __builtin_amdgcn_global_load_lds((const unsigned*)((const char*)(gbase) + (voff)[_i]), (PG8_LAS unsigned*)(lds + (bufoff) + ldsw + _i * 8192), 16, 0, 0); } while (0)
#define PG8_LDA(dst, b, h) do { _Pragma("unroll") for (int m = 0; m < 4; ++m) _Pragma("unroll") for (int k = 0; k < 2; ++k) dst[m][k] = *(const PG8_LAS bf16x8*)(lds + PG8_SA(b, h) + aoff + m * 2048 + k * 1024); } while (0)
#define PG8_LDB(dst, b, h) do { _Pragma("unroll") for (int n = 0; n < 2; ++n) _Pragma("unroll") for (int k = 0; k < 2; ++k) dst[n][k] = *(const PG8_LAS bf16x8*)(lds + PG8_SB(b, h) + boff + n * 2048 + k * 1024); } while (0)
#define PG8_MMA(ai, bj, At, Bt) do { __builtin_amdgcn_s_setprio(1); _Pragma("unroll") for (int m = 0; m < 4; ++m) _Pragma("unroll") for (int n = 0; n < 2; ++n) _Pragma("unroll") for (int k = 0; k < 2; ++k) \
        acc[ai][bj][m][n] = __builtin_amdgcn_mfma_f32_16x16x32_bf16(Bt[n][k], At[m][k], acc[ai][bj][m][n], 0, 0, 0); __builtin_amdgcn_s_setprio(0); } while (0)
#define PG8_WAIT_V(n) asm volatile("s_waitcnt vmcnt(" #n ")" ::: "memory")
#define PG8_WAIT_L(n) asm volatile("s_waitcnt lgkmcnt(" #n ")" ::: "memory")
#define PG8_BAR __builtin_amdgcn_s_barrier()
#define PG8_SCHED __builtin_amdgcn_sched_barrier(0)
    Unit cur, nxt; int ui = 0;
    if (!S.next(0, cur)) return;
    f32x4 acc[2][2][4][2];
#pragma unroll
    for (int a = 0; a < 2; ++a)
#pragma unroll
        for (int b = 0; b < 2; ++b)
#pragma unroll
            for (int m = 0; m < 4; ++m)
#pragma unroll
                for (int n = 0; n < 2; ++n) acc[a][b][m][n] = (f32x4){0.f, 0.f, 0.f, 0.f};
    bf16x8 At[4][2], B0[2][2], B1[2][2];
    const char* cA = GATHER ? (const char*)g.A : (const char*)g.A + (size_t)cur.pm * tstep; const char* cB = (const char*)g.Bt + (size_t)cur.pn * tstep;
    const size_t hstepA = GATHER ? 0 : hstep;
    unsigned gc[2][2], gn[2][2];
#define PG8_GLOAD(uidx, o) do { _Pragma("unroll") for (int _h = 0; _h < 2; ++_h) _Pragma("unroll") for (int _i = 0; _i < 2; ++_i) { int R_, C_; stage_rc(tid * 16 + _i * 8192, R_, C_); \
        o[_h][_i] = (unsigned)(rowtab[(uidx) * 256 + _h * HALF + R_] * K + C_) * 2u; } } while (0)
    if constexpr (GATHER) { PG8_GLOAD(0, gc); } else { gc[0][0] = gc[1][0] = voffA[0]; gc[0][1] = gc[1][1] = voffA[1]; }
#define PG8_ACUR(bufoff, half, kt) PG8_STAGE(bufoff, cA + (half) * hstepA + (size_t)(kt) * kstep, gc[half])
    S.a_ready(cur);
    if constexpr (SP2) {
        PG8_STAGE(PG8_SB(0, 0), cB, voffB); PG8_STAGE(PG8_SB(0, 1), cB + hstep, voffB); PG8_ACUR(PG8_SA(0, 0), 0, 0); PG8_ACUR(PG8_SA(0, 1), 1, 0);
        if (wr == 1) PG8_BAR;
        PG8_WAIT_V(2); PG8_BAR;
        PG8_STAGE(PG8_SB(1, 0), cB + kstep, voffB); PG8_ACUR(PG8_SA(1, 0), 0, 1); PG8_STAGE(PG8_SB(1, 1), cB + hstep + kstep, voffB);
        PG8_WAIT_V(6); PG8_BAR;
    } else {
        PG8_STAGE(PG8_SB(0, 0), cB, voffB); PG8_STAGE(PG8_SA(0, 0), cA, voffA); PG8_STAGE(PG8_SB(0, 1), cB + hstep, voffB); PG8_STAGE(PG8_SA(0, 1), cA + hstep, voffA);
        if (wr == 1) PG8_BAR;
        PG8_WAIT_V(4); PG8_BAR;
        PG8_STAGE(PG8_SB(1, 0), cB + kstep, voffB); PG8_STAGE(PG8_SA(1, 0), cA + kstep, voffA); PG8_STAGE(PG8_SB(1, 1), cB + hstep + kstep, voffB);
        PG8_WAIT_V(6); PG8_BAR;
    }
    for (;;) {
        const bool has_next = S.next(ui + 1, nxt);
        const char* nA = GATHER ? cA : (has_next ? (const char*)g.A + (size_t)nxt.pm * tstep : cA); const char* nB = has_next ? (const char*)g.Bt + (size_t)nxt.pn * tstep : cB;
        if constexpr (GATHER) { if (has_next) { PG8_GLOAD(ui + 1, gn); } else { gn[0][0] = gc[0][0]; gn[0][1] = gc[0][1]; gn[1][0] = gc[1][0]; gn[1][1] = gc[1][1]; } }
        else { gn[0][0] = gc[0][0]; gn[0][1] = gc[0][1]; gn[1][0] = gc[1][0]; gn[1][1] = gc[1][1]; }
        for (int t = 0; t < nt; t += 2) {
            const bool last = (t == nt - 2);
            const char* a1 = cA + (size_t)(t + 1) * kstep;
            const char* a2 = last ? nA : cA + (size_t)(t + 2) * kstep; const char* b2 = last ? nB : cB + (size_t)(t + 2) * kstep;
            const char* a3 = a2 + kstep; const char* b3 = b2 + kstep;
            unsigned o2[2][2];
            o2[0][0] = last ? gn[0][0] : gc[0][0]; o2[0][1] = last ? gn[0][1] : gc[0][1]; o2[1][0] = last ? gn[1][0] : gc[1][0]; o2[1][1] = last ? gn[1][1] : gc[1][1];
            if (last && has_next) S.a_ready(nxt);
            if constexpr (SP2) {
            PG8_LDB(B0, 0, 0); PG8_LDB(B1, 0, 1); PG8_SCHED; PG8_LDA(At, 0, 0); PG8_STAGE(PG8_SA(1, 1), a1 + hstepA, gc[1]);
            PG8_WAIT_V(8); PG8_WAIT_L(0); PG8_BAR; PG8_MMA(0, 0, At, B0); PG8_MMA(0, 1, At, B1); PG8_BAR; PG8_SCHED;
            PG8_LDA(At, 0, 1); PG8_STAGE(PG8_SB(0, 0), b2, voffB); PG8_STAGE(PG8_SB(0, 1), b2 + hstep, voffB); PG8_STAGE(PG8_SA(0, 0), a2, o2[0]);
            PG8_WAIT_V(8); PG8_WAIT_L(0); PG8_BAR; PG8_MMA(1, 0, At, B0); PG8_MMA(1, 1, At, B1); PG8_BAR; PG8_SCHED;
            PG8_LDB(B0, 1, 0); PG8_LDB(B1, 1, 1); PG8_SCHED; PG8_LDA(At, 1, 0); PG8_STAGE(PG8_SA(0, 1), a2 + hstepA, o2[1]);
            PG8_WAIT_V(8); PG8_WAIT_L(0); PG8_BAR; PG8_MMA(0, 0, At, B0); PG8_MMA(0, 1, At, B1); PG8_BAR; PG8_SCHED;
            PG8_LDA(At, 1, 1); PG8_STAGE(PG8_SB(1, 0), b3, voffB); PG8_STAGE(PG8_SB(1, 1), b3 + hstep, voffB); PG8_STAGE(PG8_SA(1, 0), a3, o2[0]);
            PG8_WAIT_V(8); PG8_WAIT_L(0); PG8_BAR; PG8_MMA(1, 0, At, B0); PG8_MMA(1, 1, At, B1); PG8_BAR; PG8_SCHED;
            } else {
            PG8_LDB(B0, 0, 0); PG8_SCHED; PG8_LDA(At, 0, 0); PG8_STAGE(PG8_SA(1, 1), a1 + hstep, voffA);
            PG8_WAIT_L(8); PG8_BAR; PG8_WAIT_L(0); PG8_MMA(0, 0, At, B0); PG8_BAR; PG8_SCHED;
            PG8_LDB(B1, 0, 1); PG8_STAGE(PG8_SB(0, 0), b2, voffB);
            PG8_BAR; PG8_WAIT_L(0); PG8_MMA(0, 1, At, B1); PG8_BAR;
            PG8_LDA(At, 0, 1); PG8_STAGE(PG8_SA(0, 0), a2, voffA);
            PG8_BAR; PG8_WAIT_L(0); PG8_MMA(1, 0, At, B0); PG8_BAR; PG8_SCHED;
            PG8_STAGE(PG8_SB(0, 1), b2 + hstep, voffB);
            PG8_WAIT_V(6); PG8_BAR; PG8_MMA(1, 1, At, B1); PG8_BAR;
            PG8_LDB(B0, 1, 0); PG8_SCHED; PG8_LDA(At, 1, 0); PG8_STAGE(PG8_SA(0, 1), a2 + hstep, voffA);
            PG8_WAIT_L(8); PG8_BAR; PG8_WAIT_L(0); PG8_MMA(0, 0, At, B0); PG8_BAR; PG8_SCHED;
            PG8_LDB(B1, 1, 1); PG8_STAGE(PG8_SB(1, 0), b3, voffB);
            PG8_BAR; PG8_WAIT_L(0); PG8_MMA(0, 1, At, B1); PG8_BAR;
            PG8_LDA(At, 1, 1); PG8_STAGE(PG8_SA(1, 0), a3, voffA);
            PG8_BAR; PG8_WAIT_L(0); PG8_MMA(1, 0, At, B0); PG8_BAR; PG8_SCHED;
            PG8_STAGE(PG8_SB(1, 1), b3 + hstep, voffB);
            PG8_WAIT_V(6); PG8_BAR; PG8_MMA(1, 1, At, B1); PG8_BAR;
            }
        }
        if constexpr (ALIGN_EPI) { if (wr == 0) PG8_BAR; }
        if constexpr (!Epi::AFTER_DRAIN) { E(acc, cur, wr, wc, fr, fq); S.done(cur); }
        if (!has_next) break;
#pragma unroll
        for (int a = 0; a < 2; ++a)
#pragma unroll
            for (int b = 0; b < 2; ++b)
#pragma unroll
                for (int m = 0; m < 4; ++m)
#pragma unroll
                    for (int n = 0; n < 2; ++n) acc[a][b][m][n] = (f32x4){0.f, 0.f, 0.f, 0.f};
        cur = nxt; cA = nA; cB = nB; ++ui; gc[0][0] = gn[0][0]; gc[0][1] = gn[0][1]; gc[1][0] = gn[1][0]; gc[1][1] = gn[1][1];
        if constexpr (ALIGN_EPI) { if (wr == 1) PG8_BAR; }
    }
    PG8_WAIT_V(0);
    if constexpr (!ALIGN_EPI) { if (wr == 0) PG8_BAR; }
    PG8_BAR;
    if constexpr (Epi::AFTER_DRAIN) { E.fused(acc, cur, wr, wc, fr, fq, lds, wid, lane); S.done(cur); }
#undef PG8_SA
#undef PG8_SB
#undef PG8_STAGE
#undef PG8_GLOAD
#undef PG8_ACUR
#undef PG8_LDA
#undef PG8_LDB
#undef PG8_MMA
#undef PG8_WAIT_V
#undef PG8_WAIT_L
#undef PG8_BAR
#undef PG8_SCHED
}
}

#ifndef PG8_SP2
#define PG8_SP2 true
#endif
#ifndef PG8_ALIGN
#define PG8_ALIGN true
#endif
#include <hip/hip_bf16.h>
#include <cmath>
namespace attn_body {
using bf16=__hip_bfloat16;
using bf16x8=__attribute__((ext_vector_type(8)))short;
using s16x4=__attribute__((ext_vector_type(4)))short;
using f32x16=__attribute__((ext_vector_type(16)))float;
using u32x4=__attribute__((ext_vector_type(4)))unsigned;
constexpr int D=64,PQ=2304,PO=1024,WIN=128;
constexpr int NW=8,QBLK=32,QB=QBLK*NW,KVBLK=64;
constexpr int ATTN_UNIT_ROWS=QB;
__device__ __forceinline__ int crow(int r,int hi){return (r&3)+8*(r>>2)+4*hi;}
#define SBAR() __builtin_amdgcn_sched_barrier(0)
template<int MODE> __device__ __forceinline__ void cmask(f32x16&p0,f32x16&p1,int jb,int qrel,int hi){
  const float NEG=-INFINITY; int kb=64*jb+4*hi;
  #pragma unroll
  for(int r=0;r<16;++r){int kv=kb+(r&3)+8*(r>>2);
    if(MODE==1){ if((unsigned)(qrel-kv)>=(unsigned)WIN)p0[r]=NEG; if((unsigned)(qrel-kv-32)>=(unsigned)WIN)p1[r]=NEG; }
    else { if(kv>qrel)p0[r]=NEG; if(kv+32>qrel)p1[r]=NEG; } }
}

constexpr int NSLOT=3, SLOTB=8192;
constexpr int LDS_K=0, LDS_V=NSLOT*SLOTB, LDS_WS=2*NSLOT*SLOTB, LDS_OST=LDS_WS+NW*64*4, LDS_BYTES=LDS_OST+NW*4096;
constexpr float C2=0.125f*1.4426950408889634f;
__device__ __forceinline__ void glds16(const void*gsrc,unsigned lds_dst){unsigned keep;
  asm volatile("s_mov_b32 %0, m0\n\ts_mov_b32 m0, %2\n\ts_nop 0\n\tglobal_load_lds_dwordx4 %1, off\n\ts_mov_b32 m0, %0":"=&s"(keep):"v"(gsrc),"s"(lds_dst):"memory");}
__device__ __forceinline__ float max3f(float a,float b,float c){float r;asm("v_max3_f32 %0, %1, %2, %3":"=v"(r):"v"(a),"v"(b),"v"(c));return r;}
__device__ __forceinline__ float max2f(float a,float b){float r;asm("v_max_f32_e32 %0, %1, %2":"=v"(r):"v"(a),"v"(b));return r;}
__device__ __forceinline__ float fadd_s(float a,float b){float r;asm("v_add_f32_e32 %0, %1, %2":"=v"(r):"v"(a),"v"(b));return r;}
__device__ __forceinline__ float fsub_s(float a,float b){float r;asm("v_sub_f32_e32 %0, %1, %2":"=v"(r):"v"(a),"v"(b));return r;}
typedef float f32x2_t __attribute__((ext_vector_type(2))); typedef __bf16 bf16x2_t __attribute__((ext_vector_type(2)));
__device__ __forceinline__ unsigned cvtpk_s(float lo,float hi){f32x2_t v={lo,hi};bf16x2_t b=__builtin_convertvector(v,bf16x2_t);return __builtin_bit_cast(unsigned,b);}
#define WAIT_BAR(N) asm volatile("s_waitcnt vmcnt(" #N ") lgkmcnt(0)\n\ts_barrier":::"memory")

__device__ __forceinline__ void qkt(f32x16&p0,f32x16&p1,const char*Kslot,const bf16x8*qr,const f32x16&negm,int r32,int hi){
  const char*kb=Kslot+hi*1024+r32*16;
  #pragma unroll
  for(int d0=0;d0<4;++d0){
    const bf16x8 b0=*reinterpret_cast<const bf16x8*>(kb+d0*2048);
    const bf16x8 b1=*reinterpret_cast<const bf16x8*>(kb+d0*2048+512);
    if(d0==0){p0=__builtin_amdgcn_mfma_f32_32x32x16_bf16(b0,qr[0],negm,0,0,0);p1=__builtin_amdgcn_mfma_f32_32x32x16_bf16(b1,qr[0],negm,0,0,0);}
    else{p0=__builtin_amdgcn_mfma_f32_32x32x16_bf16(b0,qr[d0],p0,0,0,0);p1=__builtin_amdgcn_mfma_f32_32x32x16_bf16(b1,qr[d0],p1,0,0,0);}}
}
typedef __attribute__((address_space(3))) const char* lds_cptr;
typedef short v4i16_t __attribute__((ext_vector_type(4)));
__device__ __forceinline__ void kload8(bf16x8*kf,lds_cptr kp){
  kf[0]=*(const __attribute__((address_space(3))) bf16x8*)(kp);      kf[1]=*(const __attribute__((address_space(3))) bf16x8*)(kp+512);
  kf[2]=*(const __attribute__((address_space(3))) bf16x8*)(kp+2048); kf[3]=*(const __attribute__((address_space(3))) bf16x8*)(kp+2560);
  kf[4]=*(const __attribute__((address_space(3))) bf16x8*)(kp+4096); kf[5]=*(const __attribute__((address_space(3))) bf16x8*)(kp+4608);
  kf[6]=*(const __attribute__((address_space(3))) bf16x8*)(kp+6144); kf[7]=*(const __attribute__((address_space(3))) bf16x8*)(kp+6656);
}
__device__ __forceinline__ void kload2(bf16x8*kf,lds_cptr kp,int j){ kf[2*j]=*(const __attribute__((address_space(3))) bf16x8*)(kp+j*2048); kf[2*j+1]=*(const __attribute__((address_space(3))) bf16x8*)(kp+j*2048+512); }
__device__ __forceinline__ s16x4 vtr(lds_cptr p){ return __builtin_bit_cast(s16x4,__builtin_amdgcn_ds_read_tr16_b64_v4i16((__attribute__((address_space(3))) v4i16_t*)p)); }
__device__ __forceinline__ float rowmax(const f32x16&p0,const f32x16&p1){
  float a=max3f(p0[0],p0[1],p1[0]),b=max3f(p0[2],p0[3],p1[1]);a=max3f(a,p1[2],p1[3]);
  #pragma unroll
  for(int r=4;r<16;r+=4){a=max3f(a,p0[r],p0[r+1]);b=max3f(b,p0[r+2],p0[r+3]);a=max3f(a,p1[r],p1[r+1]);b=max3f(b,p1[r+2],p1[r+3]);}
  const float m=max2f(a,b);
  auto rr=__builtin_amdgcn_permlane32_swap(__float_as_uint(m),__float_as_uint(m),false,false);
  return max2f(__uint_as_float(rr[0]),__uint_as_float(rr[1]));
}
__device__ __forceinline__ void pv(f32x16*o,int vb,bf16x8 pa0,bf16x8 pa1,bf16x8 pa2,bf16x8 pa3){
  #pragma unroll
  for(int d0=0;d0<2;++d0){s16x4 lo[4],hi[4];
    #pragma unroll
    for(int ks=0;ks<4;++ks){
      asm volatile("ds_read_b64_tr_b16 %0,%1 offset:%c2":"=&v"(lo[ks]):"v"(vb),"i"(d0*4096+ks*1024):"memory");
      asm volatile("ds_read_b64_tr_b16 %0,%1 offset:%c2":"=&v"(hi[ks]):"v"(vb),"i"(d0*4096+ks*1024+512):"memory");}
    asm volatile("s_waitcnt lgkmcnt(0)":::"memory");SBAR();
    #define PK(k) (bf16x8){lo[k][0],lo[k][1],lo[k][2],lo[k][3],hi[k][0],hi[k][1],hi[k][2],hi[k][3]}
    o[d0]=__builtin_amdgcn_mfma_f32_32x32x16_bf16(pa0,PK(0),o[d0],0,0,0);
    o[d0]=__builtin_amdgcn_mfma_f32_32x32x16_bf16(pa1,PK(1),o[d0],0,0,0);
    o[d0]=__builtin_amdgcn_mfma_f32_32x32x16_bf16(pa2,PK(2),o[d0],0,0,0);
    o[d0]=__builtin_amdgcn_mfma_f32_32x32x16_bf16(pa3,PK(3),o[d0],0,0,0);
    #undef PK
  }
}

#ifndef ATTN_STORE16
#define ATTN_STORE16(p,v) (*(u32x4*)(p)=(v))
#endif
template<int MODE,int THRL> __device__ __forceinline__ void attn_unit(const bf16*Qh,const bf16*__restrict__ Kh,const bf16*__restrict__ Vh,bf16*Oh,int q0,int kt0,const int NT,float sink2,char*shm){
  int tid_=threadIdx.x; asm volatile("":"+v"(tid_)); const int tid=tid_,lane=tid&63,r32=lane&31,hi=lane>>5; const int wid=__builtin_amdgcn_readfirstlane(tid>>6);
  const bf16*Qw=Qh+(long)(q0+wid*QBLK)*PQ;
  const unsigned lds0=(unsigned)(uintptr_t)shm;
  float*wsf=(float*)(shm+LDS_WS)+wid*64;
  const bf16*ksrc=Kh+(long)(kt0*KVBLK+lane)*PQ+wid*8;
  const bf16*vsrc=Vh+(long)(kt0*KVBLK+16*(wid&3)+(lane>>2))*PQ+(wid>>2)*32+(lane&3)*8;
  const unsigned kdst=lds0+LDS_K+wid*1024, vdst=lds0+LDS_V+wid*1024;
  #define DMA_K(t,slot) glds16(ksrc+(long)(t)*KVBLK*PQ,(unsigned)__builtin_amdgcn_readfirstlane(kdst+(slot)))
  #define DMA_V(t,slot) glds16(vsrc+(long)(t)*KVBLK*PQ,(unsigned)__builtin_amdgcn_readfirstlane(vdst+(slot)))
  const int vb0=(int)(lds0+LDS_V)+((lane>>4)&1)*32+(lane&3)*8+(4*hi+((lane&15)>>2))*64;
  const char*Kbase=shm+LDS_K; bf16x8 kf[8];
  const lds_cptr shm3=(lds_cptr)shm; const lds_cptr kp0=shm3+LDS_K+hi*1024+r32*16; const lds_cptr vp0=shm3+LDS_V+((lane>>4)&1)*32+(lane&3)*8+(4*hi+((lane&15)>>2))*64;
  DMA_K(0,0);DMA_V(0,0);DMA_K(1,SLOTB);
  bf16x8 qr[4];
  #pragma unroll
  for(int d0=0;d0<4;++d0)qr[d0]=*reinterpret_cast<const bf16x8*>(&Qw[(long)r32*PQ+d0*16+hi*8]);
  float mhat=0.f,l_reg=0.f;f32x16 o[2];o[0]=f32x16{};o[1]=f32x16{};f32x16 negm=f32x16{};asm volatile("":"+v"(negm));
  const int qrel=wid*QBLK+r32;
  #define CMASK(P0,P1,t) do{int jb_=(t)-(NT-4); if(MODE==1||jb_>=0)cmask<MODE>(P0,P1,jb_,qrel,hi);}while(0)
  bool resc=false;
  #define START(P0,P1) do{ const float rm=rowmax(P0,P1); resc=false; \
    { const float dl=(MODE==1)?__builtin_fmaxf(rm,-60.f):rm; mhat=fadd_s(mhat,dl); \
      _Pragma("unroll") for(int r=0;r<16;++r){P0[r]=fsub_s(P0[r],dl);P1[r]=fsub_s(P1[r],dl);} \
      _Pragma("unroll") for(int r=0;r<16;++r)negm[r]=-mhat; asm volatile("":"+v"(negm)); } \
    _Pragma("unroll") for(int r=0;r<16;++r)P0[r]=__builtin_amdgcn_exp2f(P0[r]); }while(0)
  #define RESC() do{ if(resc){ asm volatile("s_waitcnt lgkmcnt(0)":::"memory"); \
      _Pragma("unroll") for(int d_=0;d_<2;++d_) _Pragma("unroll") for(int r=0;r<16;++r)o[d_][r]*=wsf[crow(r,hi)]; } }while(0)
  f32x16 pA0,pA1,pB0,pB1;
  int sl_prev=0,sl_cur=0,sl_next=SLOTB;
  #define ROT() do{sl_prev=sl_cur;sl_cur=sl_next;sl_next=(sl_next==(NSLOT-1)*SLOTB)?0:sl_next+SLOTB;}while(0)
  DMA_K(2,2*SLOTB);
  WAIT_BAR(3);
  qkt(pA0,pA1,Kbase,qr,negm,r32,hi);asm volatile("s_nop 15\n\ts_nop 7":"+v"(pA0),"+v"(pA1));CMASK(pA0,pA1,0);
  START(pA0,pA1);
  _Pragma("unroll") for(int r=0;r<16;++r)pA1[r]=__builtin_amdgcn_exp2f(pA1[r]);
  WAIT_BAR(0);
  DMA_K(3,0);DMA_V(1,SLOTB);
  ROT();
  kload8(kf,kp0+sl_cur);
  WAIT_BAR(2);
  s16x4 vlo[8],vhi[8]; u32x4 pw0,pw1,pw2,pw3;
  #define PKW(P,B) cvtpk_s(P[B],P[B+1])
  #define PAF(k) __builtin_bit_cast(bf16x8,pw##k)
  #define VFR(i) (bf16x8){vlo[i][0],vlo[i][1],vlo[i][2],vlo[i][3],vhi[i][0],vhi[i][1],vhi[i][2],vhi[i][3]}
  #define PIN(x) asm volatile("":"+v"(x))
  #define MX3(a,b,c) __builtin_fmaxf(__builtin_fmaxf((a),(b)),(c))
  #define GAPA(MF,A0,A1,A2,A3,W0,W1,PW) do{ MF; sacc+=A0; sacc+=A1; sacc+=A2; sacc+=A3; PIN(sacc); W0; W1; PIN(PW); SBAR(); }while(0)
  #define EX(v) __builtin_amdgcn_exp2f(v)
  #define GAPB(MF,X,B) do{ MF; X[B]=EX(X[B]); X[B+1]=EX(X[B+1]); X[B+2]=EX(X[B+2]); X[B+3]=EX(X[B+3]); PIN(X); SBAR(); }while(0)
  #define VRD(i) do{ vlo[i]=vtr(vp_+(((i)>>2)*4096+((i)&3)*1024)); vhi[i]=vtr(vp_+(((i)>>2)*4096+((i)&3)*1024+512)); }while(0)
  #define KRD(G,j) do{ if(G){ kload2(kf,kp0+sl_next,j); SBAR(); } }while(0)
  #define STEP(C0,C1,P0,P1,t,GK,GV,GL) do{ SBAR(); \
    const lds_cptr vp_=vp0+sl_prev; \
    VRD(0); SBAR(); float sacc=(P0[0]+P0[1]); \
    GAPA(C0=__builtin_amdgcn_mfma_f32_32x32x16_bf16(kf[0],qr[0],negm,0,0,0), P0[2],P0[3],P0[4],P0[5],     pw0[0]=PKW(P0,0), pw0[1]=PKW(P0,2), pw0); \
    VRD(4); SBAR(); GAPA(C1=__builtin_amdgcn_mfma_f32_32x32x16_bf16(kf[1],qr[0],negm,0,0,0), P0[6],P0[7],P0[8],P0[9],     pw0[2]=PKW(P0,4), pw0[3]=PKW(P0,6), pw0); \
    VRD(1); SBAR(); GAPA(C0=__builtin_amdgcn_mfma_f32_32x32x16_bf16(kf[2],qr[1],C0,0,0,0),   P0[10],P0[11],P0[12],P0[13], pw1[0]=PKW(P0,8), pw1[1]=PKW(P0,10), pw1); \
    VRD(5); SBAR(); GAPA(C1=__builtin_amdgcn_mfma_f32_32x32x16_bf16(kf[3],qr[1],C1,0,0,0),   P0[14],P0[15],P1[0],P1[1],   pw1[2]=PKW(P0,12),pw1[3]=PKW(P0,14), pw1); \
    VRD(2); SBAR(); GAPA(C0=__builtin_amdgcn_mfma_f32_32x32x16_bf16(kf[4],qr[2],C0,0,0,0),   P1[2],P1[3],P1[4],P1[5],     pw2[0]=PKW(P1,0), pw2[1]=PKW(P1,2), pw2); \
    VRD(6); SBAR(); GAPA(C1=__builtin_amdgcn_mfma_f32_32x32x16_bf16(kf[5],qr[2],C1,0,0,0),   P1[6],P1[7],P1[8],P1[9],     pw2[2]=PKW(P1,4), pw2[3]=PKW(P1,6), pw2); \
    VRD(3); SBAR(); GAPA(C0=__builtin_amdgcn_mfma_f32_32x32x16_bf16(kf[6],qr[3],C0,0,0,0),   P1[10],P1[11],P1[12],P1[13], pw3[0]=PKW(P1,8), pw3[1]=PKW(P1,10), pw3); \
    VRD(7); SBAR(); GAPA(C1=__builtin_amdgcn_mfma_f32_32x32x16_bf16(kf[7],qr[3],C1,0,0,0),   P1[14],P1[15],0.f,0.f,       pw3[2]=PKW(P1,12),pw3[3]=PKW(P1,14), pw3); \
    l_reg+=sacc; \
    if(GK){DMA_K((t)+3,sl_cur);} if(GV){DMA_V((t)+1,sl_next);} \
    CMASK(C0,C1,t); \
    { float a=MX3(C0[0],C0[1],C1[0]),b=MX3(C0[2],C0[3],C1[1]); a=MX3(a,C1[2],C1[3]); \
      _Pragma("unroll") for(int r=4;r<16;r+=4){a=MX3(a,C0[r],C0[r+1]);b=MX3(b,C0[r+2],C0[r+3]);a=MX3(a,C1[r],C1[r+1]);b=MX3(b,C1[r+2],C1[r+3]);} \
      float rm=__builtin_fmaxf(a,b); { auto rr=__builtin_amdgcn_permlane32_swap(__float_as_uint(rm),__float_as_uint(rm),false,false); rm=__builtin_fmaxf(__uint_as_float(rr[0]),__uint_as_float(rr[1])); } \
      resc=false; \
      if(__builtin_expect(__any(rm>(float)THRL),0)){ const float dl=__builtin_fmaxf(rm,0.f); mhat+=dl; \
        _Pragma("unroll") for(int r=0;r<16;++r){C0[r]-=dl;C1[r]-=dl;} \
        _Pragma("unroll") for(int r=0;r<16;++r)negm[r]=-mhat; asm volatile("":"+v"(negm)); \
        const float f=__builtin_amdgcn_exp2f(-dl); l_reg*=f; if(hi==0)wsf[r32]=f; resc=true; } } \
    SBAR(); \
    GAPB(o[0]=__builtin_amdgcn_mfma_f32_32x32x16_bf16(PAF(0),VFR(0),o[0],0,0,0), C0,0); \
    GAPB(o[1]=__builtin_amdgcn_mfma_f32_32x32x16_bf16(PAF(0),VFR(4),o[1],0,0,0), C0,4); \
    KRD(GL,0); GAPB(o[0]=__builtin_amdgcn_mfma_f32_32x32x16_bf16(PAF(1),VFR(1),o[0],0,0,0), C0,8); \
    KRD(GL,1); GAPB(o[1]=__builtin_amdgcn_mfma_f32_32x32x16_bf16(PAF(1),VFR(5),o[1],0,0,0), C0,12); \
    KRD(GL,2); GAPB(o[0]=__builtin_amdgcn_mfma_f32_32x32x16_bf16(PAF(2),VFR(2),o[0],0,0,0), C1,0); \
    KRD(GL,3); GAPB(o[1]=__builtin_amdgcn_mfma_f32_32x32x16_bf16(PAF(2),VFR(6),o[1],0,0,0), C1,4); \
    GAPB(o[0]=__builtin_amdgcn_mfma_f32_32x32x16_bf16(PAF(3),VFR(3),o[0],0,0,0), C1,8); \
    GAPB(o[1]=__builtin_amdgcn_mfma_f32_32x32x16_bf16(PAF(3),VFR(7),o[1],0,0,0), C1,12); \
    }while(0)
  int t=1;
  #undef CMASK
  #define CMASK(P0,P1,t) do{}while(0)
  for(;t+5<NT;t+=2){
    STEP(pB0,pB1,pA0,pA1,t,true,true,true);     WAIT_BAR(2); RESC(); ROT();
    STEP(pA0,pA1,pB0,pB1,t+1,true,true,true);   WAIT_BAR(2); RESC(); ROT();
  }
  #undef CMASK
  #define CMASK(P0,P1,t) do{int jb_=(t)-(NT-4); if(MODE==1||jb_>=0)cmask<MODE>(P0,P1,jb_,qrel,hi);}while(0)
  #define ENDW(tt) do{ if((tt)+3<NT){WAIT_BAR(2);} else if((tt)+2<NT){WAIT_BAR(1);} else {WAIT_BAR(0);} }while(0)
  for(;t+1<NT;t+=2){
    STEP(pB0,pB1,pA0,pA1,t,(t+3<NT),(t+1<NT),(t+1<NT));       ENDW(t);   RESC(); ROT();
    STEP(pA0,pA1,pB0,pB1,t+1,(t+4<NT),(t+2<NT),(t+2<NT));     ENDW(t+1); RESC(); ROT();
  }
  STEP(pB0,pB1,pA0,pA1,NT-1,false,false,false); RESC();
  { float sacc=pB0[0]+pB0[1]; _Pragma("unroll") for(int r=2;r<16;++r)sacc+=pB0[r]; _Pragma("unroll") for(int r=0;r<16;++r)sacc+=pB1[r]; l_reg+=sacc;
    pw0=(u32x4){PKW(pB0,0),PKW(pB0,2),PKW(pB0,4),PKW(pB0,6)};pw1=(u32x4){PKW(pB0,8),PKW(pB0,10),PKW(pB0,12),PKW(pB0,14)};pw2=(u32x4){PKW(pB1,0),PKW(pB1,2),PKW(pB1,4),PKW(pB1,6)};pw3=(u32x4){PKW(pB1,8),PKW(pB1,10),PKW(pB1,12),PKW(pB1,14)};
    SBAR(); pv(o,vb0+sl_cur,PAF(0),PAF(1),PAF(2),PAF(3)); }
  #undef PKW
  #undef PAF
  #undef VFR
  #undef PIN
  #undef MX3
  #undef GAPA
  #undef GAPB
  #undef EX
  #undef VRD
  #undef KRD
  #undef STEP
  #undef ENDW
  {auto rr=__builtin_amdgcn_permlane32_swap(__float_as_uint(l_reg),__float_as_uint(l_reg),false,false);l_reg=__uint_as_float(rr[0])+__uint_as_float(rr[1]);}
  if(MODE==1)l_reg+=__builtin_amdgcn_exp2f(sink2-mhat);
  if(hi==0)wsf[32+r32]=l_reg;asm volatile("s_waitcnt lgkmcnt(0)":::"memory");
  float rli[16];
  #pragma unroll
  for(int r=0;r<16;++r)rli[r]=__builtin_amdgcn_rcpf(wsf[32+crow(r,hi)]);
  bf16*Ow=Oh+(long)(q0+wid*QBLK)*PO;
  { bf16*stg=(bf16*)(shm+LDS_OST)+wid*2048;
    #pragma unroll
    for(int r=0;r<16;++r){const int orow=crow(r,hi);
      #pragma unroll
      for(int d0=0;d0<2;++d0)stg[orow*64+d0*32+r32]=__float2bfloat16(o[d0][r]*rli[r]);}
    asm volatile("s_waitcnt lgkmcnt(0)":::"memory");
    #pragma unroll
    for(int i=0;i<4;++i){const int row=i*8+(lane>>3),ch=lane&7; const u32x4 v=*(const u32x4*)(stg+row*64+ch*8); ATTN_STORE16(Ow+(long)row*PO+ch*8,v);} }
  asm volatile("s_waitcnt lgkmcnt(0)\n\ts_barrier":::"memory");
  #undef DMA_K
  #undef DMA_V
  #undef CMASK
  #undef START
  #undef RESC
  #undef ROT
}
constexpr int ATTN_LDS_BYTES=LDS_BYTES;

constexpr int SW_K=0, SW_V=6*8192, SW_WS=12*8192, SW_ST=SW_WS+2048, SWA_LDS_BYTES=SW_ST+NW*2048;
template<int ABL=0> __device__ __forceinline__ void swa_unit(const bf16*Qb,const bf16*__restrict__ Kh,const bf16*__restrict__ Vh,bf16*Ob,const unsigned*kmx,int q0,const float*sink2v,char*shm){
  int tid_=threadIdx.x; asm volatile("":"+v"(tid_)); const int tid=tid_,lane=tid&63,r32=lane&31,hi=lane>>5; const int wid=__builtin_amdgcn_readfirstlane(tid>>6);
  const unsigned lds0=(unsigned)(uintptr_t)shm;
  const int nt=(q0==0)?4:6, kt0=q0/KVBLK-(nt-4);
  const bf16*ksrc=Kh+(long)(kt0*KVBLK+lane)*PQ+wid*8;
  const bf16*vsrc=Vh+(long)(kt0*KVBLK+16*(wid&3)+(lane>>2))*PQ+(wid>>2)*32+(lane&3)*8;
  for(int ti=0;ti<nt;++ti){
    glds16(ksrc+(long)ti*KVBLK*PQ,(unsigned)__builtin_amdgcn_readfirstlane(lds0+SW_K+ti*8192+wid*1024));
    glds16(vsrc+(long)ti*KVBLK*PQ,(unsigned)__builtin_amdgcn_readfirstlane(lds0+SW_V+ti*8192+wid*1024)); }
  const bf16*Qw=Qb+(long)(q0+wid*QBLK+r32)*PQ+hi*8;
  bf16x8 qa[4],qb[4];
  #pragma unroll
  for(int d0=0;d0<4;++d0){qa[d0]=*reinterpret_cast<const bf16x8*>(Qw+d0*16);qb[d0]=*reinterpret_cast<const bf16x8*>(Qw+D+d0*16);}
  float kb2=0.f;
  #pragma unroll
  for(int g_=0;g_<8;++g_)kb2+=__uint_as_float(kmx[g_]);
  asm volatile("s_waitcnt vmcnt(0) lgkmcnt(0)\n\ts_barrier":::"memory");
  float*wsf=(float*)(shm+SW_WS)+wid*64;
  const u32x4 a1w=(u32x4){hi==0?0x3F803F80u:0u,0u,0u,0u};
  const int kb0=8*(q0>>8)+wid-4;
  const lds_cptr shm3=(lds_cptr)shm;
  const lds_cptr kpl=shm3+SW_K+hi*1024+r32*16;
  const lds_cptr vpl=shm3+SW_V+((lane>>4)&1)*32+(lane&3)*8+(4*hi+((lane&15)>>2))*64;
  #pragma unroll
  for(int g=0;g<4;g+=2){
    float mA,mB; f32x16 cbA,cbB;
    { float qsA=0.f,qsB=0.f;
      #pragma unroll
      for(int d0=0;d0<4;++d0){ const u32x4 va=__builtin_bit_cast(u32x4,qa[d0]),vb_=__builtin_bit_cast(u32x4,qb[d0]);
        #pragma unroll
        for(int e_=0;e_<4;++e_){ const float a_=__uint_as_float(va[e_]<<16),c_=__uint_as_float(va[e_]&0xffff0000u),d_=__uint_as_float(vb_[e_]<<16),f_=__uint_as_float(vb_[e_]&0xffff0000u); qsA+=a_*a_+c_*c_; qsB+=d_*d_+f_*f_; } }
      { auto rr=__builtin_amdgcn_permlane32_swap(__float_as_uint(qsA),__float_as_uint(qsA),false,false); qsA=__uint_as_float(rr[0])+__uint_as_float(rr[1]); }
      { auto rr=__builtin_amdgcn_permlane32_swap(__float_as_uint(qsB),__float_as_uint(qsB),false,false); qsB=__uint_as_float(rr[0])+__uint_as_float(rr[1]); }
      mA=sqrtf(qsA*kb2)*1.01f+1e-3f-64.f; mB=sqrtf(qsB*kb2)*1.01f+1e-3f-64.f;
      u32x4 bw=(u32x4){0u,0u,0u,0u};
      { const float nm_=-mA; const unsigned h_=cvtpk_s(nm_,0.f)&0xffffu; const float r_=nm_-__uint_as_float(h_<<16); const unsigned l_=cvtpk_s(r_,0.f)&0xffffu; bw[0]=(hi==0)?(h_|(l_<<16)):0u; }
      cbA=__builtin_amdgcn_mfma_f32_32x32x16_bf16(__builtin_bit_cast(bf16x8,a1w),__builtin_bit_cast(bf16x8,bw),f32x16{},0,0,0);
      { const float nm_=-mB; const unsigned h_=cvtpk_s(nm_,0.f)&0xffffu; const float r_=nm_-__uint_as_float(h_<<16); const unsigned l_=cvtpk_s(r_,0.f)&0xffffu; bw[0]=(hi==0)?(h_|(l_<<16)):0u; }
      cbB=__builtin_amdgcn_mfma_f32_32x32x16_bf16(__builtin_bit_cast(bf16x8,a1w),__builtin_bit_cast(bf16x8,bw),f32x16{},0,0,0); }
    float lA=0.f,lB=0.f; f32x16 oA[2],oB[2]; oA[0]=f32x16{};oA[1]=f32x16{};oB[0]=f32x16{};oB[1]=f32x16{};
    for(int j=0;j<5;++j){ const int kb=kb0+j; if(kb<0)continue; if(ABL==1)continue;
      const int ti=(kb>>1)-kt0, half=kb&1;
      f32x16 sA=cbA,sB=cbB;
      { const lds_cptr kp=kpl+ti*8192+half*512;
        #pragma unroll
        for(int d0=0;d0<4;++d0){ const bf16x8 kf=*(const __attribute__((address_space(3))) bf16x8*)(kp+d0*2048);
          sA=__builtin_amdgcn_mfma_f32_32x32x16_bf16(kf,qa[d0],sA,0,0,0); sB=__builtin_amdgcn_mfma_f32_32x32x16_bf16(kf,qb[d0],sB,0,0,0); } }
      if(j==0){
        #pragma unroll
        for(int r=0;r<16;++r){ const int i_=(r&3)+8*(r>>2)+4*hi; if(i_<=r32){sA[r]=-INFINITY;sB[r]=-INFINITY;} } }
      if(j==4){
        #pragma unroll
        for(int r=0;r<16;++r){ const int i_=(r&3)+8*(r>>2)+4*hi; if(i_>r32){sA[r]=-INFINITY;sB[r]=-INFINITY;} } }
      #pragma unroll
      for(int r=0;r<16;++r){ sA[r]=__builtin_amdgcn_exp2f(sA[r]); sB[r]=__builtin_amdgcn_exp2f(sB[r]); lA+=sA[r]; lB+=sB[r]; }
      u32x4 pa[2],pb[2];
      #pragma unroll
      for(int k=0;k<2;++k){
        pa[k]=(u32x4){cvtpk_s(sA[8*k],sA[8*k+1]),cvtpk_s(sA[8*k+2],sA[8*k+3]),cvtpk_s(sA[8*k+4],sA[8*k+5]),cvtpk_s(sA[8*k+6],sA[8*k+7])};
        pb[k]=(u32x4){cvtpk_s(sB[8*k],sB[8*k+1]),cvtpk_s(sB[8*k+2],sB[8*k+3]),cvtpk_s(sB[8*k+4],sB[8*k+5]),cvtpk_s(sB[8*k+6],sB[8*k+7])}; }
      { const lds_cptr vp=vpl+ti*8192+half*2048;
        #pragma unroll
        for(int d0=0;d0<2;++d0)
          #pragma unroll
          for(int k=0;k<2;++k){ const s16x4 lo=vtr(vp+d0*4096+k*1024), hh=vtr(vp+d0*4096+k*1024+512);
            const bf16x8 vf=(bf16x8){lo[0],lo[1],lo[2],lo[3],hh[0],hh[1],hh[2],hh[3]};
            oA[d0]=__builtin_amdgcn_mfma_f32_32x32x16_bf16(__builtin_bit_cast(bf16x8,pa[k]),vf,oA[d0],0,0,0);
            oB[d0]=__builtin_amdgcn_mfma_f32_32x32x16_bf16(__builtin_bit_cast(bf16x8,pb[k]),vf,oB[d0],0,0,0); } }
    }
    if(g==0){
      #pragma unroll
      for(int d0=0;d0<4;++d0){qa[d0]=*reinterpret_cast<const bf16x8*>(Qw+2*D+d0*16);qb[d0]=*reinterpret_cast<const bf16x8*>(Qw+3*D+d0*16);} }
    #pragma unroll
    for(int hsel=0;hsel<2;++hsel){
      float l=hsel?lB:lA; const float m=hsel?mB:mA; const f32x16*o=hsel?oB:oA;
      {auto rr=__builtin_amdgcn_permlane32_swap(__float_as_uint(l),__float_as_uint(l),false,false);l=__uint_as_float(rr[0])+__uint_as_float(rr[1]);}
      l+=__builtin_amdgcn_exp2f(sink2v[g+hsel]-m);
      if(hi==0)wsf[32+r32]=l; asm volatile("s_waitcnt lgkmcnt(0)":::"memory");
      float rli[16];
      #pragma unroll
      for(int r=0;r<16;++r)rli[r]=__builtin_amdgcn_rcpf(wsf[32+crow(r,hi)]);
      bf16*Ow=Ob+(long)(q0+wid*QBLK)*PO+(g+hsel)*D;
      bf16*stg=(bf16*)(shm+SW_ST)+wid*1024;
      #pragma unroll
      for(int d0=0;d0<2;++d0){
        #pragma unroll
        for(int r=0;r<16;++r)stg[crow(r,hi)*32+r32]=__float2bfloat16(o[d0][r]*rli[r]);
        asm volatile("s_waitcnt lgkmcnt(0)":::"memory");
        #pragma unroll
        for(int i=0;i<2;++i){const int row=i*16+(lane>>2),ch=lane&3; const u32x4 v=*(const u32x4*)(stg+row*32+ch*8); ATTN_STORE16(Ow+(long)row*PO+d0*32+ch*8,v);}
        asm volatile("s_waitcnt lgkmcnt(0)":::"memory");
      }
    }
  }
  asm volatile("s_waitcnt lgkmcnt(0)\n\ts_barrier":::"memory");
}

constexpr int W_SLK=8192, W_SLV=16384, W_LDS_K=0, W_LDS_V=NSLOT*W_SLK, W_LDS_WS=W_LDS_V+NSLOT*W_SLV, W_LDS_OST=W_LDS_WS+NW*64*4, W_LDS_BYTES=W_LDS_OST+NW*4096;
template<int THRL> __device__ __forceinline__ void attn_unit_w(const bf16*Qh,const bf16*__restrict__ Kh,const bf16*__restrict__ Vh,bf16*Oh,const unsigned*kmx,int q0,const int NT,char*shm){
  int tid_=threadIdx.x; asm volatile("":"+v"(tid_)); const int tid=tid_,lane=tid&63,r32=lane&31,hi=lane>>5; const int wid=__builtin_amdgcn_readfirstlane(tid>>6);
  const bf16*Qw=Qh+(long)(q0+wid*QBLK)*PQ;
  const unsigned lds0=(unsigned)(uintptr_t)shm;
  float*wsf=(float*)(shm+W_LDS_WS)+wid*64;
  const bf16*ksrc=Kh+(long)lane*PQ+wid*8;
  const bf16*vsrc=Vh+(long)(16*(wid&3)+(lane>>2))*PQ+(wid>>2)*32+(lane&3)*8;
  const unsigned kdst=lds0+W_LDS_K+wid*1024, vdst=lds0+W_LDS_V+wid*1024;
  #define DMA_K(t,slot) glds16(ksrc+(long)(t)*KVBLK*PQ,(unsigned)__builtin_amdgcn_readfirstlane(kdst+(slot)))
  #define DMA_V(t,slot) do{ glds16(vsrc+(long)(t)*KVBLK*PQ,(unsigned)__builtin_amdgcn_readfirstlane(vdst+2*(slot))); glds16(vsrc+64+(long)(t)*KVBLK*PQ,(unsigned)__builtin_amdgcn_readfirstlane(vdst+2*(slot)+8192)); }while(0)
  const char*Kbase=shm+W_LDS_K; bf16x8 kf[8];
  const lds_cptr shm3=(lds_cptr)shm; const lds_cptr kp0=shm3+W_LDS_K+hi*1024+r32*16; const lds_cptr vp0=shm3+W_LDS_V+((lane>>4)&1)*32+(lane&3)*8+(4*hi+((lane&15)>>2))*64;
  const int vb0=(int)(lds0+W_LDS_V)+((lane>>4)&1)*32+(lane&3)*8+(4*hi+((lane&15)>>2))*64;
  DMA_K(0,0);DMA_V(0,0);DMA_K(1,W_SLK);
  bf16x8 qr[4];
  #pragma unroll
  for(int d0=0;d0<4;++d0)qr[d0]=*reinterpret_cast<const bf16x8*>(&Qw[(long)r32*PQ+d0*16+hi*8]);
  float mhat=0.f,l_reg=0.f;f32x16 o[4];o[0]=f32x16{};o[1]=f32x16{};o[2]=f32x16{};o[3]=f32x16{};const f32x16 zacc=f32x16{};
  const u32x4 a1w=(u32x4){hi==0?0x3F803F80u:0u,0u,0u,0u}; u32x4 bmw=(u32x4){0u,0u,0u,0u}; f32x16 cb;
  #define SETBM() do{ const float nm_=-mhat; const unsigned h_=cvtpk_s(nm_,0.f)&0xffffu; const float r_=nm_-__uint_as_float(h_<<16); const unsigned l_=cvtpk_s(r_,0.f)&0xffffu; bmw[0]=(hi==0)?(h_|(l_<<16)):0u; }while(0)
  #define BIASMF() __builtin_amdgcn_mfma_f32_32x32x16_bf16(__builtin_bit_cast(bf16x8,a1w),__builtin_bit_cast(bf16x8,bmw),zacc,0,0,0)
  const int qrel=wid*QBLK+r32;
  { float kb2=0.f; _Pragma("unroll") for(int g=0;g<8;++g)kb2+=__uint_as_float(kmx[g]);
    float qs=0.f; _Pragma("unroll") for(int d0=0;d0<4;++d0){ const u32x4 qv=__builtin_bit_cast(u32x4,qr[d0]); _Pragma("unroll") for(int e_=0;e_<4;++e_){ const float a_=__uint_as_float(qv[e_]<<16),b_=__uint_as_float(qv[e_]&0xffff0000u); qs+=a_*a_+b_*b_; } }
    { auto rr=__builtin_amdgcn_permlane32_swap(__float_as_uint(qs),__float_as_uint(qs),false,false); qs=__uint_as_float(rr[0])+__uint_as_float(rr[1]); }
    mhat=sqrtf(qs*kb2)*1.01f+1e-3f-64.f; }
  SETBM(); cb=BIASMF();
  #define CMASK(P0,P1,t) do{int jb_=(t)-(NT-4); if(jb_>=0)cmask<0>(P0,P1,jb_,qrel,hi);}while(0)
  #define START(P0,P1) do{ _Pragma("unroll") for(int r=0;r<16;++r)P0[r]=__builtin_amdgcn_exp2f(P0[r]); }while(0)
  f32x16 pA0,pA1,pB0,pB1;
  int sl_prev=0,sl_cur=0,sl_next=W_SLK;
  #define ROT() do{sl_prev=sl_cur;sl_cur=sl_next;sl_next=(sl_next==(NSLOT-1)*W_SLK)?0:sl_next+W_SLK;}while(0)
  DMA_K(2,2*W_SLK);
  WAIT_BAR(4);
  qkt(pA0,pA1,Kbase,qr,cb,r32,hi);asm volatile("s_nop 15\n\ts_nop 7":"+v"(pA0),"+v"(pA1));CMASK(pA0,pA1,0);
  START(pA0,pA1);
  _Pragma("unroll") for(int r=0;r<16;++r)pA1[r]=__builtin_amdgcn_exp2f(pA1[r]);
  WAIT_BAR(0);
  DMA_K(3,0);DMA_V(1,W_SLK);
  ROT();
  kload8(kf,kp0+sl_cur);
  WAIT_BAR(3);
  s16x4 vlo[4],vhi[4]; u32x4 pw0,pw1,pw2,pw3;
  #define PKW(P,B) cvtpk_s(P[B],P[B+1])
  #define PAF(k) __builtin_bit_cast(bf16x8,pw##k)
  #define VFR(i) (bf16x8){vlo[i][0],vlo[i][1],vlo[i][2],vlo[i][3],vhi[i][0],vhi[i][1],vhi[i][2],vhi[i][3]}
  #define PIN(x) asm volatile("":"+v"(x))
  #define MX3(a,b,c) __builtin_fmaxf(__builtin_fmaxf((a),(b)),(c))
  #define GAPA(MF,A0,A1,A2,A3,W0,W1,PW) do{ MF; sacc+=A0; sacc+=A1; sacc+=A2; sacc+=A3; PIN(sacc); W0; W1; PIN(PW); SBAR(); }while(0)
  #define EX(v) __builtin_amdgcn_exp2f(v)
  #define GAPB(MF,X,B) do{ MF; X[B]=EX(X[B]); X[B+1]=EX(X[B+1]); PIN(X); SBAR(); }while(0)
  #define VRD(j) do{ vlo[(j)&3]=vtr(vp_+(((j)&3)*4096+((j)>>2)*1024)); vhi[(j)&3]=vtr(vp_+(((j)&3)*4096+((j)>>2)*1024+512)); SBAR(); }while(0)
  #define KRD(G,j) do{ if(G){ kload2(kf,kp0+sl_next,j); SBAR(); } }while(0)
  #define STEP(C0,C1,P0,P1,t,GK,GV,GL) do{ SBAR(); \
    const lds_cptr vp_=vp0+2*sl_prev; \
    float sacc=(P0[0]+P0[1]); \
    GAPA(C0=__builtin_amdgcn_mfma_f32_32x32x16_bf16(kf[0],qr[0],cb,0,0,0), P0[2],P0[3],P0[4],P0[5],     pw0[0]=PKW(P0,0), pw0[1]=PKW(P0,2), pw0); \
    GAPA(C1=__builtin_amdgcn_mfma_f32_32x32x16_bf16(kf[1],qr[0],cb,0,0,0), P0[6],P0[7],P0[8],P0[9],     pw0[2]=PKW(P0,4), pw0[3]=PKW(P0,6), pw0); \
    GAPA(C0=__builtin_amdgcn_mfma_f32_32x32x16_bf16(kf[2],qr[1],C0,0,0,0),   P0[10],P0[11],P0[12],P0[13], pw1[0]=PKW(P0,8), pw1[1]=PKW(P0,10), pw1); \
    GAPA(C1=__builtin_amdgcn_mfma_f32_32x32x16_bf16(kf[3],qr[1],C1,0,0,0),   P0[14],P0[15],P1[0],P1[1],   pw1[2]=PKW(P0,12),pw1[3]=PKW(P0,14), pw1); \
    GAPA(C0=__builtin_amdgcn_mfma_f32_32x32x16_bf16(kf[4],qr[2],C0,0,0,0),   P1[2],P1[3],P1[4],P1[5],     pw2[0]=PKW(P1,0), pw2[1]=PKW(P1,2), pw2); \
    VRD(0); GAPA(C1=__builtin_amdgcn_mfma_f32_32x32x16_bf16(kf[5],qr[2],C1,0,0,0),   P1[6],P1[7],P1[8],P1[9],     pw2[2]=PKW(P1,4), pw2[3]=PKW(P1,6), pw2); \
    VRD(1); GAPA(C0=__builtin_amdgcn_mfma_f32_32x32x16_bf16(kf[6],qr[3],C0,0,0,0),   P1[10],P1[11],P1[12],P1[13], pw3[0]=PKW(P1,8), pw3[1]=PKW(P1,10), pw3); \
    VRD(2); GAPA(C1=__builtin_amdgcn_mfma_f32_32x32x16_bf16(kf[7],qr[3],C1,0,0,0),   P1[14],P1[15],0.f,0.f,       pw3[2]=PKW(P1,12),pw3[3]=PKW(P1,14), pw3); \
    l_reg+=sacc; \
    if(GK){DMA_K((t)+3,sl_cur);} if(GV){DMA_V((t)+1,sl_next);} \
    CMASK(C0,C1,t); \
    SBAR(); \
    VRD(3); do{ o[0]=__builtin_amdgcn_mfma_f32_32x32x16_bf16(PAF(0),VFR(0),o[0],0,0,0); C0[0]=EX(C0[0]); C0[1]=EX(C0[1]); PIN(C0); SBAR(); }while(0); \
    VRD(4); do{ o[1]=__builtin_amdgcn_mfma_f32_32x32x16_bf16(PAF(0),VFR(1),o[1],0,0,0); C0[2]=EX(C0[2]); C0[3]=EX(C0[3]); PIN(C0); SBAR(); }while(0); \
    VRD(5); do{ o[2]=__builtin_amdgcn_mfma_f32_32x32x16_bf16(PAF(0),VFR(2),o[2],0,0,0); C0[4]=EX(C0[4]); C0[5]=EX(C0[5]); PIN(C0); SBAR(); }while(0); \
    VRD(6); do{ o[3]=__builtin_amdgcn_mfma_f32_32x32x16_bf16(PAF(0),VFR(3),o[3],0,0,0); C0[6]=EX(C0[6]); C0[7]=EX(C0[7]); PIN(C0); SBAR(); }while(0); \
    VRD(7); do{ o[0]=__builtin_amdgcn_mfma_f32_32x32x16_bf16(PAF(1),VFR(0),o[0],0,0,0); C0[8]=EX(C0[8]); C0[9]=EX(C0[9]); PIN(C0); SBAR(); }while(0); \
    VRD(8); do{ o[1]=__builtin_amdgcn_mfma_f32_32x32x16_bf16(PAF(1),VFR(1),o[1],0,0,0); C0[10]=EX(C0[10]); C0[11]=EX(C0[11]); PIN(C0); SBAR(); }while(0); \
    VRD(9); do{ o[2]=__builtin_amdgcn_mfma_f32_32x32x16_bf16(PAF(1),VFR(2),o[2],0,0,0); C0[12]=EX(C0[12]); C0[13]=EX(C0[13]); PIN(C0); SBAR(); }while(0); \
    VRD(10); do{ o[3]=__builtin_amdgcn_mfma_f32_32x32x16_bf16(PAF(1),VFR(3),o[3],0,0,0); C0[14]=EX(C0[14]); C0[15]=EX(C0[15]); PIN(C0); SBAR(); }while(0); \
    VRD(11); KRD(GL,0); do{ o[0]=__builtin_amdgcn_mfma_f32_32x32x16_bf16(PAF(2),VFR(0),o[0],0,0,0); C1[0]=EX(C1[0]); C1[1]=EX(C1[1]); PIN(C1); SBAR(); }while(0); \
    VRD(12); do{ o[1]=__builtin_amdgcn_mfma_f32_32x32x16_bf16(PAF(2),VFR(1),o[1],0,0,0); C1[2]=EX(C1[2]); C1[3]=EX(C1[3]); PIN(C1); SBAR(); }while(0); \
    VRD(13); KRD(GL,1); do{ o[2]=__builtin_amdgcn_mfma_f32_32x32x16_bf16(PAF(2),VFR(2),o[2],0,0,0); C1[4]=EX(C1[4]); C1[5]=EX(C1[5]); PIN(C1); SBAR(); }while(0); \
    VRD(14); do{ o[3]=__builtin_amdgcn_mfma_f32_32x32x16_bf16(PAF(2),VFR(3),o[3],0,0,0); C1[6]=EX(C1[6]); C1[7]=EX(C1[7]); PIN(C1); SBAR(); }while(0); \
    VRD(15); KRD(GL,2); do{ o[0]=__builtin_amdgcn_mfma_f32_32x32x16_bf16(PAF(3),VFR(0),o[0],0,0,0); C1[8]=EX(C1[8]); C1[9]=EX(C1[9]); PIN(C1); SBAR(); }while(0); \
    do{ o[1]=__builtin_amdgcn_mfma_f32_32x32x16_bf16(PAF(3),VFR(1),o[1],0,0,0); C1[10]=EX(C1[10]); C1[11]=EX(C1[11]); PIN(C1); SBAR(); }while(0); \
    KRD(GL,3); do{ o[2]=__builtin_amdgcn_mfma_f32_32x32x16_bf16(PAF(3),VFR(2),o[2],0,0,0); C1[12]=EX(C1[12]); C1[13]=EX(C1[13]); PIN(C1); SBAR(); }while(0); \
    do{ o[3]=__builtin_amdgcn_mfma_f32_32x32x16_bf16(PAF(3),VFR(3),o[3],0,0,0); C1[14]=EX(C1[14]); C1[15]=EX(C1[15]); PIN(C1); SBAR(); }while(0); \
    }while(0)
  int t=1;
  #undef CMASK
  #define CMASK(P0,P1,t) do{}while(0)
  for(;t+5<NT;t+=2){
    STEP(pB0,pB1,pA0,pA1,t,true,true,true);     WAIT_BAR(3); ROT();
    STEP(pA0,pA1,pB0,pB1,t+1,true,true,true);   WAIT_BAR(3); ROT();
  }
  #undef CMASK
  #define CMASK(P0,P1,t) do{int jb_=(t)-(NT-4); if(jb_>=0)cmask<0>(P0,P1,jb_,qrel,hi);}while(0)
  #define ENDW(tt) do{ if((tt)+3<NT){WAIT_BAR(3);} else if((tt)+2<NT){WAIT_BAR(2);} else {WAIT_BAR(0);} }while(0)
  for(;t+1<NT;t+=2){
    STEP(pB0,pB1,pA0,pA1,t,(t+3<NT),(t+1<NT),(t+1<NT));       ENDW(t);   ROT();
    STEP(pA0,pA1,pB0,pB1,t+1,(t+4<NT),(t+2<NT),(t+2<NT));     ENDW(t+1); ROT();
  }
  STEP(pB0,pB1,pA0,pA1,NT-1,false,false,false);
  { float sacc=pB0[0]+pB0[1]; _Pragma("unroll") for(int r=2;r<16;++r)sacc+=pB0[r]; _Pragma("unroll") for(int r=0;r<16;++r)sacc+=pB1[r]; l_reg+=sacc;
    pw0=(u32x4){PKW(pB0,0),PKW(pB0,2),PKW(pB0,4),PKW(pB0,6)};pw1=(u32x4){PKW(pB0,8),PKW(pB0,10),PKW(pB0,12),PKW(pB0,14)};pw2=(u32x4){PKW(pB1,0),PKW(pB1,2),PKW(pB1,4),PKW(pB1,6)};pw3=(u32x4){PKW(pB1,8),PKW(pB1,10),PKW(pB1,12),PKW(pB1,14)};
    SBAR(); pv(o,vb0+2*sl_cur,PAF(0),PAF(1),PAF(2),PAF(3)); pv(o+2,vb0+2*sl_cur+8192,PAF(0),PAF(1),PAF(2),PAF(3)); }
  #undef PKW
  #undef PAF
  #undef VFR
  #undef PIN
  #undef MX3
  #undef GAPA
  #undef GAPB
  #undef EX
  #undef VRD
  #undef KRD
  #undef STEP
  #undef ENDW
  {auto rr=__builtin_amdgcn_permlane32_swap(__float_as_uint(l_reg),__float_as_uint(l_reg),false,false);l_reg=__uint_as_float(rr[0])+__uint_as_float(rr[1]);}
  if(hi==0)wsf[32+r32]=l_reg;asm volatile("s_waitcnt lgkmcnt(0)":::"memory");
  float rli[16];
  #pragma unroll
  for(int r=0;r<16;++r)rli[r]=__builtin_amdgcn_rcpf(wsf[32+crow(r,hi)]);
  bf16*Ow=Oh+(long)(q0+wid*QBLK)*PO;
  { bf16*stg=(bf16*)(shm+W_LDS_OST)+wid*2048;
    #pragma unroll
    for(int hf=0;hf<2;++hf){
      #pragma unroll
      for(int r=0;r<16;++r){const int orow=crow(r,hi);
        #pragma unroll
        for(int d0=0;d0<2;++d0)stg[orow*64+d0*32+r32]=__float2bfloat16(o[2*hf+d0][r]*rli[r]);}
      asm volatile("s_waitcnt lgkmcnt(0)":::"memory");
      #pragma unroll
      for(int i=0;i<4;++i){const int row=i*8+(lane>>3),ch=lane&7; const u32x4 v=*(const u32x4*)(stg+row*64+ch*8); ATTN_STORE16(Ow+(long)row*PO+hf*64+ch*8,v);}
      asm volatile("s_waitcnt lgkmcnt(0)":::"memory");
    } }
  asm volatile("s_waitcnt lgkmcnt(0)\n\ts_barrier":::"memory");
  #undef DMA_K
  #undef DMA_V
  #undef CMASK
  #undef START
  #undef ROT
  #undef SETBM
  #undef BIASMF
}
#undef SBAR
#undef WAIT_BAR
}
constexpr int NWAVES = 8;
constexpr int BATCH = 2, SEQ = 16384, D = 1024, T = BATCH * SEQ;
constexpr int IN_COLS = 2304, NEXP = 32, FF = 512, NASSIGN = 2 * T, NCHUNK = 256, CHUNK_TOK = T / NCHUNK;
constexpr int PSLOTS = (NASSIGN / 256 + NEXP) * 256;
constexpr int NBLK_MAX = PSLOTS / 256;
constexpr float RMS_EPS = 1e-6f;
static_assert(CHUNK_TOK == 128 && SEQ == pg8::SEQ_LEN && IN_COLS == pg8::QKV_LD, "shapes");
constexpr size_t MiB = 1u << 20;
constexpr size_t WS_CTL = 0, CTL_ZERO_BYTES = 1 * MiB;
constexpr size_t WS_WR = 1 * MiB;
constexpr size_t WS_TOK = WS_WR + 256 * 1024;
constexpr size_t WS_ROPE = 4 * MiB;
constexpr size_t WS_WIN = 8 * MiB;
constexpr size_t WS_WO = 13 * MiB;
constexpr size_t WS_WGU = 16 * MiB;
constexpr size_t WS_WD = 80 * MiB;
constexpr size_t WS_A = 112 * MiB;
constexpr size_t WS_MIX = 176 * MiB;
constexpr size_t WS_QKV = 240 * MiB;
constexpr size_t WS_HM = 384 * MiB;
constexpr size_t WS_END = 456 * MiB;
static_assert(WS_TOK + (size_t)(T * 2 * 4) * 2 + T * 4 + NCHUNK * 32 * 4 + 288 * 4 + (size_t)PSLOTS * 16 <= WS_ROPE, "routing tables");
static_assert(WS_WIN + (size_t)IN_COLS * D * 2 <= WS_WO && WS_WO + (size_t)D * D * 2 <= WS_WGU && WS_WGU + (size_t)NEXP * 1024 * D * 2 <= WS_WD && WS_WD + (size_t)NEXP * D * FF * 2 <= WS_A, "weights");
static_assert(WS_A + (size_t)T * D * 2 <= WS_MIX && WS_MIX + (size_t)T * D * 2 <= WS_QKV && WS_QKV + (size_t)T * IN_COLS * 2 <= WS_HM && WS_QKV + (size_t)PSLOTS * D * 2 <= WS_HM && WS_HM + (size_t)PSLOTS * FF * 2 <= WS_END, "activations");
static_assert(WS_MIX + (size_t)NASSIGN * D * 2 <= WS_HM, "Y (P5b-P6) overlays MIX and the head of XS, both dead after P5a; HB stays live in WS_A until P6");
constexpr int CW_KMAX = 128;
constexpr int CW_SWAQ = 80;
constexpr int CW_NBU = 64;
constexpr int CW_BAR = 4096;
constexpr int RING_OFF = 0, RING_BYTES = 131072;
constexpr int LDSCTL_OFF = RING_BYTES, MISC_OFF = LDSCTL_OFF + 320;
constexpr int LDS_BYTES = 147456;
constexpr int ROWTAB_OFF = MISC_OFF + 128, ROWTAB_UNITS = 6;
static_assert(ROWTAB_OFF + ROWTAB_UNITS * 1024 <= LDS_BYTES, "LDS map");
#define GAS __attribute__((address_space(1)))
#define LAS __attribute__((address_space(3)))
typedef unsigned short bf16;
typedef unsigned v4u __attribute__((ext_vector_type(4)));
typedef float f32x4 __attribute__((ext_vector_type(4)));
typedef short bf16x8 __attribute__((ext_vector_type(8)));
typedef GAS unsigned gu32;
typedef GAS unsigned long long gu64;
#define RLX_AGENT __ATOMIC_RELAXED, __HIP_MEMORY_SCOPE_AGENT
#define LDS_WAIT() asm volatile("s_waitcnt lgkmcnt(0)" ::: "memory")
#define VM_WAIT() asm volatile("s_waitcnt vmcnt(0)" ::: "memory")
__device__ __forceinline__ unsigned long long rt() { return __builtin_amdgcn_s_memrealtime(); }
__device__ __forceinline__ unsigned f2bf(float f) { unsigned u = __builtin_bit_cast(unsigned, f); return (u + 0x7fffu + ((u >> 16) & 1u)) >> 16; }
__device__ __forceinline__ unsigned pk2(float lo, float hi) { return f2bf(lo) | (f2bf(hi) << 16); }

#define XB_TMO      128
#define XB_XCNT(j)  (256  + 64 * (j))
#define XB_XSUB(j)  (1280 + 64 * (j))
#define XB_XGEN(j)  (2304 + 64 * (j))
#define XB_TOP      3328
#define XB_TOPGEN   3392
#define XCD_BAR_WORDS 3456
#define XB_SPIN_CAP (1u << 18)

__device__ __forceinline__ unsigned xb_ld(unsigned* p)              { return __hip_atomic_load(p, __ATOMIC_RELAXED, __HIP_MEMORY_SCOPE_AGENT); }
__device__ __forceinline__ unsigned xb_add(unsigned* p, unsigned v) { return __hip_atomic_fetch_add(p, v, __ATOMIC_RELAXED, __HIP_MEMORY_SCOPE_AGENT); }
__device__ __forceinline__ unsigned xb_xcc_id() { return (unsigned)__builtin_amdgcn_s_getreg((3 << 11) | 20) & 0xFu; }
#define XB_SPIN(cond, bar) do { unsigned _sp = 0; while (cond) { __builtin_amdgcn_s_sleep(1); \
    if ((++_sp & 255u) == 0u) { if (xb_ld(&(bar)[XB_TMO])) break; if (_sp > XB_SPIN_CAP) { atomicAdd(&(bar)[XB_TMO], 1u); break; } } } } while (0)

struct XcdBarrier {
    unsigned* bar; unsigned x;
    volatile LAS unsigned* st;
};

__device__ __forceinline__ XcdBarrier xcd_barrier_post(unsigned* bar, volatile LAS unsigned* st) {
    XcdBarrier b; b.bar = bar; b.x = xb_xcc_id(); b.st = st;
    if (threadIdx.x == 0) (void)xb_add(&bar[XB_XCNT(b.x)], 1u);
    return b;
}
__device__ __forceinline__ void xcd_barrier_complete(unsigned* bar, unsigned x, unsigned& nloc, unsigned& nx) {
    const unsigned G = gridDim.x * gridDim.y * gridDim.z;
    unsigned sum, cnt, mine, sp = 0u;
    for (;;) {
        sum = 0u; cnt = 0u; mine = 0u;
#pragma unroll
        for (unsigned j = 0; j < 16; ++j) { const unsigned c = xb_ld(&bar[XB_XCNT(j)]); sum += c; cnt += (c > 0u) ? 1u : 0u; mine = (j == x) ? c : mine; }
        if (sum == G) break;
        __builtin_amdgcn_s_sleep(1);
        if ((++sp & 255u) == 0u) { if (xb_ld(&bar[XB_TMO])) break; if (sp > XB_SPIN_CAP) { atomicAdd(&bar[XB_TMO], 1u); break; } }
    }
    nloc = mine > 0u ? mine : 1u; nx = cnt > 0u ? cnt : 1u;
}

__device__ __forceinline__ void xcd_barrier(const XcdBarrier& b) {
    asm volatile("s_waitcnt vmcnt(0)" ::: "memory");
    __syncthreads();
    if (threadIdx.x == 0) {
        unsigned* bar = b.bar;
        __builtin_amdgcn_s_waitcnt(0);
        unsigned nloc = b.st[0], nx = b.st[1];
        if (nloc == 0u) { xcd_barrier_complete(bar, b.x, nloc, nx); b.st[0] = nloc; b.st[1] = nx; }
        const unsigned old = xb_add(&bar[XB_XSUB(b.x)], 1u);
        const unsigned gen = old / nloc;
        if (old + 1u == (gen + 1u) * nloc) {
            __builtin_amdgcn_fence(__ATOMIC_RELEASE, "agent");
            asm volatile("s_waitcnt vmcnt(0)" ::: "memory");
            const unsigned og = xb_add(&bar[XB_TOP], 1u);
            const unsigned tg = og / nx;
            if (og + 1u == (tg + 1u) * nx) xb_add(&bar[XB_TOPGEN], 1u);
            else XB_SPIN(xb_ld(&bar[XB_TOPGEN]) == tg, bar);
            __builtin_amdgcn_fence(__ATOMIC_ACQUIRE, "agent");
            xb_add(&bar[XB_XGEN(b.x)], 1u);
            asm volatile("s_waitcnt vmcnt(0)" ::: "memory");
        } else {
            XB_SPIN(xb_ld(&bar[XB_XGEN(b.x)]) == gen, bar);
            __builtin_amdgcn_fence(__ATOMIC_ACQUIRE, "agent");
            asm volatile("s_waitcnt vmcnt(0)" ::: "memory");
        }
    }
    __syncthreads();
}
struct Frame {
    LAS unsigned char* lds;
    volatile LAS unsigned* MISC;
    gu32* ctl;
    int tid, lane, wave;
    int vcu, G;
    const float* x; float* out;
    const float *g1, *w_in, *lq1, *lk1, *lq2, *lk2, *subg, *sinks, *w_out, *g2, *w_rg, *b_rg, *w_re, *b_re, *w_gate, *w_up, *w_down, *gf;
    bf16 *Win_t, *Wo_t, *Wgu_t, *Wd_t;
    bf16 *XN, *OD, *HB, *Y, *MIX, *QKV, *XS, *HM;
    float *Wr, *rope;
    int* tok_e; float* tok_g; float* tok_rstd; int* cnt; unsigned* blk_e; int* slot_dst; float* slot_gate; float* slot_rstd; int* slot_tok;
};
__device__ __forceinline__ float wave_sum(float v) {
#pragma unroll
    for (int o = 1; o < 64; o <<= 1) v += __shfl_xor(v, o);
    return v;
}
__device__ __forceinline__ void tr_item(const float* W, int ldn, int k0, int sc, const float* ksc, bf16* WT, int Kd, int drow0, LAS float* scr, int lane) {
#pragma unroll 8
    for (int i = 0; i < 32; ++i) { const int kk = 2 * i + (lane >> 5); float v = W[(size_t)(k0 + kk) * ldn + sc]; if (ksc) v *= ksc[k0 + kk]; scr[kk * 33 + (lane & 31)] = v; }
    LDS_WAIT(); asm volatile("" ::: "memory");
    const int c = lane & 7;
#pragma unroll
    for (int j = 0; j < 4; ++j) { const int n = (lane >> 3) + 8 * j; const LAS float* s = scr + (8 * c) * 33 + n;
        v4u o; o.x = pk2(s[0 * 33], s[1 * 33]); o.y = pk2(s[2 * 33], s[3 * 33]); o.z = pk2(s[4 * 33], s[5 * 33]); o.w = pk2(s[6 * 33], s[7 * 33]);
        *(GAS v4u*)(WT + (size_t)(drow0 + n) * Kd + k0 + 8 * c) = o; }
    LDS_WAIT(); asm volatile("" ::: "memory");
}
__device__ __forceinline__ void tr_item_w(const float* W, int ldn, int k0, int n0, const float* ksc, bf16* WT, int Kd, int drow0, LAS float* scr, int lane) {
    const int r = lane >> 3, c4 = (lane & 7) * 4;
    f32x4 v[8];
#pragma unroll
    for (int i = 0; i < 8; ++i) v[i] = *(const GAS f32x4*)(W + (size_t)(k0 + 8 * i + r) * ldn + n0 + c4);
    if (ksc) {
#pragma unroll
        for (int i = 0; i < 8; ++i) v[i] = v[i] * ksc[k0 + 8 * i + r]; }
#pragma unroll
    for (int i = 0; i < 8; ++i) { LAS float* d = scr + (8 * i + r) * 33 + c4; d[0] = v[i].x; d[1] = v[i].y; d[2] = v[i].z; d[3] = v[i].w; }
    LDS_WAIT(); asm volatile("" ::: "memory");
    const int c = lane & 7;
#pragma unroll
    for (int j = 0; j < 4; ++j) { const int n = (lane >> 3) + 8 * j; const LAS float* s = scr + (8 * c) * 33 + n;
        v4u o; o.x = pk2(s[0 * 33], s[1 * 33]); o.y = pk2(s[2 * 33], s[3 * 33]); o.z = pk2(s[4 * 33], s[5 * 33]); o.w = pk2(s[6 * 33], s[7 * 33]);
        *(GAS v4u*)(WT + (size_t)(drow0 + n) * Kd + k0 + 8 * c) = o; }
    LDS_WAIT(); asm volatile("" ::: "memory");
}
__device__ __forceinline__ int win_src_col(int n) {
    const bool isrope = (n < 1024) || (n >= 1536 && n < 2176);
    if (!isrope) return n;
    const int j = n & 63; return (n & ~63) + (j >> 1) + 32 * (j & 1);
}
constexpr int I_IN = (IN_COLS / 32) * (D / 64), I_O = (D / 32) * (D / 64), I_GU = NEXP * (1024 / 32) * (D / 64), I_D = NEXP * (D / 32) * (FF / 64), I_MOE = I_GU + I_D;
constexpr int MOE_TAIL_ITEMS = 17408;
__device__ __forceinline__ void moe_weight_items(Frame& F, int lo, int hi, int w, int nw) {
    LAS float* scr = (LAS float*)(F.lds + RING_OFF + F.wave * 16384);
    int lane_ = F.lane; asm volatile("" : "+v"(lane_)); const int lane = lane_;
    for (int it = lo + w; it < hi; it += nw) {
        int r = it;
        if (r < I_GU) { const int e = r / 512, q = r % 512, nb = q % 32, kb = q / 32;
            const float* src = (((nb >> 2) & 1) ? F.w_up : F.w_gate) + (size_t)e * D * FF; const int f0 = (nb >> 3) * 128 + (nb & 3) * 32;
            tr_item_w(src, FF, 64 * kb, f0, F.g2, F.Wgu_t + (size_t)e * 1024 * D, D, 32 * nb, scr, lane); continue; } r -= I_GU;
        { const int e = r / 256, q = r % 256, nb = q % 32, kb = q / 32;
            tr_item_w(F.w_down + (size_t)e * FF * D, D, 64 * kb, 32 * nb, nullptr, F.Wd_t + (size_t)e * D * FF, FF, 32 * nb, scr, lane); }
    }
}
__device__ __forceinline__ void p0_prologue(Frame& F) {
    LAS float* scr = (LAS float*)(F.lds + RING_OFF + F.wave * 16384);
    int lane_ = F.lane; asm volatile("" : "+v"(lane_)); const int gw = F.vcu * NWAVES + F.wave, NGW = F.G * NWAVES, lane = lane_;
    for (int it = gw; it < I_IN + I_O; it += NGW) {
        int r = it;
        if (r < I_IN) { const int nb = r % (IN_COLS / 32), kb = r / (IN_COLS / 32); tr_item(F.w_in, IN_COLS, 64 * kb, win_src_col(32 * nb + (lane & 31)), nullptr, F.Win_t, D, 32 * nb, scr, lane); continue; } r -= I_IN;
        { const int nb = r % (D / 32), kb = r / (D / 32); tr_item_w(F.w_out, D, 64 * kb, 32 * nb, nullptr, F.Wo_t, D, 32 * nb, scr, lane); }
    }
    if (F.G != 256) moe_weight_items(F, 0, I_MOE, gw, NGW);
    for (int i = (gw * 64 + lane); i < 3 * 8 * 4 * 64; i += NGW * 64) { const int ln = i & 63, q = (i >> 6) & 3, S = (i >> 8) & 7, blk = i >> 11, j = 16 * blk + (ln & 15), k0 = 128 * S + 32 * (ln >> 4) + 8 * q;
        unsigned hi[8], lo[8];
#pragma unroll
        for (int e = 0; e < 8; ++e) { const int k = k0 + e; const float w = j < 4 ? F.g2[k] * F.w_rg[k * 4 + j] : j < 36 ? F.g2[k] * F.w_re[k * NEXP + (j - 4)] : 0.f;
            hi[e] = f2bf(w); lo[e] = f2bf(w - __uint_as_float(hi[e] << 16)); }
        v4u oh, ol; oh.x = hi[0] | (hi[1] << 16); oh.y = hi[2] | (hi[3] << 16); oh.z = hi[4] | (hi[5] << 16); oh.w = hi[6] | (hi[7] << 16);
        ol.x = lo[0] | (lo[1] << 16); ol.y = lo[2] | (lo[3] << 16); ol.z = lo[4] | (lo[5] << 16); ol.w = lo[6] | (lo[7] << 16);
        *((GAS v4u*)F.Wr + i) = oh; *((GAS v4u*)F.Wr + 3 * 8 * 4 * 64 + i) = ol; }
    for (int i = (gw * 64 + lane); i < SEQ * 32; i += NGW * 64) { const int pos = i >> 5, fi = i & 31;
        double inv = 1.0; for (int q = 0; q < fi; ++q) inv *= 0.74989420933245582730;
        const double rev = (double)pos * inv * 0.15915494309189533577; const float fr = (float)(rev - __builtin_rint(rev));
        typedef float f32x2g __attribute__((ext_vector_type(2))); f32x2g cs; cs.x = __builtin_amdgcn_cosf(fr); cs.y = __builtin_amdgcn_sinf(fr); *(GAS f32x2g*)(F.rope + 2 * (size_t)i) = cs; }
    { f32x4 g[4];
#pragma unroll
      for (int j = 0; j < 4; ++j) g[j] = *((const GAS f32x4*)F.g1 + lane + 64 * j);
      for (int m = 2 * gw; m < T; m += 2 * NGW) {
        const GAS f32x4* xr = (const GAS f32x4*)(F.x + (size_t)m * D) + lane;
        f32x4 v[8]; float s0 = 0.f, s1 = 0.f;
#pragma unroll
        for (int j = 0; j < 8; ++j) v[j] = xr[64 * j];
#pragma unroll
        for (int j = 0; j < 4; ++j) { s0 += (v[j].x * v[j].x + v[j].y * v[j].y) + (v[j].z * v[j].z + v[j].w * v[j].w); s1 += (v[4 + j].x * v[4 + j].x + v[4 + j].y * v[4 + j].y) + (v[4 + j].z * v[4 + j].z + v[4 + j].w * v[4 + j].w); }
        const float r0 = 1.0f / sqrtf(wave_sum(s0) * (1.f / D) + RMS_EPS), r1 = 1.0f / sqrtf(wave_sum(s1) * (1.f / D) + RMS_EPS);
        GAS unsigned long long* o8 = (GAS unsigned long long*)(F.XN + (size_t)m * D) + lane;
#pragma unroll
        for (int j = 0; j < 8; ++j) { const f32x4 gg = g[j & 3]; const float rs = j < 4 ? r0 : r1;
            o8[64 * j] = (unsigned long long)pk2(v[j].x * rs * gg.x, v[j].y * rs * gg.y) | ((unsigned long long)pk2(v[j].z * rs * gg.z, v[j].w * rs * gg.w) << 32); }
      } }
}
#ifndef SWA_ABL
#define SWA_ABL 0
#endif
template <int PART> __device__ __forceinline__ void p2_attention(Frame& F, char* lds) {
    using abf = attn_body::bf16;
#ifndef SKIP_DIFF
    if (PART != 2) for (int L = F.vcu; L < 16 * 64; L += F.G) {
        const int i = L >> 8, v = L & 255, hh = v >> 4, s = v & 15, qb = 32 * (i >> 1) + ((i & 1) ? 31 - s : s);
        const int c = hh & 1, h = (hh >> 1) & 3, b = hh >> 3;
        const abf* base = (const abf*)F.QKV + (size_t)b * SEQ * IN_COLS;
        attn_body::attn_unit_w<8>(base + h * 128 + c * 64, base + 512 + h * 128 + c * 64, base + 1024 + h * 128,
                                  (abf*)F.OD + (size_t)b * SEQ * D + c * 512 + h * 128, (const unsigned*)(F.ctl + CW_KMAX) + (b * 8 + h * 2 + c) * 8, qb * 256, 4 * qb + 4, lds);
        if (F.G == 256 && PART == 0 && i < 3) { constexpr int NREST = I_MOE - MOE_TAIL_ITEMS, SL = (NREST + 2) / 3;
            const int lo_ = i * SL, hi_ = (i + 1) * SL < NREST ? (i + 1) * SL : NREST; moe_weight_items(F, lo_, hi_, F.vcu * NWAVES + F.wave, F.G * NWAVES); __syncthreads(); }
    }
#endif
#ifndef SKIP_SWA
    if (PART != 1) for (int L0 = F.vcu;; L0 += F.G) {
        int L = L0;
        if (PART == 0) { if (F.tid == 0) F.MISC[12] = __hip_atomic_fetch_add(F.ctl + CW_SWAQ, 1u, __ATOMIC_RELAXED, __HIP_MEMORY_SCOPE_AGENT); __syncthreads(); L = (int)F.MISC[12]; __syncthreads(); }
        L = __builtin_amdgcn_readfirstlane(L);
        if (L >= 2 * 2 * 64) break;
        const int qb = L & 63, kvh = (L >> 6) & 1, b = L >> 7;
        const abf* base = (const abf*)F.QKV + (size_t)b * SEQ * IN_COLS;
        float sk[4];
#pragma unroll
        for (int g = 0; g < 4; ++g) sk[g] = F.sinks[kvh * 4 + g] * 1.4426950408889634f;
        attn_body::swa_unit<(PART == 2) ? SWA_ABL : 0>(base + 1536 + kvh * 256, base + 2048 + kvh * 64, base + 2176 + kvh * 64, (abf*)F.MIX + (size_t)b * SEQ * D + 512 + kvh * 256, (const unsigned*)(F.ctl + CW_KMAX) + 128 + (b * 2 + kvh) * 8, qb * 256, sk, lds);
    }
#endif
}
__device__ __forceinline__ void p2b_combine(Frame& F) {
    int lane_ = F.lane; asm volatile("" : "+v"(lane_)); const int gw = F.vcu * NWAVES + F.wave, NGW = F.G * NWAVES, lane = lane_;
    const float lam = __expf(wave_sum(F.lq1[lane] * F.lk1[lane])) - __expf(wave_sum(F.lq2[lane] * F.lk2[lane])) + 0.2f;
    const f32x4 ga = *(const f32x4*)(F.subg + (lane & 15) * 8), gb = *(const f32x4*)(F.subg + (lane & 15) * 8 + 4);
    for (int m = gw; m < T; m += NGW) {
        const v4u a = *(const GAS v4u*)(F.OD + (size_t)m * D + 8 * lane), b = *(const GAS v4u*)(F.OD + (size_t)m * D + 512 + 8 * lane);
        float o[8]; float ss = 0.f;
#pragma unroll
        for (int q = 0; q < 4; ++q) { const unsigned ua = q == 0 ? a.x : q == 1 ? a.y : q == 2 ? a.z : a.w, ub = q == 0 ? b.x : q == 1 ? b.y : q == 2 ? b.z : b.w;
            o[2 * q] = __uint_as_float(ua << 16) - lam * __uint_as_float(ub << 16); o[2 * q + 1] = __uint_as_float(ua & 0xffff0000u) - lam * __uint_as_float(ub & 0xffff0000u);
            ss += o[2 * q] * o[2 * q] + o[2 * q + 1] * o[2 * q + 1]; }
        ss += __shfl_xor(ss, 1); ss += __shfl_xor(ss, 2); ss += __shfl_xor(ss, 4); ss += __shfl_xor(ss, 8);
        const float r = 0.8f / sqrtf(ss * (1.f / 128.f) + RMS_EPS);
        v4u w; w.x = pk2(o[0] * r * ga[0], o[1] * r * ga[1]); w.y = pk2(o[2] * r * ga[2], o[3] * r * ga[3]); w.z = pk2(o[4] * r * gb[0], o[5] * r * gb[1]); w.w = pk2(o[6] * r * gb[2], o[7] * r * gb[3]);
        *(GAS v4u*)(F.MIX + (size_t)m * D + 8 * lane) = w;
    }
}
__device__ __forceinline__ void p4a_router(Frame& F) {
    typedef float f32x4m __attribute__((ext_vector_type(4)));
    LAS int* lcnt = (LAS int*)(F.lds + RING_OFF);
    LAS float* lgs = (LAS float*)(F.lds + RING_OFF + 1024) + F.wave * 768;
    int lane_ = F.lane; asm volatile("" : "+v"(lane_)); const int lane = lane_, n = lane & 15, g = lane >> 4;
    const GAS v4u* Wh = (const GAS v4u*)F.Wr; const GAS v4u* Wl = Wh + 3 * 8 * 4 * 64;
    for (int ch = F.vcu; ch < NCHUNK; ch += F.G) {
        if (F.tid < 32) lcnt[F.tid] = 0;
        __syncthreads();
        const int t = ch * CHUNK_TOK + F.wave * 16 + n;
        const bf16* hrow = F.HB + (size_t)t * D + 32 * g;
        f32x4m acc[3]; acc[0] = (f32x4m){0.f, 0.f, 0.f, 0.f}; acc[1] = acc[0]; acc[2] = acc[0];
        float ss = 0.f;
#pragma unroll 2
        for (int S = 0; S < 8; ++S) {
            v4u hb[4];
#pragma unroll
            for (int q = 0; q < 4; ++q) hb[q] = *(const GAS v4u*)(hrow + 128 * S + 8 * q);
#pragma unroll
            for (int q = 0; q < 4; ++q) {
#pragma unroll
                for (int e = 0; e < 4; ++e) { const unsigned u = e == 0 ? hb[q].x : e == 1 ? hb[q].y : e == 2 ? hb[q].z : hb[q].w; const float a = __uint_as_float(u << 16), c = __uint_as_float(u & 0xffff0000u); ss += a * a + c * c; }
#pragma unroll
                for (int blk = 0; blk < 3; ++blk) { const int fi = ((blk * 8 + S) * 4 + q) * 64 + lane;
                    const v4u wh = Wh[fi], wl = Wl[fi];
                    acc[blk] = __builtin_amdgcn_mfma_f32_16x16x32_bf16(__builtin_bit_cast(bf16x8, wh), __builtin_bit_cast(bf16x8, hb[q]), acc[blk], 0, 0, 0);
                    acc[blk] = __builtin_amdgcn_mfma_f32_16x16x32_bf16(__builtin_bit_cast(bf16x8, wl), __builtin_bit_cast(bf16x8, hb[q]), acc[blk], 0, 0, 0); }
            }
        }
        ss += __shfl_xor(ss, 16); ss += __shfl_xor(ss, 32);
#pragma unroll
        for (int blk = 0; blk < 3; ++blk)
#pragma unroll
            for (int r = 0; r < 4; ++r) lgs[n * 48 + 16 * blk + 4 * g + r] = acc[blk][r];
        LDS_WAIT(); asm volatile("" ::: "memory");
        const LAS float* lg = lgs + n * 48;
        const float rstd = 1.0f / sqrtf(ss * (1.f / D) + RMS_EPS);
        float gl[4];
#pragma unroll
        for (int j = 0; j < 4; ++j) gl[j] = lg[j] * rstd + F.b_rg[j];
        int gi = 0; float gm = gl[0];
#pragma unroll
        for (int j = 1; j < 4; ++j) if (gl[j] > gm) { gm = gl[j]; gi = j; }
        float den = 0.f;
#pragma unroll
        for (int j = 0; j < 4; ++j) den += __expf(gl[j] - gm);
        const float ptop = 1.0f / den;
        float el[8];
#pragma unroll
        for (int i = 0; i < 8; ++i) el[i] = lg[4 + gi * 8 + i] * rstd + F.b_re[gi * 8 + i];
        int i0 = 0; float v0 = el[0];
#pragma unroll
        for (int i = 1; i < 8; ++i) if (el[i] > v0) { v0 = el[i]; i0 = i; }
        int i1 = -1; float v1 = -INFINITY;
#pragma unroll
        for (int i = 0; i < 8; ++i) if (i != i0 && el[i] > v1) { v1 = el[i]; i1 = i; }
        const float e1w = __expf(v1 - v0), gt0 = ptop / (1.0f + e1w), gt1 = gt0 * e1w;
        if (g == 0) { const int e0 = gi * 8 + i0, e1 = gi * 8 + i1;
            F.tok_e[2 * t] = e0; F.tok_e[2 * t + 1] = e1; F.tok_g[2 * t] = gt0; F.tok_g[2 * t + 1] = gt1; F.tok_rstd[t] = rstd;
            atomicAdd((int*)&lcnt[e0], 1); atomicAdd((int*)&lcnt[e1], 1); }
        __syncthreads();
        if (F.tid < 32) F.cnt[ch * 32 + F.tid] = lcnt[F.tid];
        __syncthreads();
    }
}
__device__ __forceinline__ void p4b_scatter(Frame& F) {
    LAS int* E = (LAS int*)(F.lds + RING_OFF);
    LAS int* SL = E + 256;
    LAS int* base = SL + 256;
    LAS int* padded = base + 32;
    LAS int* padlo = padded + 32;
    LAS int* padhi = padlo + 32;
    LAS int* ptot = padhi + 32; LAS int* ppre = ptot + 512;
    int tid_ = F.tid; asm volatile("" : "+v"(tid_)); const int tid = tid_;
    for (int ch = F.vcu; ch < NCHUNK; ch += F.G) {
        int pre = 0, total = 0;
        if (tid < 256) E[tid] = F.tok_e[ch * 256 + tid];
        { const int e_ = tid & 31, part = tid >> 5; int tsum = 0, psum = 0;
#pragma unroll
          for (int q = 0; q < 16; ++q) { const int c2 = part * 16 + q; const int vv = F.cnt[c2 * 32 + e_]; tsum += vv; psum += (c2 < ch) ? vv : 0; }
          ptot[part * 32 + e_] = tsum; ppre[part * 32 + e_] = psum; }
        __syncthreads();
        if (tid < 32) {
#pragma unroll
            for (int q = 0; q < 16; ++q) { total += ptot[q * 32 + tid]; pre += ppre[q * 32 + tid]; }
            padded[tid] = (total + 255) & ~255; }
        __syncthreads();
        if (tid < 32) { int ps = 0; for (int e2 = 0; e2 < tid; ++e2) ps += padded[e2];
            base[tid] = ps + pre; padlo[tid] = ps + total; padhi[tid] = ps + padded[tid];
            if (ch == 0) { for (int rb = ps >> 8; rb < ((ps + padded[tid]) >> 8); ++rb) F.blk_e[rb] = (unsigned)tid; if (tid == 31) __hip_atomic_store(F.ctl + CW_NBU, (unsigned)((ps + padded[tid]) >> 8), RLX_AGENT); } }
        __syncthreads();
        if (tid < 256) { const int e = E[tid]; int rank = 0; for (int a2 = 0; a2 < tid; ++a2) rank += (E[a2] == e) ? 1 : 0;
            const int slot = base[e] + rank; SL[tid] = slot;
            F.slot_dst[slot] = ch * 256 + tid; F.slot_tok[slot] = ch * CHUNK_TOK + (tid >> 1); F.slot_gate[slot] = F.tok_g[ch * 256 + tid]; F.slot_rstd[slot] = F.tok_rstd[ch * CHUNK_TOK + (tid >> 1)]; }
        __syncthreads();
        if (ch < NEXP) { const int lo = padlo[ch], hi = padhi[ch];
            for (int s = lo + tid; s < hi; s += NWAVES * 64) { F.slot_dst[s] = -1; F.slot_tok[s] = 0; F.slot_gate[s] = 0.f; F.slot_rstd[s] = 0.f; } }
        __syncthreads();
    }
}
__device__ __forceinline__ void p6_final(Frame& F) {
    int lane_ = F.lane; asm volatile("" : "+v"(lane_)); const int gw = F.vcu * NWAVES + F.wave, NGW = F.G * NWAVES, lane = lane_;
    f32x4 g[4];
#pragma unroll
    for (int j = 0; j < 4; ++j) g[j] = *((const GAS f32x4*)F.gf + 2 * lane + (j & 1) + 128 * (j >> 1));
    for (int m = gw; m < T; m += NGW) {
        const GAS v4u* hr = (const GAS v4u*)(F.HB + (size_t)m * D) + lane; const GAS v4u* y0 = (const GAS v4u*)(F.Y + (size_t)(2 * m) * D) + lane; const GAS v4u* y1 = (const GAS v4u*)(F.Y + (size_t)(2 * m + 1) * D) + lane;
        v4u a[2], b[2], c[2];
#pragma unroll
        for (int j = 0; j < 2; ++j) { a[j] = hr[64 * j]; b[j] = y0[64 * j]; c[j] = y1[64 * j]; }
        float v[16]; float s = 0.f;
#pragma unroll
        for (int j = 0; j < 2; ++j)
#pragma unroll
            for (int q = 0; q < 4; ++q) { const unsigned ua = q == 0 ? a[j].x : q == 1 ? a[j].y : q == 2 ? a[j].z : a[j].w, ub = q == 0 ? b[j].x : q == 1 ? b[j].y : q == 2 ? b[j].z : b[j].w, uc = q == 0 ? c[j].x : q == 1 ? c[j].y : q == 2 ? c[j].z : c[j].w;
                const float lo = __uint_as_float(ua << 16) + __uint_as_float(ub << 16) + __uint_as_float(uc << 16), hi = __uint_as_float(ua & 0xffff0000u) + __uint_as_float(ub & 0xffff0000u) + __uint_as_float(uc & 0xffff0000u);
                v[8 * j + 2 * q] = lo; v[8 * j + 2 * q + 1] = hi; s += lo * lo + hi * hi; }
        const float rstd = 1.0f / sqrtf(wave_sum(s) * (1.f / D) + RMS_EPS);
        GAS f32x4* orow = (GAS f32x4*)(F.out + (size_t)m * D) + 2 * lane;
#pragma unroll
        for (int j = 0; j < 2; ++j) { const f32x4 g0 = g[2 * j], g1 = g[2 * j + 1];
            orow[128 * j] = (f32x4){v[8 * j] * rstd * g0.x, v[8 * j + 1] * rstd * g0.y, v[8 * j + 2] * rstd * g0.z, v[8 * j + 3] * rstd * g0.w};
            orow[128 * j + 1] = (f32x4){v[8 * j + 4] * rstd * g1.x, v[8 * j + 5] * rstd * g1.y, v[8 * j + 6] * rstd * g1.z, v[8 * j + 7] * rstd * g1.w}; }
    }
}

struct Args { const float* in[19]; float* out; unsigned char* ws; };
__global__ void __launch_bounds__(NWAVES * 64, 2) hymba_fwd(Args args) {
    extern __shared__ __attribute__((aligned(16))) unsigned char lds[];
    Frame F;
    F.lds = (LAS unsigned char*)lds;
    F.MISC = (volatile LAS unsigned*)(F.lds + MISC_OFF);
    F.tid = threadIdx.x; F.lane = F.tid & 63; F.wave = __builtin_amdgcn_readfirstlane(F.tid >> 6);
    F.G = gridDim.x; { const int bx = blockIdx.x; F.vcu = (F.G % 8 == 0) ? (bx % 8) * (F.G / 8) + bx / 8 : bx; }
    unsigned char* ws = args.ws;
    F.ctl = (gu32*)(ws + WS_CTL);
    F.x = args.in[0]; F.g1 = args.in[1]; F.w_in = args.in[2]; F.lq1 = args.in[3]; F.lk1 = args.in[4]; F.lq2 = args.in[5]; F.lk2 = args.in[6]; F.subg = args.in[7]; F.sinks = args.in[8];
    F.w_out = args.in[9]; F.g2 = args.in[10]; F.w_rg = args.in[11]; F.b_rg = args.in[12]; F.w_re = args.in[13]; F.b_re = args.in[14]; F.w_gate = args.in[15]; F.w_up = args.in[16]; F.w_down = args.in[17]; F.gf = args.in[18];
    F.out = args.out;
    F.Win_t = (bf16*)(ws + WS_WIN); F.Wo_t = (bf16*)(ws + WS_WO); F.Wgu_t = (bf16*)(ws + WS_WGU); F.Wd_t = (bf16*)(ws + WS_WD);
    F.XN = (bf16*)(ws + WS_A); F.OD = F.XN; F.HB = F.XN; F.MIX = (bf16*)(ws + WS_MIX); F.Y = F.MIX; F.QKV = (bf16*)(ws + WS_QKV); F.XS = F.QKV; F.HM = (bf16*)(ws + WS_HM);
    F.Wr = (float*)(ws + WS_WR); F.rope = (float*)(ws + WS_ROPE);
    { unsigned char* p = ws + WS_TOK; F.tok_e = (int*)p; p += (size_t)T * 8; F.tok_g = (float*)p; p += (size_t)T * 8; F.tok_rstd = (float*)p; p += (size_t)T * 4; F.cnt = (int*)p; p += NCHUNK * 32 * 4;
      F.blk_e = (unsigned*)p; p += 288 * 4; F.slot_dst = (int*)p; p += (size_t)PSLOTS * 4; F.slot_gate = (float*)p; p += (size_t)PSLOTS * 4; F.slot_rstd = (float*)p; p += (size_t)PSLOTS * 4; F.slot_tok = (int*)p; }
    for (int u = F.tid; u < (LDS_BYTES - LDSCTL_OFF) / 4; u += NWAVES * 64) ((LAS unsigned*)(F.lds + LDSCTL_OFF))[u] = 0u;
    __syncthreads();
    XcdBarrier bar = xcd_barrier_post((unsigned*)(F.ctl + CW_BAR), F.MISC + 8);
#define GRID_BAR() xcd_barrier(bar)

#define RUN_P0() p0_prologue(F)
#define RUN_P1() do { pg8::Gemm g{F.XN, F.Win_t, T, IN_COLS, D}; pg8::StaticOrder S; S.init(T, IN_COLS, F.G, (int)blockIdx.x); \
      pg8::EpiQKV E{F.QKV, F.rope, attn_body::C2, 0, (unsigned*)(F.ctl + CW_KMAX)}; \
      pg8::gemm_phase<pg8::EpiQKV, pg8::StaticOrder, PG8_ALIGN, PG8_SP2>(F.lds + RING_OFF, g, S, E); \
      if (F.G == 256 && blockIdx.x >= 128) moe_weight_items(F, I_MOE - MOE_TAIL_ITEMS, I_MOE, ((int)blockIdx.x - 128) * NWAVES + F.wave, 128 * NWAVES); } while (0)
#define RUN_P2() p2_attention<0>(F, (char*)lds + RING_OFF)
#define RUN_P2B() p2b_combine(F)
#define RUN_P3() do { pg8::Gemm g{F.MIX, F.Wo_t, T, D, D}; pg8::StaticOrder S; S.init(T, D, F.G, (int)blockIdx.x); \
      pg8::EpiResid E{F.x, F.HB}; \
      pg8::gemm_phase<pg8::EpiResid, pg8::StaticOrder, PG8_ALIGN, PG8_SP2>(F.lds + RING_OFF, g, S, E); } while (0)
#define RUN_P4A() p4a_router(F)
#define RUN_P4B() p4b_scatter(F)
#define RUN_P5A() do { const int nbu = __builtin_amdgcn_readfirstlane((int)__hip_atomic_load(F.ctl + CW_NBU, RLX_AGENT)); \
      pg8::Gemm g{F.HB, F.Wgu_t, PSLOTS, NEXP * 1024, D}; pg8::MoeSched S{F.blk_e, nbu * 4, F.G, (int)blockIdx.x}; \
      LAS int* rowtab = (LAS int*)(F.lds + ROWTAB_OFF); pg8::Unit uu; \
      for (int ui = 0; ui < ROWTAB_UNITS && S.next(ui, uu); ++ui) if (F.tid < 256) rowtab[ui * 256 + F.tid] = F.slot_tok[uu.pm * 256 + F.tid];     \
      __syncthreads(); \
      pg8::EpiGateUp E{F.HM, F.slot_rstd}; \
      pg8::gemm_phase<pg8::EpiGateUp, pg8::MoeSched, PG8_ALIGN, true, true>(F.lds + RING_OFF, g, S, E, rowtab); } while (0)
#define RUN_P5B() do { const int nbu = __builtin_amdgcn_readfirstlane((int)__hip_atomic_load(F.ctl + CW_NBU, RLX_AGENT)); \
      pg8::Gemm g{F.HM, F.Wd_t, PSLOTS, NEXP * 1024, FF}; pg8::MoeSched S{F.blk_e, nbu * 4, F.G, (int)blockIdx.x}; \
      pg8::EpiDown E{F.Y, F.slot_dst, F.slot_gate}; \
      pg8::gemm_phase<pg8::EpiDown, pg8::MoeSched, PG8_ALIGN, PG8_SP2>(F.lds + RING_OFF, g, S, E); } while (0)
#ifdef DUP_P0
    RUN_P0(); GRID_BAR();
#endif
    RUN_P0(); GRID_BAR();
#ifdef DUP_P1
    { pg8::Gemm g{F.XN, F.Win_t, T, IN_COLS, D}; pg8::StaticOrder S; S.init(T, IN_COLS, F.G, (int)blockIdx.x);
      pg8::EpiQKV E{F.QKV, F.rope, attn_body::C2, DUP_P1, (unsigned*)(F.ctl + CW_KMAX)};
      pg8::gemm_phase<pg8::EpiQKV, pg8::StaticOrder, PG8_ALIGN, PG8_SP2>(F.lds + RING_OFF, g, S, E); }
    GRID_BAR();
#endif
    RUN_P1(); GRID_BAR();
#ifdef DUP_P2
    p2_attention<DUP_P2>(F, (char*)lds + RING_OFF); GRID_BAR();
#endif
    RUN_P2(); GRID_BAR();
#ifdef DUP_P2B
    RUN_P2B(); GRID_BAR();
#endif
    RUN_P2B(); GRID_BAR();
#ifdef DUP_P3
    RUN_P3(); GRID_BAR();
#endif
    RUN_P3(); GRID_BAR();
#ifdef DUP_P4A
    RUN_P4A(); GRID_BAR();
#endif
    RUN_P4A(); GRID_BAR();
#ifdef DUP_P4B
    RUN_P4B(); GRID_BAR();
#endif
    RUN_P4B(); GRID_BAR();
#ifdef DUP_P5A
    RUN_P5A(); GRID_BAR();
#endif
    RUN_P5A(); GRID_BAR();
#ifdef DUP_P5B
    RUN_P5B(); GRID_BAR();
#endif
    RUN_P5B(); GRID_BAR();
#ifndef SKIP_P6
    p6_final(F);
#endif
}

extern "C" void kernel_launch(void* const* d_in, const int* in_sizes, int n_in, void* d_out, int out_size, void* d_ws, size_t ws_size, hipStream_t stream) {
    static int grid = 0;
    if (grid == 0) {
        if (n_in != 19 || in_sizes[0] != T * D || out_size != T * D || ws_size < WS_END) { fprintf(stderr, "kernel_launch: unexpected shapes (n_in %d, in0 %d, out %d, ws %zu); nothing launched\n", n_in, n_in > 0 ? in_sizes[0] : -1, out_size, ws_size); grid = -1; return; }
        int dev = 0, cus = 0, per_cu = 0;
        if (hipGetDevice(&dev) != hipSuccess || hipDeviceGetAttribute(&cus, hipDeviceAttributeMultiprocessorCount, dev) != hipSuccess) { grid = -1; return; }
        if (hipFuncSetAttribute((const void*)hymba_fwd, hipFuncAttributeMaxDynamicSharedMemorySize, LDS_BYTES) != hipSuccess) { grid = -1; return; }
        if (hipOccupancyMaxActiveBlocksPerMultiprocessor(&per_cu, (const void*)hymba_fwd, NWAVES * 64, LDS_BYTES) != hipSuccess || per_cu < 1) { fprintf(stderr, "kernel_launch: occupancy query reports %d\n", per_cu); }
        (void)hipGetLastError();
        grid = cus;
    }
    if (grid < 0) return;
    if (hipMemsetAsync((char*)d_ws + WS_CTL, 0, CTL_ZERO_BYTES, stream) != hipSuccess) return;
    Args a{};
    for (int i = 0; i < 19; ++i) a.in[i] = (const float*)d_in[i];
    a.out = (float*)d_out; a.ws = (unsigned char*)d_ws;
    hipLaunchKernelGGL(hymba_fwd, dim3(grid), dim3(NWAVES * 64), LDS_BYTES, stream, a);
}
```

```cpp
#include <hip/hip_runtime.h>
#include <cstdio>
#include <cstdint>
namespace pg8 {
#define PG8_LAS __attribute__((address_space(3)))
typedef unsigned short bf16_t;
typedef short bf16x8 __attribute__((ext_vector_type(8)));
typedef float f32x4 __attribute__((ext_vector_type(4)));
typedef unsigned u32x4 __attribute__((ext_vector_type(4)));
constexpr int BM = 256, BK = 64, HALF = 128, HTB = HALF * BK * 2  , STAGE_BYTES = 8 * HTB, NXCD = 8, WGM = 2;

__host__ __device__ __forceinline__ int lds_byte(int r, int c) { const int st = (r >> 4) * 2 + (c >> 5), rr = r & 15, cc = c & 31, ob = rr * 64 + cc * 2; return st * 1024 + (ob ^ (((ob >> 9) & 1) << 5)); }
__host__ __device__ __forceinline__ void stage_rc(int b, int& R, int& C) { const int st = b / 1024, sb = b % 1024, swz = sb ^ (((sb >> 9) & 1) << 5); R = (st >> 1) * 16 + swz / 64; C = (st & 1) * 32 + (swz % 64) / 2; }
__host__ __device__ __forceinline__ int perm32(int rho) { const int n = rho >> 4, i = rho & 15; return 8 * (i >> 2) + 4 * n + (i & 3); }

struct Unit { int pm, pn; };
struct Gemm { const bf16_t* A; const bf16_t* Bt; int M, N, K; };

struct StaticOrder {
    static constexpr bool DYN = false;
    int nM, nN, nwg, G, c;
    __host__ __device__ void init(int M, int N, int G_, int c_) { nM = M / BM; nN = N / BM; nwg = nM * nN; G = G_; c = c_; }
    __host__ __device__ bool next(int i, Unit& u) const {
        const long L = (long)i * G + c; if (L >= nwg) return false;
        int wgid = (int)L; { const int q = nwg / NXCD, r = nwg % NXCD, xcd = wgid % NXCD, off = wgid / NXCD; wgid = (xcd < r ? xcd * (q + 1) : r * (q + 1) + (xcd - r) * q) + off; }
        const int nig = WGM * nN, gid = wgid / nig, fm = gid * WGM, gsz = (nM - fm) < WGM ? (nM - fm) : WGM;
        u.pm = fm + ((wgid % nig) % gsz); u.pn = (wgid % nig) / gsz; return true;
    }
    __device__ __forceinline__ void a_ready(const Unit&) const {}
    __device__ __forceinline__ void done(const Unit&) const {}
};

__device__ __forceinline__ unsigned cvt_pk_bf16(float lo, float hi) { unsigned r; asm volatile("v_cvt_pk_bf16_f32 %0, %1, %2" : "=v"(r) : "v"(lo), "v"(hi)); return r; }
typedef float f32x2 __attribute__((ext_vector_type(2)));
__device__ __forceinline__ f32x2 gelu_pk(f32x2 v) {
    const f32x2 av = __builtin_elementwise_abs(v), d = av * 0.2316418882f + 1.0f;
    f32x2 t; t.x = __builtin_amdgcn_rcpf(d.x); t.y = __builtin_amdgcn_rcpf(d.y);
    f32x2 q = t * 0.5307027145f + (-0.7265760135f); q = q * t + 0.7107068705f; q = q * t + (-0.142248368f); q = q * t + 0.127414796f; q = q * t;
    const f32x2 s = (v * v) * (-0.72134752044f);
    f32x2 e; e.x = __builtin_amdgcn_exp2f(s.x); e.y = __builtin_amdgcn_exp2f(s.y);
    const f32x2 m = v * (q * e), r = v - m;
    f32x2 o; o.x = v.x < 0.f ? m.x : r.x; o.y = v.y < 0.f ? m.y : r.y; return o;
}

template <int ACT  > struct EpiBf16 {
    static constexpr bool PERM = true, AFTER_DRAIN = false; static_assert(ACT == 0 || ACT == 1, "EpiBf16: ACT is 0 (none) or 1 (gelu_pk)");
    bf16_t* O; int ldc; const float* bias; int split_cols; size_t split_stride; float scale0;
    __device__ __forceinline__ void operator()(const f32x4 (&acc)[2][2][4][2], const Unit& u, int wr, int wc, int fr, int fq) const {
        const int row0 = u.pm * BM + wr * 64 + fr; int colt = u.pn * BM; bf16_t* base = O;
        float sc = 1.f; if (split_cols) { const int t = colt / split_cols; base += (size_t)t * split_stride; colt -= t * split_cols; if (t == 0) sc = scale0; }
        const int col0 = colt + wc * 32 + 8 * fq, bcol0 = u.pn * BM + wc * 32 + 8 * fq;
        f32x4 bv[2][2];
#pragma unroll
        for (int bj = 0; bj < 2; ++bj)
#pragma unroll
            for (int n = 0; n < 2; ++n) bv[bj][n] = bias ? *(const f32x4*)(bias + bcol0 + bj * HALF + 4 * n) : (f32x4){0.f, 0.f, 0.f, 0.f};
#pragma unroll
        for (int ai = 0; ai < 2; ++ai)
#pragma unroll
            for (int m = 0; m < 4; ++m) { bf16_t* rowp = base + (size_t)(row0 + ai * HALF + m * 16) * ldc + col0;
#pragma unroll
                for (int bj = 0; bj < 2; ++bj) { f32x4 v0 = acc[ai][bj][m][0] + bv[bj][0], v1 = acc[ai][bj][m][1] + bv[bj][1];
                    if (ACT == 1) { f32x2 a = gelu_pk((f32x2){v0[0], v0[1]}), b = gelu_pk((f32x2){v0[2], v0[3]}), c = gelu_pk((f32x2){v1[0], v1[1]}), d = gelu_pk((f32x2){v1[2], v1[3]});
                        v0 = (f32x4){a.x, a.y, b.x, b.y}; v1 = (f32x4){c.x, c.y, d.x, d.y}; }
                    v0 = v0 * sc; v1 = v1 * sc; u32x4 w; w.x = cvt_pk_bf16(v0[0], v0[1]); w.y = cvt_pk_bf16(v0[2], v0[3]); w.z = cvt_pk_bf16(v1[0], v1[1]); w.w = cvt_pk_bf16(v1[2], v1[3]);
                    *(u32x4*)(rowp + bj * HALF) = w; } }
    }
};

constexpr int QKV_LD = 2304, SEQ_LEN = 16384;
struct EpiQKV {
    static constexpr bool PERM = true, AFTER_DRAIN = false;
    bf16_t* O; const float* rope; float qscale; int norope; unsigned* kmax;
    __device__ __forceinline__ void operator()(const f32x4 (&acc)[2][2][4][2], const Unit& u, int wr, int wc, int fr, int fq) const {
        const int row0 = u.pm * BM + wr * 64 + fr;
#pragma unroll
        for (int bj = 0; bj < 2; ++bj) {
            const int cb = u.pn * BM + bj * HALF, col0 = cb + wc * 32 + 8 * fq;
            const bool isrope = !norope && ((cb < 1024) || (cb >= 1536 && cb < 2176));
            const float sc = ((cb < 512) || (cb >= 1536 && cb < 2048)) ? qscale : 1.f;
            const int i0 = (col0 & 63) >> 1;
            const bool iskd = ((cb >= 512) && (cb < 1024)) || cb == 2048; float kmx = 0.f;
#pragma unroll
            for (int ai = 0; ai < 2; ++ai)
#pragma unroll
                for (int m = 0; m < 4; ++m) {
                    const int row = row0 + ai * HALF + m * 16;
                    f32x4 v0 = acc[ai][bj][m][0], v1 = acc[ai][bj][m][1];
                    if (isrope) {
                        const int pos = row & (SEQ_LEN - 1);
                        const f32x4* tp = (const f32x4*)(rope + ((size_t)pos * 32 + i0) * 2);
                        const f32x4 t0 = tp[0], t1 = tp[1];
                        f32x4 r0, r1;
                        r0[0] = v0[0] * t0[0] - v0[1] * t0[1]; r0[1] = v0[0] * t0[1] + v0[1] * t0[0];
                        r0[2] = v0[2] * t0[2] - v0[3] * t0[3]; r0[3] = v0[2] * t0[3] + v0[3] * t0[2];
                        r1[0] = v1[0] * t1[0] - v1[1] * t1[1]; r1[1] = v1[0] * t1[1] + v1[1] * t1[0];
                        r1[2] = v1[2] * t1[2] - v1[3] * t1[3]; r1[3] = v1[2] * t1[3] + v1[3] * t1[2];
                        v0 = r0; v1 = r1;
                    }
                    if (iskd) kmx = __builtin_fmaxf(kmx, (v0[0] * v0[0] + v0[1] * v0[1]) + (v0[2] * v0[2] + v0[3] * v0[3]) + (v1[0] * v1[0] + v1[1] * v1[1]) + (v1[2] * v1[2] + v1[3] * v1[3]));
                    v0 = v0 * sc; v1 = v1 * sc;
                    u32x4 w; w.x = cvt_pk_bf16(v0[0], v0[1]); w.y = cvt_pk_bf16(v0[2], v0[3]); w.z = cvt_pk_bf16(v1[0], v1[1]); w.w = cvt_pk_bf16(v1[2], v1[3]);
                    *(u32x4*)(O + (size_t)row * QKV_LD + col0) = w;
                }
            if (iskd) {
                kmx = __builtin_fmaxf(kmx, __builtin_bit_cast(float, __builtin_amdgcn_mov_dpp(__builtin_bit_cast(int, kmx), 0xB1, 0xF, 0xF, true)));
                kmx = __builtin_fmaxf(kmx, __builtin_bit_cast(float, __builtin_amdgcn_mov_dpp(__builtin_bit_cast(int, kmx), 0x4E, 0xF, 0xF, true)));
                kmx = __builtin_fmaxf(kmx, __builtin_bit_cast(float, __builtin_amdgcn_mov_dpp(__builtin_bit_cast(int, kmx), 0x141, 0xF, 0xF, true)));
                kmx = __builtin_fmaxf(kmx, __builtin_bit_cast(float, __builtin_amdgcn_mov_dpp(__builtin_bit_cast(int, kmx), 0x140, 0xF, 0xF, true)));
                const int slot = cb < 1024 ? (((u.pm >> 6) * 8 + ((cb + wc * 32 - 512) >> 6)) * 8) : (128 + ((u.pm >> 6) * 2 + (wc >> 1)) * 8);
                if (fr == 0) __hip_atomic_fetch_max(kmax + slot + (wc & 1) * 4 + fq, __builtin_bit_cast(unsigned, kmx), __ATOMIC_RELAXED, __HIP_MEMORY_SCOPE_AGENT); }
        }
    }
};
struct EpiResid {
    static constexpr bool PERM = true, AFTER_DRAIN = false;
    const float* x; bf16_t* hb;
    __device__ __forceinline__ void operator()(const f32x4 (&acc)[2][2][4][2], const Unit& u, int wr, int wc, int fr, int fq) const {
        const int row0 = u.pm * BM + wr * 64 + fr;
#pragma unroll
        for (int ai = 0; ai < 2; ++ai)
#pragma unroll
            for (int m = 0; m < 4; ++m) {
                const size_t ro = (size_t)(row0 + ai * HALF + m * 16) * 1024;
#pragma unroll
                for (int bj = 0; bj < 2; ++bj) {
                    const size_t o = ro + u.pn * BM + bj * HALF + wc * 32 + 8 * fq;
                    const f32x4 v0 = acc[ai][bj][m][0] + *(const f32x4*)(x + o), v1 = acc[ai][bj][m][1] + *(const f32x4*)(x + o + 4);
                    u32x4 w; w.x = cvt_pk_bf16(v0[0], v0[1]); w.y = cvt_pk_bf16(v0[2], v0[3]); w.z = cvt_pk_bf16(v1[0], v1[1]); w.w = cvt_pk_bf16(v1[2], v1[3]);
                    *(u32x4*)(hb + o) = w;
                }
            }
    }
};
__device__ __forceinline__ float silu_mul(float g, float up) { return g * __builtin_amdgcn_rcpf(1.0f + __builtin_amdgcn_exp2f(-1.4426950408889634f * g)) * up; }
struct EpiGateUp {
    static constexpr bool PERM = true, AFTER_DRAIN = false;
    bf16_t* hm; const float* slot_rstd;
    __device__ __forceinline__ void operator()(const f32x4 (&acc)[2][2][4][2], const Unit& u, int wr, int wc, int fr, int fq) const {
        const int row0 = u.pm * BM + wr * 64 + fr, f0 = (u.pn & 3) * 128 + wc * 32 + 8 * fq;
#pragma unroll
        for (int ai = 0; ai < 2; ++ai)
#pragma unroll
            for (int m = 0; m < 4; ++m) {
                const int row = row0 + ai * HALF + m * 16; const float rs = slot_rstd[row];
                const f32x4 g0 = acc[ai][0][m][0] * rs, g1 = acc[ai][0][m][1] * rs, u0 = acc[ai][1][m][0] * rs, u1 = acc[ai][1][m][1] * rs;
                u32x4 w; w.x = cvt_pk_bf16(silu_mul(g0[0], u0[0]), silu_mul(g0[1], u0[1])); w.y = cvt_pk_bf16(silu_mul(g0[2], u0[2]), silu_mul(g0[3], u0[3]));
                w.z = cvt_pk_bf16(silu_mul(g1[0], u1[0]), silu_mul(g1[1], u1[1])); w.w = cvt_pk_bf16(silu_mul(g1[2], u1[2]), silu_mul(g1[3], u1[3]));
                *(u32x4*)(hm + (size_t)row * 512 + f0) = w;
            }
    }
};
struct EpiDown {
    static constexpr bool PERM = true, AFTER_DRAIN = false;
    bf16_t* Y; const int* slot_dst; const float* slot_gate;
    __device__ __forceinline__ void operator()(const f32x4 (&acc)[2][2][4][2], const Unit& u, int wr, int wc, int fr, int fq) const {
        const int row0 = u.pm * BM + wr * 64 + fr, c0 = (u.pn & 3) * BM + wc * 32 + 8 * fq;
#pragma unroll
        for (int ai = 0; ai < 2; ++ai)
#pragma unroll
            for (int m = 0; m < 4; ++m) {
                const int row = row0 + ai * HALF + m * 16; const int dst = slot_dst[row]; const float gt = slot_gate[row];
                if (dst >= 0) {
#pragma unroll
                    for (int bj = 0; bj < 2; ++bj) { const f32x4 v0 = acc[ai][bj][m][0] * gt, v1 = acc[ai][bj][m][1] * gt;
                        u32x4 w; w.x = cvt_pk_bf16(v0[0], v0[1]); w.y = cvt_pk_bf16(v0[2], v0[3]); w.z = cvt_pk_bf16(v1[0], v1[1]); w.w = cvt_pk_bf16(v1[2], v1[3]);
                        *(u32x4*)(Y + (size_t)dst * 1024 + c0 + bj * HALF) = w; }
                }
            }
    }
};
struct MoeSched {
    static constexpr bool DYN = false;
    const unsigned* blk_e; int nunits, G, c;
    __device__ __forceinline__ bool next(int i, Unit& u) const {
        const long L = (long)i * G + c; if (L >= nunits) return false;
        int wgid = (int)L; { const int q = nunits / NXCD, r = nunits % NXCD, xcd = wgid % NXCD, off = wgid / NXCD; wgid = (xcd < r ? xcd * (q + 1) : r * (q + 1) + (xcd - r) * q) + off; }
        const int rb = wgid >> 2, j = wgid & 3;
        const int e = __builtin_amdgcn_readfirstlane((int)__hip_atomic_load(blk_e + rb, __ATOMIC_RELAXED, __HIP_MEMORY_SCOPE_AGENT));
        u.pm = rb; u.pn = e * 4 + j; return true;
    }
    __device__ __forceinline__ void a_ready(const Unit&) const {}
    __device__ __forceinline__ void done(const Unit&) const {}
};
struct XcdSched {
    static constexpr bool DYN = false;
    const unsigned* blk_e; int lo, hi, r, nloc; unsigned* donew;
    __device__ __forceinline__ bool next(int i, Unit& u) const {
        const int L = i * nloc + r; if (L >= 4 * (hi - lo)) return false;
        const int rb = lo + (L >> 2), j = L & 3;
        const int e = __builtin_amdgcn_readfirstlane((int)__hip_atomic_load(blk_e + rb, __ATOMIC_RELAXED, __HIP_MEMORY_SCOPE_AGENT));
        u.pm = rb; u.pn = e * 4 + j; return true;
    }
    __device__ __forceinline__ void a_ready(const Unit&) const {}
    __device__ __forceinline__ void done(const Unit& u) const {
        asm volatile("s_waitcnt vmcnt(0)" ::: "memory");
        if ((threadIdx.x & 63) == 0) (void)__hip_atomic_fetch_add(donew + u.pm, 1u, __ATOMIC_RELAXED, __HIP_MEMORY_SCOPE_AGENT);
    }
};
struct XcdDyn {
    static constexpr bool DYN = true;
    const unsigned* blk_e; int lo, hi; unsigned* ctr; unsigned* donew; volatile PG8_LAS unsigned* w;
    mutable unsigned nx;
    __device__ __forceinline__ bool unit_of(unsigned k, Unit& u) const {
        if (k >= (unsigned)(4 * (hi - lo))) return false;
        const int rb = lo + (int)(k >> 2), j = (int)(k & 3u);
        const int e = __builtin_amdgcn_readfirstlane((int)__hip_atomic_load(blk_e + rb, __ATOMIC_RELAXED, __HIP_MEMORY_SCOPE_AGENT));
        u.pm = rb; u.pn = e * 4 + j; return true;
    }
    __device__ __forceinline__ bool first(Unit& u) const {
        if (threadIdx.x == 0) w[0] = __hip_atomic_fetch_add(ctr, 1u, __ATOMIC_RELAXED, __HIP_MEMORY_SCOPE_AGENT);
        __syncthreads(); const unsigned k = (unsigned)__builtin_amdgcn_readfirstlane((int)w[0]); return unit_of(k, u);
    }
    __device__ __forceinline__ void claim_issue() const { if (threadIdx.x == 0) nx = __hip_atomic_fetch_add(ctr, 1u, __ATOMIC_RELAXED, __HIP_MEMORY_SCOPE_AGENT); }
    __device__ __forceinline__ void publish(int i) const { if (threadIdx.x == 0) w[i & 1] = nx; }
    __device__ __forceinline__ bool read(int i, Unit& u) const { const unsigned k = (unsigned)__builtin_amdgcn_readfirstlane((int)w[i & 1]); return unit_of(k, u); }
    __device__ __forceinline__ void a_ready(const Unit& u) const {
        unsigned sp = 0u;
        while (__hip_atomic_load(donew + u.pm, __ATOMIC_RELAXED, __HIP_MEMORY_SCOPE_AGENT) < 32u) { __builtin_amdgcn_s_sleep(1); if (++sp > (1u << 22)) break; }
    }
    __device__ __forceinline__ void done(const Unit&) const {}
};
template <class Epi, class Sched, bool ALIGN_EPI = false, bool SP2 = false, bool GATHER = false>
__device__ __forceinline__ void gemm_phase(PG8_LAS unsigned char* lds, const Gemm g, const Sched& S, const Epi& E, PG8_LAS const int* rowtab = nullptr) {
    static_assert(!GATHER || SP2, "GATHER is wired into the SP2 loop only");
    int tid_ = threadIdx.x; asm volatile("" : "+v"(tid_));
    const int tid = tid_, wid = __builtin_amdgcn_readfirstlane(tid >> 6), lane = tid & 63, wr = wid >> 2, wc = wid & 3, fr = lane & 15, fq = lane >> 4;
    const int K = g.K, nt = K / BK;
    unsigned voffA[2], voffB[2];
#pragma unroll
    for (int i = 0; i < 2; ++i) { int R, C; stage_rc(tid * 16 + i * 8192, R, C); const int Rb = Epi::PERM ? ((R & ~31) + perm32(R & 31)) : R;
        voffA[i] = (unsigned)(R * K + C) * 2u; voffB[i] = (unsigned)(Rb * K + C) * 2u; }
    const size_t kstep = (size_t)(BK * 2);
    const size_t hstep = (size_t)HALF * K * 2;
    const size_t tstep = 2 * hstep;
    const unsigned ldsw = (unsigned)wid * 1024u;
    const int aoff = lds_byte(wr * 64 + fr, fq * 8), boff = lds_byte(wc * 32 + fr, fq * 8);
#define PG8_SA(b, h) (((b) * 2 + (h)) * HTB)
#define PG8_SB(b, h) ((4 + (b) * 2 + (h)) * HTB)
#define PG8_STAGE(bufoff, gbase, voff) do { _Pragma("unroll") for (int _i = 0; _i < 2; ++_i) \
        __builtin_amdgcn_global_load_lds((const unsigned*)((const char*)(gbase) + (voff)[_i]), (PG8_LAS unsigned*)(lds + (bufoff) + ldsw + _i * 8192), 16, 0, 0); } while (0)
#define PG8_LDA(dst, b, h) do { _Pragma("unroll") for (int m = 0; m < 4; ++m) _Pragma("unroll") for (int k = 0; k < 2; ++k) dst[m][k] = *(const PG8_LAS bf16x8*)(lds + PG8_SA(b, h) + aoff + m * 2048 + k * 1024); } while (0)
#define PG8_LDB(dst, b, h) do { _Pragma("unroll") for (int n = 0; n < 2; ++n) _Pragma("unroll") for (int k = 0; k < 2; ++k) dst[n][k] = *(const PG8_LAS bf16x8*)(lds + PG8_SB(b, h) + boff + n * 2048 + k * 1024); } while (0)
#define PG8_MMA(ai, bj, At, Bt) do { __builtin_amdgcn_s_setprio(1); _Pragma("unroll") for (int m = 0; m < 4; ++m) _Pragma("unroll") for (int n = 0; n < 2; ++n) _Pragma("unroll") for (int k = 0; k < 2; ++k) \
        acc[ai][bj][m][n] = __builtin_amdgcn_mfma_f32_16x16x32_bf16(Bt[n][k], At[m][k], acc[ai][bj][m][n], 0, 0, 0); __builtin_amdgcn_s_setprio(0); } while (0)
#define PG8_WAIT_V(n) asm volatile("s_waitcnt vmcnt(" #n ")" ::: "memory")
#define PG8_WAIT_L(n) asm volatile("s_waitcnt lgkmcnt(" #n ")" ::: "memory")
#define PG8_BAR __builtin_amdgcn_s_barrier()
#define PG8_SCHED __builtin_amdgcn_sched_barrier(0)
    Unit cur, nxt; int ui = 0;
    if constexpr (Sched::DYN) { static_assert(SP2 && !GATHER, "dynamic scheds: SP2 loop, plain A"); if (!S.first(cur)) return; } else { if (!S.next(0, cur)) return; }
    f32x4 acc[2][2][4][2];
#pragma unroll
    for (int a = 0; a < 2; ++a)
#pragma unroll
        for (int b = 0; b < 2; ++b)
#pragma unroll
            for (int m = 0; m < 4; ++m)
#pragma unroll
                for (int n = 0; n < 2; ++n) acc[a][b][m][n] = (f32x4){0.f, 0.f, 0.f, 0.f};
    bf16x8 At[4][2], B0[2][2], B1[2][2];
    const char* cA = GATHER ? (const char*)g.A : (const char*)g.A + (size_t)cur.pm * tstep; const char* cB = (const char*)g.Bt + (size_t)cur.pn * tstep;
    const size_t hstepA = GATHER ? 0 : hstep;
    unsigned gc[2][2], gn[2][2];
#define PG8_GLOAD(uidx, o) do { _Pragma("unroll") for (int _h = 0; _h < 2; ++_h) _Pragma("unroll") for (int _i = 0; _i < 2; ++_i) { int R_, C_; stage_rc(tid * 16 + _i * 8192, R_, C_); \
        o[_h][_i] = (unsigned)(rowtab[(uidx) * 256 + _h * HALF + R_] * K + C_) * 2u; } } while (0)
    if constexpr (GATHER) { PG8_GLOAD(0, gc); } else { gc[0][0] = gc[1][0] = voffA[0]; gc[0][1] = gc[1][1] = voffA[1]; }
#define PG8_ACUR(bufoff, half, kt) PG8_STAGE(bufoff, cA + (half) * hstepA + (size_t)(kt) * kstep, gc[half])
    S.a_ready(cur);
    if constexpr (SP2) {
        PG8_STAGE(PG8_SB(0, 0), cB, voffB); PG8_STAGE(PG8_SB(0, 1), cB + hstep, voffB); PG8_ACUR(PG8_SA(0, 0), 0, 0); PG8_ACUR(PG8_SA(0, 1), 1, 0);
        if (wr == 1) PG8_BAR;
        PG8_WAIT_V(2); PG8_BAR;
        PG8_STAGE(PG8_SB(1, 0), cB + kstep, voffB); PG8_ACUR(PG8_SA(1, 0), 0, 1); PG8_STAGE(PG8_SB(1, 1), cB + hstep + kstep, voffB);
        PG8_WAIT_V(6); PG8_BAR;
    } else {
        PG8_STAGE(PG8_SB(0, 0), cB, voffB); PG8_STAGE(PG8_SA(0, 0), cA, voffA); PG8_STAGE(PG8_SB(0, 1), cB + hstep, voffB); PG8_STAGE(PG8_SA(0, 1), cA + hstep, voffA);
        if (wr == 1) PG8_BAR;
        PG8_WAIT_V(4); PG8_BAR;
        PG8_STAGE(PG8_SB(1, 0), cB + kstep, voffB); PG8_STAGE(PG8_SA(1, 0), cA + kstep, voffA); PG8_STAGE(PG8_SB(1, 1), cB + hstep + kstep, voffB);
        PG8_WAIT_V(6); PG8_BAR;
    }
    for (;;) {
        bool has_next = false; if constexpr (Sched::DYN) { S.claim_issue(); } else { has_next = S.next(ui + 1, nxt); }
        const char* nA = GATHER ? cA : (has_next ? (const char*)g.A + (size_t)nxt.pm * tstep : cA); const char* nB = has_next ? (const char*)g.Bt + (size_t)nxt.pn * tstep : cB;
        if constexpr (GATHER) { if (has_next) { PG8_GLOAD(ui + 1, gn); } else { gn[0][0] = gc[0][0]; gn[0][1] = gc[0][1]; gn[1][0] = gc[1][0]; gn[1][1] = gc[1][1]; } }
        else { gn[0][0] = gc[0][0]; gn[0][1] = gc[0][1]; gn[1][0] = gc[1][0]; gn[1][1] = gc[1][1]; }
        for (int t = 0; t < nt; t += 2) {
            const bool last = (t == nt - 2);
            const char* a1 = cA + (size_t)(t + 1) * kstep;
            const char* a2; const char* b2; const char* a3; const char* b3; unsigned o2[2][2];
#define PG8_NEXTPTRS() do { a2 = last ? nA : cA + (size_t)(t + 2) * kstep; b2 = last ? nB : cB + (size_t)(t + 2) * kstep; a3 = a2 + kstep; b3 = b2 + kstep; \
            o2[0][0] = last ? gn[0][0] : gc[0][0]; o2[0][1] = last ? gn[0][1] : gc[0][1]; o2[1][0] = last ? gn[1][0] : gc[1][0]; o2[1][1] = last ? gn[1][1] : gc[1][1]; } while (0)
            if constexpr (!Sched::DYN) { PG8_NEXTPTRS(); if (last && has_next) S.a_ready(nxt); }
            else { if (last) S.publish(ui + 1); }
            if constexpr (SP2) {
            PG8_LDB(B0, 0, 0); PG8_LDB(B1, 0, 1); PG8_SCHED; PG8_LDA(At, 0, 0); PG8_STAGE(PG8_SA(1, 1), a1 + hstepA, gc[1]);
            PG8_WAIT_V(8); PG8_WAIT_L(0); PG8_BAR; PG8_MMA(0, 0, At, B0); PG8_MMA(0, 1, At, B1); PG8_BAR; PG8_SCHED;
            if constexpr (Sched::DYN) { if (last) { has_next = S.read(ui + 1, nxt); if (has_next) { S.a_ready(nxt); nA = (const char*)g.A + (size_t)nxt.pm * tstep; nB = (const char*)g.Bt + (size_t)nxt.pn * tstep; } } PG8_NEXTPTRS(); }
            PG8_LDA(At, 0, 1); PG8_STAGE(PG8_SB(0, 0), b2, voffB); PG8_STAGE(PG8_SB(0, 1), b2 + hstep, voffB); PG8_STAGE(PG8_SA(0, 0), a2, o2[0]);
            PG8_WAIT_V(8); PG8_WAIT_L(0); PG8_BAR; PG8_MMA(1, 0, At, B0); PG8_MMA(1, 1, At, B1); PG8_BAR; PG8_SCHED;
            PG8_LDB(B0, 1, 0); PG8_LDB(B1, 1, 1); PG8_SCHED; PG8_LDA(At, 1, 0); PG8_STAGE(PG8_SA(0, 1), a2 + hstepA, o2[1]);
            PG8_WAIT_V(8); PG8_WAIT_L(0); PG8_BAR; PG8_MMA(0, 0, At, B0); PG8_MMA(0, 1, At, B1); PG8_BAR; PG8_SCHED;
            PG8_LDA(At, 1, 1); PG8_STAGE(PG8_SB(1, 0), b3, voffB); PG8_STAGE(PG8_SB(1, 1), b3 + hstep, voffB); PG8_STAGE(PG8_SA(1, 0), a3, o2[0]);
            PG8_WAIT_V(8); PG8_WAIT_L(0); PG8_BAR; PG8_MMA(1, 0, At, B0); PG8_MMA(1, 1, At, B1); PG8_BAR; PG8_SCHED;
            } else {
            PG8_LDB(B0, 0, 0); PG8_SCHED; PG8_LDA(At, 0, 0); PG8_STAGE(PG8_SA(1, 1), a1 + hstep, voffA);
            PG8_WAIT_L(8); PG8_BAR; PG8_WAIT_L(0); PG8_MMA(0, 0, At, B0); PG8_BAR; PG8_SCHED;
            PG8_LDB(B1, 0, 1); PG8_STAGE(PG8_SB(0, 0), b2, voffB);
            PG8_BAR; PG8_WAIT_L(0); PG8_MMA(0, 1, At, B1); PG8_BAR;
            PG8_LDA(At, 0, 1); PG8_STAGE(PG8_SA(0, 0), a2, voffA);
            PG8_BAR; PG8_WAIT_L(0); PG8_MMA(1, 0, At, B0); PG8_BAR; PG8_SCHED;
            PG8_STAGE(PG8_SB(0, 1), b2 + hstep, voffB);
            PG8_WAIT_V(6); PG8_BAR; PG8_MMA(1, 1, At, B1); PG8_BAR;
            PG8_LDB(B0, 1, 0); PG8_SCHED; PG8_LDA(At, 1, 0); PG8_STAGE(PG8_SA(0, 1), a2 + hstep, voffA);
            PG8_WAIT_L(8); PG8_BAR; PG8_WAIT_L(0); PG8_MMA(0, 0, At, B0); PG8_BAR; PG8_SCHED;
            PG8_LDB(B1, 1, 1); PG8_STAGE(PG8_SB(1, 0), b3, voffB);
            PG8_BAR; PG8_WAIT_L(0); PG8_MMA(0, 1, At, B1); PG8_BAR;
            PG8_LDA(At, 1, 1); PG8_STAGE(PG8_SA(1, 0), a3, voffA);
            PG8_BAR; PG8_WAIT_L(0); PG8_MMA(1, 0, At, B0); PG8_BAR; PG8_SCHED;
            PG8_STAGE(PG8_SB(1, 1), b3 + hstep, voffB);
            PG8_WAIT_V(6); PG8_BAR; PG8_MMA(1, 1, At, B1); PG8_BAR;
            }
        }
        if constexpr (ALIGN_EPI) { if (wr == 0) PG8_BAR; }
        if constexpr (!Epi::AFTER_DRAIN) { E(acc, cur, wr, wc, fr, fq); S.done(cur); }
        if (!has_next) break;
#pragma unroll
        for (int a = 0; a < 2; ++a)
#pragma unroll
            for (int b = 0; b < 2; ++b)
#pragma unroll
                for (int m = 0; m < 4; ++m)
#pragma unroll
                    for (int n = 0; n < 2; ++n) acc[a][b][m][n] = (f32x4){0.f, 0.f, 0.f, 0.f};
        cur = nxt; cA = nA; cB = nB; ++ui; gc[0][0] = gn[0][0]; gc[0][1] = gn[0][1]; gc[1][0] = gn[1][0]; gc[1][1] = gn[1][1];
        if constexpr (ALIGN_EPI) { if (wr == 1) PG8_BAR; }
    }
    PG8_WAIT_V(0);
    if constexpr (!ALIGN_EPI) { if (wr == 0) PG8_BAR; }
    PG8_BAR;
    if constexpr (Epi::AFTER_DRAIN) { E.fused(acc, cur, wr, wc, fr, fq, lds, wid, lane); S.done(cur); }
#undef PG8_SA
#undef PG8_SB
#undef PG8_STAGE
#undef PG8_GLOAD
#undef PG8_ACUR
#undef PG8_LDA
#undef PG8_LDB
#undef PG8_MMA
#undef PG8_WAIT_V
#undef PG8_WAIT_L
#undef PG8_BAR
#undef PG8_SCHED
#undef PG8_NEXTPTRS
}
}

#ifndef PG8_SP2
#define PG8_SP2 true
#endif
#ifndef PG8_ALIGN
#define PG8_ALIGN true
#endif
#include <hip/hip_bf16.h>
#include <cmath>
namespace attn_body {
using bf16=__hip_bfloat16;
using bf16x8=__attribute__((ext_vector_type(8)))short;
using s16x4=__attribute__((ext_vector_type(4)))short;
using f32x16=__attribute__((ext_vector_type(16)))float;
using u32x4=__attribute__((ext_vector_type(4)))unsigned;
constexpr int D=64,PQ=2304,PO=1024,WIN=128;
constexpr int NW=8,QBLK=32,QB=QBLK*NW,KVBLK=64;
constexpr int ATTN_UNIT_ROWS=QB;
__device__ __forceinline__ int crow(int r,int hi){return (r&3)+8*(r>>2)+4*hi;}
#define SBAR() __builtin_amdgcn_sched_barrier(0)
template<int MODE> __device__ __forceinline__ void cmask(f32x16&p0,f32x16&p1,int jb,int qrel,int hi){
  const float NEG=-INFINITY; int kb=64*jb+4*hi;
  #pragma unroll
  for(int r=0;r<16;++r){int kv=kb+(r&3)+8*(r>>2);
    if(MODE==1){ if((unsigned)(qrel-kv)>=(unsigned)WIN)p0[r]=NEG; if((unsigned)(qrel-kv-32)>=(unsigned)WIN)p1[r]=NEG; }
    else { if(kv>qrel)p0[r]=NEG; if(kv+32>qrel)p1[r]=NEG; } }
}

constexpr int NSLOT=3, SLOTB=8192;
constexpr int LDS_K=0, LDS_V=NSLOT*SLOTB, LDS_WS=2*NSLOT*SLOTB, LDS_OST=LDS_WS+NW*64*4, LDS_BYTES=LDS_OST+NW*4096;
constexpr float C2=0.125f*1.4426950408889634f;
__device__ __forceinline__ void glds16(const void*gsrc,unsigned lds_dst){unsigned keep;
  asm volatile("s_mov_b32 %0, m0\n\ts_mov_b32 m0, %2\n\ts_nop 0\n\tglobal_load_lds_dwordx4 %1, off\n\ts_mov_b32 m0, %0":"=&s"(keep):"v"(gsrc),"s"(lds_dst):"memory");}
__device__ __forceinline__ float max3f(float a,float b,float c){float r;asm("v_max3_f32 %0, %1, %2, %3":"=v"(r):"v"(a),"v"(b),"v"(c));return r;}
__device__ __forceinline__ float max2f(float a,float b){float r;asm("v_max_f32_e32 %0, %1, %2":"=v"(r):"v"(a),"v"(b));return r;}
__device__ __forceinline__ float fadd_s(float a,float b){float r;asm("v_add_f32_e32 %0, %1, %2":"=v"(r):"v"(a),"v"(b));return r;}
__device__ __forceinline__ float fsub_s(float a,float b){float r;asm("v_sub_f32_e32 %0, %1, %2":"=v"(r):"v"(a),"v"(b));return r;}
typedef float f32x2_t __attribute__((ext_vector_type(2))); typedef __bf16 bf16x2_t __attribute__((ext_vector_type(2)));
__device__ __forceinline__ unsigned cvtpk_s(float lo,float hi){f32x2_t v={lo,hi};bf16x2_t b=__builtin_convertvector(v,bf16x2_t);return __builtin_bit_cast(unsigned,b);}
#define WAIT_BAR(N) asm volatile("s_waitcnt vmcnt(" #N ") lgkmcnt(0)\n\ts_barrier":::"memory")

__device__ __forceinline__ void qkt(f32x16&p0,f32x16&p1,const char*Kslot,const bf16x8*qr,const f32x16&negm,int r32,int hi){
  const char*kb=Kslot+hi*1024+r32*16;
  #pragma unroll
  for(int d0=0;d0<4;++d0){
    const bf16x8 b0=*reinterpret_cast<const bf16x8*>(kb+d0*2048);
    const bf16x8 b1=*reinterpret_cast<const bf16x8*>(kb+d0*2048+512);
    if(d0==0){p0=__builtin_amdgcn_mfma_f32_32x32x16_bf16(b0,qr[0],negm,0,0,0);p1=__builtin_amdgcn_mfma_f32_32x32x16_bf16(b1,qr[0],negm,0,0,0);}
    else{p0=__builtin_amdgcn_mfma_f32_32x32x16_bf16(b0,qr[d0],p0,0,0,0);p1=__builtin_amdgcn_mfma_f32_32x32x16_bf16(b1,qr[d0],p1,0,0,0);}}
}
typedef __attribute__((address_space(3))) const char* lds_cptr;
typedef short v4i16_t __attribute__((ext_vector_type(4)));
__device__ __forceinline__ void kload8(bf16x8*kf,lds_cptr kp){
  kf[0]=*(const __attribute__((address_space(3))) bf16x8*)(kp);      kf[1]=*(const __attribute__((address_space(3))) bf16x8*)(kp+512);
  kf[2]=*(const __attribute__((address_space(3))) bf16x8*)(kp+2048); kf[3]=*(const __attribute__((address_space(3))) bf16x8*)(kp+2560);
  kf[4]=*(const __attribute__((address_space(3))) bf16x8*)(kp+4096); kf[5]=*(const __attribute__((address_space(3))) bf16x8*)(kp+4608);
  kf[6]=*(const __attribute__((address_space(3))) bf16x8*)(kp+6144); kf[7]=*(const __attribute__((address_space(3))) bf16x8*)(kp+6656);
}
__device__ __forceinline__ void kload2(bf16x8*kf,lds_cptr kp,int j){ kf[2*j]=*(const __attribute__((address_space(3))) bf16x8*)(kp+j*2048); kf[2*j+1]=*(const __attribute__((address_space(3))) bf16x8*)(kp+j*2048+512); }
__device__ __forceinline__ s16x4 vtr(lds_cptr p){ return __builtin_bit_cast(s16x4,__builtin_amdgcn_ds_read_tr16_b64_v4i16((__attribute__((address_space(3))) v4i16_t*)p)); }
__device__ __forceinline__ float rowmax(const f32x16&p0,const f32x16&p1){
  float a=max3f(p0[0],p0[1],p1[0]),b=max3f(p0[2],p0[3],p1[1]);a=max3f(a,p1[2],p1[3]);
  #pragma unroll
  for(int r=4;r<16;r+=4){a=max3f(a,p0[r],p0[r+1]);b=max3f(b,p0[r+2],p0[r+3]);a=max3f(a,p1[r],p1[r+1]);b=max3f(b,p1[r+2],p1[r+3]);}
  const float m=max2f(a,b);
  auto rr=__builtin_amdgcn_permlane32_swap(__float_as_uint(m),__float_as_uint(m),false,false);
  return max2f(__uint_as_float(rr[0]),__uint_as_float(rr[1]));
}
__device__ __forceinline__ void pv(f32x16*o,int vb,bf16x8 pa0,bf16x8 pa1,bf16x8 pa2,bf16x8 pa3){
  #pragma unroll
  for(int d0=0;d0<2;++d0){s16x4 lo[4],hi[4];
    #pragma unroll
    for(int ks=0;ks<4;++ks){
      asm volatile("ds_read_b64_tr_b16 %0,%1 offset:%c2":"=&v"(lo[ks]):"v"(vb),"i"(d0*4096+ks*1024):"memory");
      asm volatile("ds_read_b64_tr_b16 %0,%1 offset:%c2":"=&v"(hi[ks]):"v"(vb),"i"(d0*4096+ks*1024+512):"memory");}
    asm volatile("s_waitcnt lgkmcnt(0)":::"memory");SBAR();
    #define PK(k) (bf16x8){lo[k][0],lo[k][1],lo[k][2],lo[k][3],hi[k][0],hi[k][1],hi[k][2],hi[k][3]}
    o[d0]=__builtin_amdgcn_mfma_f32_32x32x16_bf16(pa0,PK(0),o[d0],0,0,0);
    o[d0]=__builtin_amdgcn_mfma_f32_32x32x16_bf16(pa1,PK(1),o[d0],0,0,0);
    o[d0]=__builtin_amdgcn_mfma_f32_32x32x16_bf16(pa2,PK(2),o[d0],0,0,0);
    o[d0]=__builtin_amdgcn_mfma_f32_32x32x16_bf16(pa3,PK(3),o[d0],0,0,0);
    #undef PK
  }
}

#ifndef ATTN_STORE16
#define ATTN_STORE16(p,v) (*(u32x4*)(p)=(v))
#endif
template<int MODE,int THRL> __device__ __forceinline__ void attn_unit(const bf16*Qh,const bf16*__restrict__ Kh,const bf16*__restrict__ Vh,bf16*Oh,int q0,int kt0,const int NT,float sink2,char*shm){
  int tid_=threadIdx.x; asm volatile("":"+v"(tid_)); const int tid=tid_,lane=tid&63,r32=lane&31,hi=lane>>5; const int wid=__builtin_amdgcn_readfirstlane(tid>>6);
  const bf16*Qw=Qh+(long)(q0+wid*QBLK)*PQ;
  const unsigned lds0=(unsigned)(uintptr_t)shm;
  float*wsf=(float*)(shm+LDS_WS)+wid*64;
  const bf16*ksrc=Kh+(long)(kt0*KVBLK+lane)*PQ+wid*8;
  const bf16*vsrc=Vh+(long)(kt0*KVBLK+16*(wid&3)+(lane>>2))*PQ+(wid>>2)*32+(lane&3)*8;
  const unsigned kdst=lds0+LDS_K+wid*1024, vdst=lds0+LDS_V+wid*1024;
  #define DMA_K(t,slot) glds16(ksrc+(long)(t)*KVBLK*PQ,(unsigned)__builtin_amdgcn_readfirstlane(kdst+(slot)))
  #define DMA_V(t,slot) glds16(vsrc+(long)(t)*KVBLK*PQ,(unsigned)__builtin_amdgcn_readfirstlane(vdst+(slot)))
  const int vb0=(int)(lds0+LDS_V)+((lane>>4)&1)*32+(lane&3)*8+(4*hi+((lane&15)>>2))*64;
  const char*Kbase=shm+LDS_K; bf16x8 kf[8];
  const lds_cptr shm3=(lds_cptr)shm; const lds_cptr kp0=shm3+LDS_K+hi*1024+r32*16; const lds_cptr vp0=shm3+LDS_V+((lane>>4)&1)*32+(lane&3)*8+(4*hi+((lane&15)>>2))*64;
  DMA_K(0,0);DMA_V(0,0);DMA_K(1,SLOTB);
  bf16x8 qr[4];
  #pragma unroll
  for(int d0=0;d0<4;++d0)qr[d0]=*reinterpret_cast<const bf16x8*>(&Qw[(long)r32*PQ+d0*16+hi*8]);
  float mhat=0.f,l_reg=0.f;f32x16 o[2];o[0]=f32x16{};o[1]=f32x16{};f32x16 negm=f32x16{};asm volatile("":"+v"(negm));
  const int qrel=wid*QBLK+r32;
  #define CMASK(P0,P1,t) do{int jb_=(t)-(NT-4); if(MODE==1||jb_>=0)cmask<MODE>(P0,P1,jb_,qrel,hi);}while(0)
  bool resc=false;
  #define START(P0,P1) do{ const float rm=rowmax(P0,P1); resc=false; \
    { const float dl=(MODE==1)?__builtin_fmaxf(rm,-60.f):rm; mhat=fadd_s(mhat,dl); \
      _Pragma("unroll") for(int r=0;r<16;++r){P0[r]=fsub_s(P0[r],dl);P1[r]=fsub_s(P1[r],dl);} \
      _Pragma("unroll") for(int r=0;r<16;++r)negm[r]=-mhat; asm volatile("":"+v"(negm)); } \
    _Pragma("unroll") for(int r=0;r<16;++r)P0[r]=__builtin_amdgcn_exp2f(P0[r]); }while(0)
  #define RESC() do{ if(resc){ asm volatile("s_waitcnt lgkmcnt(0)":::"memory"); \
      _Pragma("unroll") for(int d_=0;d_<2;++d_) _Pragma("unroll") for(int r=0;r<16;++r)o[d_][r]*=wsf[crow(r,hi)]; } }while(0)
  f32x16 pA0,pA1,pB0,pB1;
  int sl_prev=0,sl_cur=0,sl_next=SLOTB;
  #define ROT() do{sl_prev=sl_cur;sl_cur=sl_next;sl_next=(sl_next==(NSLOT-1)*SLOTB)?0:sl_next+SLOTB;}while(0)
  DMA_K(2,2*SLOTB);
  WAIT_BAR(3);
  qkt(pA0,pA1,Kbase,qr,negm,r32,hi);asm volatile("s_nop 15\n\ts_nop 7":"+v"(pA0),"+v"(pA1));CMASK(pA0,pA1,0);
  START(pA0,pA1);
  _Pragma("unroll") for(int r=0;r<16;++r)pA1[r]=__builtin_amdgcn_exp2f(pA1[r]);
  WAIT_BAR(0);
  DMA_K(3,0);DMA_V(1,SLOTB);
  ROT();
  kload8(kf,kp0+sl_cur);
  WAIT_BAR(2);
  s16x4 vlo[8],vhi[8]; u32x4 pw0,pw1,pw2,pw3;
  #define PKW(P,B) cvtpk_s(P[B],P[B+1])
  #define PAF(k) __builtin_bit_cast(bf16x8,pw##k)
  #define VFR(i) (bf16x8){vlo[i][0],vlo[i][1],vlo[i][2],vlo[i][3],vhi[i][0],vhi[i][1],vhi[i][2],vhi[i][3]}
  #define PIN(x) asm volatile("":"+v"(x))
  #define MX3(a,b,c) __builtin_fmaxf(__builtin_fmaxf((a),(b)),(c))
  #define GAPA(MF,A0,A1,A2,A3,W0,W1,PW) do{ MF; sacc+=A0; sacc+=A1; sacc+=A2; sacc+=A3; PIN(sacc); W0; W1; PIN(PW); SBAR(); }while(0)
  #define EX(v) __builtin_amdgcn_exp2f(v)
  #define GAPB(MF,X,B) do{ MF; X[B]=EX(X[B]); X[B+1]=EX(X[B+1]); X[B+2]=EX(X[B+2]); X[B+3]=EX(X[B+3]); PIN(X); SBAR(); }while(0)
  #define VRD(i) do{ vlo[i]=vtr(vp_+(((i)>>2)*4096+((i)&3)*1024)); vhi[i]=vtr(vp_+(((i)>>2)*4096+((i)&3)*1024+512)); }while(0)
  #define KRD(G,j) do{ if(G){ kload2(kf,kp0+sl_next,j); SBAR(); } }while(0)
  #define STEP(C0,C1,P0,P1,t,GK,GV,GL) do{ SBAR(); \
    const lds_cptr vp_=vp0+sl_prev; \
    VRD(0); SBAR(); float sacc=(P0[0]+P0[1]); \
    GAPA(C0=__builtin_amdgcn_mfma_f32_32x32x16_bf16(kf[0],qr[0],negm,0,0,0), P0[2],P0[3],P0[4],P0[5],     pw0[0]=PKW(P0,0), pw0[1]=PKW(P0,2), pw0); \
    VRD(4); SBAR(); GAPA(C1=__builtin_amdgcn_mfma_f32_32x32x16_bf16(kf[1],qr[0],negm,0,0,0), P0[6],P0[7],P0[8],P0[9],     pw0[2]=PKW(P0,4), pw0[3]=PKW(P0,6), pw0); \
    VRD(1); SBAR(); GAPA(C0=__builtin_amdgcn_mfma_f32_32x32x16_bf16(kf[2],qr[1],C0,0,0,0),   P0[10],P0[11],P0[12],P0[13], pw1[0]=PKW(P0,8), pw1[1]=PKW(P0,10), pw1); \
    VRD(5); SBAR(); GAPA(C1=__builtin_amdgcn_mfma_f32_32x32x16_bf16(kf[3],qr[1],C1,0,0,0),   P0[14],P0[15],P1[0],P1[1],   pw1[2]=PKW(P0,12),pw1[3]=PKW(P0,14), pw1); \
    VRD(2); SBAR(); GAPA(C0=__builtin_amdgcn_mfma_f32_32x32x16_bf16(kf[4],qr[2],C0,0,0,0),   P1[2],P1[3],P1[4],P1[5],     pw2[0]=PKW(P1,0), pw2[1]=PKW(P1,2), pw2); \
    VRD(6); SBAR(); GAPA(C1=__builtin_amdgcn_mfma_f32_32x32x16_bf16(kf[5],qr[2],C1,0,0,0),   P1[6],P1[7],P1[8],P1[9],     pw2[2]=PKW(P1,4), pw2[3]=PKW(P1,6), pw2); \
    VRD(3); SBAR(); GAPA(C0=__builtin_amdgcn_mfma_f32_32x32x16_bf16(kf[6],qr[3],C0,0,0,0),   P1[10],P1[11],P1[12],P1[13], pw3[0]=PKW(P1,8), pw3[1]=PKW(P1,10), pw3); \
    VRD(7); SBAR(); GAPA(C1=__builtin_amdgcn_mfma_f32_32x32x16_bf16(kf[7],qr[3],C1,0,0,0),   P1[14],P1[15],0.f,0.f,       pw3[2]=PKW(P1,12),pw3[3]=PKW(P1,14), pw3); \
    l_reg+=sacc; \
    if(GK){DMA_K((t)+3,sl_cur);} if(GV){DMA_V((t)+1,sl_next);} \
    CMASK(C0,C1,t); \
    { float a=MX3(C0[0],C0[1],C1[0]),b=MX3(C0[2],C0[3],C1[1]); a=MX3(a,C1[2],C1[3]); \
      _Pragma("unroll") for(int r=4;r<16;r+=4){a=MX3(a,C0[r],C0[r+1]);b=MX3(b,C0[r+2],C0[r+3]);a=MX3(a,C1[r],C1[r+1]);b=MX3(b,C1[r+2],C1[r+3]);} \
      float rm=__builtin_fmaxf(a,b); { auto rr=__builtin_amdgcn_permlane32_swap(__float_as_uint(rm),__float_as_uint(rm),false,false); rm=__builtin_fmaxf(__uint_as_float(rr[0]),__uint_as_float(rr[1])); } \
      resc=false; \
      if(__builtin_expect(__any(rm>(float)THRL),0)){ const float dl=__builtin_fmaxf(rm,0.f); mhat+=dl; \
        _Pragma("unroll") for(int r=0;r<16;++r){C0[r]-=dl;C1[r]-=dl;} \
        _Pragma("unroll") for(int r=0;r<16;++r)negm[r]=-mhat; asm volatile("":"+v"(negm)); \
        const float f=__builtin_amdgcn_exp2f(-dl); l_reg*=f; if(hi==0)wsf[r32]=f; resc=true; } } \
    SBAR(); \
    GAPB(o[0]=__builtin_amdgcn_mfma_f32_32x32x16_bf16(PAF(0),VFR(0),o[0],0,0,0), C0,0); \
    GAPB(o[1]=__builtin_amdgcn_mfma_f32_32x32x16_bf16(PAF(0),VFR(4),o[1],0,0,0), C0,4); \
    KRD(GL,0); GAPB(o[0]=__builtin_amdgcn_mfma_f32_32x32x16_bf16(PAF(1),VFR(1),o[0],0,0,0), C0,8); \
    KRD(GL,1); GAPB(o[1]=__builtin_amdgcn_mfma_f32_32x32x16_bf16(PAF(1),VFR(5),o[1],0,0,0), C0,12); \
    KRD(GL,2); GAPB(o[0]=__builtin_amdgcn_mfma_f32_32x32x16_bf16(PAF(2),VFR(2),o[0],0,0,0), C1,0); \
    KRD(GL,3); GAPB(o[1]=__builtin_amdgcn_mfma_f32_32x32x16_bf16(PAF(2),VFR(6),o[1],0,0,0), C1,4); \
    GAPB(o[0]=__builtin_amdgcn_mfma_f32_32x32x16_bf16(PAF(3),VFR(3),o[0],0,0,0), C1,8); \
    GAPB(o[1]=__builtin_amdgcn_mfma_f32_32x32x16_bf16(PAF(3),VFR(7),o[1],0,0,0), C1,12); \
    }while(0)
  int t=1;
  #undef CMASK
  #define CMASK(P0,P1,t) do{}while(0)
  for(;t+5<NT;t+=2){
    STEP(pB0,pB1,pA0,pA1,t,true,true,true);     WAIT_BAR(2); RESC(); ROT();
    STEP(pA0,pA1,pB0,pB1,t+1,true,true,true);   WAIT_BAR(2); RESC(); ROT();
  }
  #undef CMASK
  #define CMASK(P0,P1,t) do{int jb_=(t)-(NT-4); if(MODE==1||jb_>=0)cmask<MODE>(P0,P1,jb_,qrel,hi);}while(0)
  #define ENDW(tt) do{ if((tt)+3<NT){WAIT_BAR(2);} else if((tt)+2<NT){WAIT_BAR(1);} else {WAIT_BAR(0);} }while(0)
  for(;t+1<NT;t+=2){
    STEP(pB0,pB1,pA0,pA1,t,(t+3<NT),(t+1<NT),(t+1<NT));       ENDW(t);   RESC(); ROT();
    STEP(pA0,pA1,pB0,pB1,t+1,(t+4<NT),(t+2<NT),(t+2<NT));     ENDW(t+1); RESC(); ROT();
  }
  STEP(pB0,pB1,pA0,pA1,NT-1,false,false,false); RESC();
  { float sacc=pB0[0]+pB0[1]; _Pragma("unroll") for(int r=2;r<16;++r)sacc+=pB0[r]; _Pragma("unroll") for(int r=0;r<16;++r)sacc+=pB1[r]; l_reg+=sacc;
    pw0=(u32x4){PKW(pB0,0),PKW(pB0,2),PKW(pB0,4),PKW(pB0,6)};pw1=(u32x4){PKW(pB0,8),PKW(pB0,10),PKW(pB0,12),PKW(pB0,14)};pw2=(u32x4){PKW(pB1,0),PKW(pB1,2),PKW(pB1,4),PKW(pB1,6)};pw3=(u32x4){PKW(pB1,8),PKW(pB1,10),PKW(pB1,12),PKW(pB1,14)};
    SBAR(); pv(o,vb0+sl_cur,PAF(0),PAF(1),PAF(2),PAF(3)); }
  #undef PKW
  #undef PAF
  #undef VFR
  #undef PIN
  #undef MX3
  #undef GAPA
  #undef GAPB
  #undef EX
  #undef VRD
  #undef KRD
  #undef STEP
  #undef ENDW
  {auto rr=__builtin_amdgcn_permlane32_swap(__float_as_uint(l_reg),__float_as_uint(l_reg),false,false);l_reg=__uint_as_float(rr[0])+__uint_as_float(rr[1]);}
  if(MODE==1)l_reg+=__builtin_amdgcn_exp2f(sink2-mhat);
  if(hi==0)wsf[32+r32]=l_reg;asm volatile("s_waitcnt lgkmcnt(0)":::"memory");
  float rli[16];
  #pragma unroll
  for(int r=0;r<16;++r)rli[r]=__builtin_amdgcn_rcpf(wsf[32+crow(r,hi)]);
  bf16*Ow=Oh+(long)(q0+wid*QBLK)*PO;
  { bf16*stg=(bf16*)(shm+LDS_OST)+wid*2048;
    #pragma unroll
    for(int r=0;r<16;++r){const int orow=crow(r,hi);
      #pragma unroll
      for(int d0=0;d0<2;++d0)stg[orow*64+d0*32+r32]=__float2bfloat16(o[d0][r]*rli[r]);}
    asm volatile("s_waitcnt lgkmcnt(0)":::"memory");
    #pragma unroll
    for(int i=0;i<4;++i){const int row=i*8+(lane>>3),ch=lane&7; const u32x4 v=*(const u32x4*)(stg+row*64+ch*8); ATTN_STORE16(Ow+(long)row*PO+ch*8,v);} }
  asm volatile("s_waitcnt lgkmcnt(0)\n\ts_barrier":::"memory");
  #undef DMA_K
  #undef DMA_V
  #undef CMASK
  #undef START
  #undef RESC
  #undef ROT
}
constexpr int ATTN_LDS_BYTES=LDS_BYTES;

constexpr int SW_K=0, SW_V=6*8192, SW_WS=12*8192, SW_ST=SW_WS+2048, SWA_LDS_BYTES=SW_ST+NW*2048;
template<int ABL=0> __device__ __forceinline__ void swa_unit(const bf16*Qb,const bf16*__restrict__ Kh,const bf16*__restrict__ Vh,bf16*Ob,const unsigned*kmx,int q0,const float*sink2v,char*shm){
  int tid_=threadIdx.x; asm volatile("":"+v"(tid_)); const int tid=tid_,lane=tid&63,r32=lane&31,hi=lane>>5; const int wid=__builtin_amdgcn_readfirstlane(tid>>6);
  const unsigned lds0=(unsigned)(uintptr_t)shm;
  const int nt=(q0==0)?4:6, kt0=q0/KVBLK-(nt-4);
  const bf16*ksrc=Kh+(long)(kt0*KVBLK+lane)*PQ+wid*8;
  const bf16*vsrc=Vh+(long)(kt0*KVBLK+16*(wid&3)+(lane>>2))*PQ+(wid>>2)*32+(lane&3)*8;
  for(int ti=0;ti<nt;++ti){
    glds16(ksrc+(long)ti*KVBLK*PQ,(unsigned)__builtin_amdgcn_readfirstlane(lds0+SW_K+ti*8192+wid*1024));
    glds16(vsrc+(long)ti*KVBLK*PQ,(unsigned)__builtin_amdgcn_readfirstlane(lds0+SW_V+ti*8192+wid*1024)); }
  const bf16*Qw=Qb+(long)(q0+wid*QBLK+r32)*PQ+hi*8;
  bf16x8 qa[4],qb[4];
  #pragma unroll
  for(int d0=0;d0<4;++d0){qa[d0]=*reinterpret_cast<const bf16x8*>(Qw+d0*16);qb[d0]=*reinterpret_cast<const bf16x8*>(Qw+D+d0*16);}
  float kb2=0.f;
  #pragma unroll
  for(int g_=0;g_<8;++g_)kb2+=__uint_as_float(kmx[g_]);
  asm volatile("s_waitcnt vmcnt(0) lgkmcnt(0)\n\ts_barrier":::"memory");
  float*wsf=(float*)(shm+SW_WS)+wid*64;
  const u32x4 a1w=(u32x4){hi==0?0x3F803F80u:0u,0u,0u,0u};
  const int kb0=8*(q0>>8)+wid-4;
  const lds_cptr shm3=(lds_cptr)shm;
  const lds_cptr kpl=shm3+SW_K+hi*1024+r32*16;
  const lds_cptr vpl=shm3+SW_V+((lane>>4)&1)*32+(lane&3)*8+(4*hi+((lane&15)>>2))*64;
  #pragma unroll
  for(int g=0;g<4;g+=2){
    float mA,mB; f32x16 cbA,cbB;
    { float qsA=0.f,qsB=0.f;
      #pragma unroll
      for(int d0=0;d0<4;++d0){ const u32x4 va=__builtin_bit_cast(u32x4,qa[d0]),vb_=__builtin_bit_cast(u32x4,qb[d0]);
        #pragma unroll
        for(int e_=0;e_<4;++e_){ const float a_=__uint_as_float(va[e_]<<16),c_=__uint_as_float(va[e_]&0xffff0000u),d_=__uint_as_float(vb_[e_]<<16),f_=__uint_as_float(vb_[e_]&0xffff0000u); qsA+=a_*a_+c_*c_; qsB+=d_*d_+f_*f_; } }
      { auto rr=__builtin_amdgcn_permlane32_swap(__float_as_uint(qsA),__float_as_uint(qsA),false,false); qsA=__uint_as_float(rr[0])+__uint_as_float(rr[1]); }
      { auto rr=__builtin_amdgcn_permlane32_swap(__float_as_uint(qsB),__float_as_uint(qsB),false,false); qsB=__uint_as_float(rr[0])+__uint_as_float(rr[1]); }
      mA=sqrtf(qsA*kb2)*1.01f+1e-3f-64.f; mB=sqrtf(qsB*kb2)*1.01f+1e-3f-64.f;
      u32x4 bw=(u32x4){0u,0u,0u,0u};
      { const float nm_=-mA; const unsigned h_=cvtpk_s(nm_,0.f)&0xffffu; const float r_=nm_-__uint_as_float(h_<<16); const unsigned l_=cvtpk_s(r_,0.f)&0xffffu; bw[0]=(hi==0)?(h_|(l_<<16)):0u; }
      cbA=__builtin_amdgcn_mfma_f32_32x32x16_bf16(__builtin_bit_cast(bf16x8,a1w),__builtin_bit_cast(bf16x8,bw),f32x16{},0,0,0);
      { const float nm_=-mB; const unsigned h_=cvtpk_s(nm_,0.f)&0xffffu; const float r_=nm_-__uint_as_float(h_<<16); const unsigned l_=cvtpk_s(r_,0.f)&0xffffu; bw[0]=(hi==0)?(h_|(l_<<16)):0u; }
      cbB=__builtin_amdgcn_mfma_f32_32x32x16_bf16(__builtin_bit_cast(bf16x8,a1w),__builtin_bit_cast(bf16x8,bw),f32x16{},0,0,0); }
    float lA=0.f,lB=0.f; f32x16 oA[2],oB[2]; oA[0]=f32x16{};oA[1]=f32x16{};oB[0]=f32x16{};oB[1]=f32x16{};
    for(int j=0;j<5;++j){ const int kb=kb0+j; if(kb<0)continue; if(ABL==1)continue;
      const int ti=(kb>>1)-kt0, half=kb&1;
      f32x16 sA=cbA,sB=cbB;
      { const lds_cptr kp=kpl+ti*8192+half*512;
        #pragma unroll
        for(int d0=0;d0<4;++d0){ const bf16x8 kf=*(const __attribute__((address_space(3))) bf16x8*)(kp+d0*2048);
          sA=__builtin_amdgcn_mfma_f32_32x32x16_bf16(kf,qa[d0],sA,0,0,0); sB=__builtin_amdgcn_mfma_f32_32x32x16_bf16(kf,qb[d0],sB,0,0,0); } }
      if(j==0){
        #pragma unroll
        for(int r=0;r<16;++r){ const int i_=(r&3)+8*(r>>2)+4*hi; if(i_<=r32){sA[r]=-INFINITY;sB[r]=-INFINITY;} } }
      if(j==4){
        #pragma unroll
        for(int r=0;r<16;++r){ const int i_=(r&3)+8*(r>>2)+4*hi; if(i_>r32){sA[r]=-INFINITY;sB[r]=-INFINITY;} } }
      #pragma unroll
      for(int r=0;r<16;++r){ sA[r]=__builtin_amdgcn_exp2f(sA[r]); sB[r]=__builtin_amdgcn_exp2f(sB[r]); lA+=sA[r]; lB+=sB[r]; }
      u32x4 pa[2],pb[2];
      #pragma unroll
      for(int k=0;k<2;++k){
        pa[k]=(u32x4){cvtpk_s(sA[8*k],sA[8*k+1]),cvtpk_s(sA[8*k+2],sA[8*k+3]),cvtpk_s(sA[8*k+4],sA[8*k+5]),cvtpk_s(sA[8*k+6],sA[8*k+7])};
        pb[k]=(u32x4){cvtpk_s(sB[8*k],sB[8*k+1]),cvtpk_s(sB[8*k+2],sB[8*k+3]),cvtpk_s(sB[8*k+4],sB[8*k+5]),cvtpk_s(sB[8*k+6],sB[8*k+7])}; }
      { const lds_cptr vp=vpl+ti*8192+half*2048;
        #pragma unroll
        for(int d0=0;d0<2;++d0)
          #pragma unroll
          for(int k=0;k<2;++k){ const s16x4 lo=vtr(vp+d0*4096+k*1024), hh=vtr(vp+d0*4096+k*1024+512);
            const bf16x8 vf=(bf16x8){lo[0],lo[1],lo[2],lo[3],hh[0],hh[1],hh[2],hh[3]};
            oA[d0]=__builtin_amdgcn_mfma_f32_32x32x16_bf16(__builtin_bit_cast(bf16x8,pa[k]),vf,oA[d0],0,0,0);
            oB[d0]=__builtin_amdgcn_mfma_f32_32x32x16_bf16(__builtin_bit_cast(bf16x8,pb[k]),vf,oB[d0],0,0,0); } }
    }
    if(g==0){
      #pragma unroll
      for(int d0=0;d0<4;++d0){qa[d0]=*reinterpret_cast<const bf16x8*>(Qw+2*D+d0*16);qb[d0]=*reinterpret_cast<const bf16x8*>(Qw+3*D+d0*16);} }
    #pragma unroll
    for(int hsel=0;hsel<2;++hsel){
      float l=hsel?lB:lA; const float m=hsel?mB:mA; const f32x16*o=hsel?oB:oA;
      {auto rr=__builtin_amdgcn_permlane32_swap(__float_as_uint(l),__float_as_uint(l),false,false);l=__uint_as_float(rr[0])+__uint_as_float(rr[1]);}
      l+=__builtin_amdgcn_exp2f(sink2v[g+hsel]-m);
      if(hi==0)wsf[32+r32]=l; asm volatile("s_waitcnt lgkmcnt(0)":::"memory");
      float rli[16];
      #pragma unroll
      for(int r=0;r<16;++r)rli[r]=__builtin_amdgcn_rcpf(wsf[32+crow(r,hi)]);
      bf16*Ow=Ob+(long)(q0+wid*QBLK)*PO+(g+hsel)*D;
      bf16*stg=(bf16*)(shm+SW_ST)+wid*1024;
      #pragma unroll
      for(int d0=0;d0<2;++d0){
        #pragma unroll
        for(int r=0;r<16;++r)stg[crow(r,hi)*32+r32]=__float2bfloat16(o[d0][r]*rli[r]);
        asm volatile("s_waitcnt lgkmcnt(0)":::"memory");
        #pragma unroll
        for(int i=0;i<2;++i){const int row=i*16+(lane>>2),ch=lane&3; const u32x4 v=*(const u32x4*)(stg+row*32+ch*8); ATTN_STORE16(Ow+(long)row*PO+d0*32+ch*8,v);}
        asm volatile("s_waitcnt lgkmcnt(0)":::"memory");
      }
    }
  }
  asm volatile("s_waitcnt lgkmcnt(0)\n\ts_barrier":::"memory");
}

constexpr int W_SLK=8192, W_SLV=16384, W_LDS_K=0, W_LDS_V=NSLOT*W_SLK, W_LDS_WS=W_LDS_V+NSLOT*W_SLV, W_LDS_OST=W_LDS_WS+NW*64*4, W_LDS_BYTES=W_LDS_OST+NW*4096;
template<int THRL> __device__ __forceinline__ void attn_unit_w(const bf16*Qh,const bf16*__restrict__ Kh,const bf16*__restrict__ Vh,bf16*Oh,const unsigned*kmx,int q0,const int NT,char*shm){
  int tid_=threadIdx.x; asm volatile("":"+v"(tid_)); const int tid=tid_,lane=tid&63,r32=lane&31,hi=lane>>5; const int wid=__builtin_amdgcn_readfirstlane(tid>>6);
  const bf16*Qw=Qh+(long)(q0+wid*QBLK)*PQ;
  const unsigned lds0=(unsigned)(uintptr_t)shm;
  float*wsf=(float*)(shm+W_LDS_WS)+wid*64;
  const bf16*ksrc=Kh+(long)lane*PQ+wid*8;
  const bf16*vsrc=Vh+(long)(16*(wid&3)+(lane>>2))*PQ+(wid>>2)*32+(lane&3)*8;
  const unsigned kdst=lds0+W_LDS_K+wid*1024, vdst=lds0+W_LDS_V+wid*1024;
  #define DMA_K(t,slot) glds16(ksrc+(long)(t)*KVBLK*PQ,(unsigned)__builtin_amdgcn_readfirstlane(kdst+(slot)))
  #define DMA_V(t,slot) do{ glds16(vsrc+(long)(t)*KVBLK*PQ,(unsigned)__builtin_amdgcn_readfirstlane(vdst+2*(slot))); glds16(vsrc+64+(long)(t)*KVBLK*PQ,(unsigned)__builtin_amdgcn_readfirstlane(vdst+2*(slot)+8192)); }while(0)
  const char*Kbase=shm+W_LDS_K; bf16x8 kf[8];
  const lds_cptr shm3=(lds_cptr)shm; const lds_cptr kp0=shm3+W_LDS_K+hi*1024+r32*16; const lds_cptr vp0=shm3+W_LDS_V+((lane>>4)&1)*32+(lane&3)*8+(4*hi+((lane&15)>>2))*64;
  const int vb0=(int)(lds0+W_LDS_V)+((lane>>4)&1)*32+(lane&3)*8+(4*hi+((lane&15)>>2))*64;
  DMA_K(0,0);DMA_V(0,0);DMA_K(1,W_SLK);
  bf16x8 qr[4];
  #pragma unroll
  for(int d0=0;d0<4;++d0)qr[d0]=*reinterpret_cast<const bf16x8*>(&Qw[(long)r32*PQ+d0*16+hi*8]);
  float mhat=0.f,l_reg=0.f;f32x16 o[4];o[0]=f32x16{};o[1]=f32x16{};o[2]=f32x16{};o[3]=f32x16{};const f32x16 zacc=f32x16{};
  const u32x4 a1w=(u32x4){hi==0?0x3F803F80u:0u,0u,0u,0u}; u32x4 bmw=(u32x4){0u,0u,0u,0u}; f32x16 cb;
  #define SETBM() do{ const float nm_=-mhat; const unsigned h_=cvtpk_s(nm_,0.f)&0xffffu; const float r_=nm_-__uint_as_float(h_<<16); const unsigned l_=cvtpk_s(r_,0.f)&0xffffu; bmw[0]=(hi==0)?(h_|(l_<<16)):0u; }while(0)
  #define BIASMF() __builtin_amdgcn_mfma_f32_32x32x16_bf16(__builtin_bit_cast(bf16x8,a1w),__builtin_bit_cast(bf16x8,bmw),zacc,0,0,0)
  const int qrel=wid*QBLK+r32;
  { float kb2=0.f; _Pragma("unroll") for(int g=0;g<8;++g)kb2+=__uint_as_float(kmx[g]);
    float qs=0.f; _Pragma("unroll") for(int d0=0;d0<4;++d0){ const u32x4 qv=__builtin_bit_cast(u32x4,qr[d0]); _Pragma("unroll") for(int e_=0;e_<4;++e_){ const float a_=__uint_as_float(qv[e_]<<16),b_=__uint_as_float(qv[e_]&0xffff0000u); qs+=a_*a_+b_*b_; } }
    { auto rr=__builtin_amdgcn_permlane32_swap(__float_as_uint(qs),__float_as_uint(qs),false,false); qs=__uint_as_float(rr[0])+__uint_as_float(rr[1]); }
    mhat=sqrtf(qs*kb2)*1.01f+1e-3f-64.f; }
  SETBM(); cb=BIASMF();
  #define CMASK(P0,P1,t) do{int jb_=(t)-(NT-4); if(jb_>=0)cmask<0>(P0,P1,jb_,qrel,hi);}while(0)
  #define START(P0,P1) do{ _Pragma("unroll") for(int r=0;r<16;++r)P0[r]=__builtin_amdgcn_exp2f(P0[r]); }while(0)
  f32x16 pA0,pA1,pB0,pB1;
  int sl_prev=0,sl_cur=0,sl_next=W_SLK;
  #define ROT() do{sl_prev=sl_cur;sl_cur=sl_next;sl_next=(sl_next==(NSLOT-1)*W_SLK)?0:sl_next+W_SLK;}while(0)
  DMA_K(2,2*W_SLK);
  WAIT_BAR(4);
  qkt(pA0,pA1,Kbase,qr,cb,r32,hi);asm volatile("s_nop 15\n\ts_nop 7":"+v"(pA0),"+v"(pA1));CMASK(pA0,pA1,0);
  START(pA0,pA1);
  _Pragma("unroll") for(int r=0;r<16;++r)pA1[r]=__builtin_amdgcn_exp2f(pA1[r]);
  WAIT_BAR(0);
  DMA_K(3,0);DMA_V(1,W_SLK);
  ROT();
  kload8(kf,kp0+sl_cur);
  WAIT_BAR(3);
  s16x4 vlo[4],vhi[4]; u32x4 pw0,pw1,pw2,pw3;
  #define PKW(P,B) cvtpk_s(P[B],P[B+1])
  #define PAF(k) __builtin_bit_cast(bf16x8,pw##k)
  #define VFR(i) (bf16x8){vlo[i][0],vlo[i][1],vlo[i][2],vlo[i][3],vhi[i][0],vhi[i][1],vhi[i][2],vhi[i][3]}
  #define PIN(x) asm volatile("":"+v"(x))
  #define MX3(a,b,c) __builtin_fmaxf(__builtin_fmaxf((a),(b)),(c))
  #define GAPA(MF,A0,A1,A2,A3,W0,W1,PW) do{ MF; sacc+=A0; sacc+=A1; sacc+=A2; sacc+=A3; PIN(sacc); W0; W1; PIN(PW); SBAR(); }while(0)
  #define EX(v) __builtin_amdgcn_exp2f(v)
  #define GAPB(MF,X,B) do{ MF; X[B]=EX(X[B]); X[B+1]=EX(X[B+1]); PIN(X); SBAR(); }while(0)
  #define VRD(j) do{ vlo[(j)&3]=vtr(vp_+(((j)&3)*4096+((j)>>2)*1024)); vhi[(j)&3]=vtr(vp_+(((j)&3)*4096+((j)>>2)*1024+512)); SBAR(); }while(0)
  #define KRD(G,j) do{ if(G){ kload2(kf,kp0+sl_next,j); SBAR(); } }while(0)
  #define STEP(C0,C1,P0,P1,t,GK,GV,GL) do{ SBAR(); \
    const lds_cptr vp_=vp0+2*sl_prev; \
    float sacc=(P0[0]+P0[1]); \
    GAPA(C0=__builtin_amdgcn_mfma_f32_32x32x16_bf16(kf[0],qr[0],cb,0,0,0), P0[2],P0[3],P0[4],P0[5],     pw0[0]=PKW(P0,0), pw0[1]=PKW(P0,2), pw0); \
    GAPA(C1=__builtin_amdgcn_mfma_f32_32x32x16_bf16(kf[1],qr[0],cb,0,0,0), P0[6],P0[7],P0[8],P0[9],     pw0[2]=PKW(P0,4), pw0[3]=PKW(P0,6), pw0); \
    GAPA(C0=__builtin_amdgcn_mfma_f32_32x32x16_bf16(kf[2],qr[1],C0,0,0,0),   P0[10],P0[11],P0[12],P0[13], pw1[0]=PKW(P0,8), pw1[1]=PKW(P0,10), pw1); \
    GAPA(C1=__builtin_amdgcn_mfma_f32_32x32x16_bf16(kf[3],qr[1],C1,0,0,0),   P0[14],P0[15],P1[0],P1[1],   pw1[2]=PKW(P0,12),pw1[3]=PKW(P0,14), pw1); \
    GAPA(C0=__builtin_amdgcn_mfma_f32_32x32x16_bf16(kf[4],qr[2],C0,0,0,0),   P1[2],P1[3],P1[4],P1[5],     pw2[0]=PKW(P1,0), pw2[1]=PKW(P1,2), pw2); \
    VRD(0); GAPA(C1=__builtin_amdgcn_mfma_f32_32x32x16_bf16(kf[5],qr[2],C1,0,0,0),   P1[6],P1[7],P1[8],P1[9],     pw2[2]=PKW(P1,4), pw2[3]=PKW(P1,6), pw2); \
    VRD(1); GAPA(C0=__builtin_amdgcn_mfma_f32_32x32x16_bf16(kf[6],qr[3],C0,0,0,0),   P1[10],P1[11],P1[12],P1[13], pw3[0]=PKW(P1,8), pw3[1]=PKW(P1,10), pw3); \
    VRD(2); GAPA(C1=__builtin_amdgcn_mfma_f32_32x32x16_bf16(kf[7],qr[3],C1,0,0,0),   P1[14],P1[15],0.f,0.f,       pw3[2]=PKW(P1,12),pw3[3]=PKW(P1,14), pw3); \
    l_reg+=sacc; \
    if(GK){DMA_K((t)+3,sl_cur);} if(GV){DMA_V((t)+1,sl_next);} \
    CMASK(C0,C1,t); \
    SBAR(); \
    VRD(3); do{ o[0]=__builtin_amdgcn_mfma_f32_32x32x16_bf16(PAF(0),VFR(0),o[0],0,0,0); C0[0]=EX(C0[0]); C0[1]=EX(C0[1]); PIN(C0); SBAR(); }while(0); \
    VRD(4); do{ o[1]=__builtin_amdgcn_mfma_f32_32x32x16_bf16(PAF(0),VFR(1),o[1],0,0,0); C0[2]=EX(C0[2]); C0[3]=EX(C0[3]); PIN(C0); SBAR(); }while(0); \
    VRD(5); do{ o[2]=__builtin_amdgcn_mfma_f32_32x32x16_bf16(PAF(0),VFR(2),o[2],0,0,0); C0[4]=EX(C0[4]); C0[5]=EX(C0[5]); PIN(C0); SBAR(); }while(0); \
    VRD(6); do{ o[3]=__builtin_amdgcn_mfma_f32_32x32x16_bf16(PAF(0),VFR(3),o[3],0,0,0); C0[6]=EX(C0[6]); C0[7]=EX(C0[7]); PIN(C0); SBAR(); }while(0); \
    VRD(7); do{ o[0]=__builtin_amdgcn_mfma_f32_32x32x16_bf16(PAF(1),VFR(0),o[0],0,0,0); C0[8]=EX(C0[8]); C0[9]=EX(C0[9]); PIN(C0); SBAR(); }while(0); \
    VRD(8); do{ o[1]=__builtin_amdgcn_mfma_f32_32x32x16_bf16(PAF(1),VFR(1),o[1],0,0,0); C0[10]=EX(C0[10]); C0[11]=EX(C0[11]); PIN(C0); SBAR(); }while(0); \
    VRD(9); do{ o[2]=__builtin_amdgcn_mfma_f32_32x32x16_bf16(PAF(1),VFR(2),o[2],0,0,0); C0[12]=EX(C0[12]); C0[13]=EX(C0[13]); PIN(C0); SBAR(); }while(0); \
    VRD(10); do{ o[3]=__builtin_amdgcn_mfma_f32_32x32x16_bf16(PAF(1),VFR(3),o[3],0,0,0); C0[14]=EX(C0[14]); C0[15]=EX(C0[15]); PIN(C0); SBAR(); }while(0); \
    VRD(11); KRD(GL,0); do{ o[0]=__builtin_amdgcn_mfma_f32_32x32x16_bf16(PAF(2),VFR(0),o[0],0,0,0); C1[0]=EX(C1[0]); C1[1]=EX(C1[1]); PIN(C1); SBAR(); }while(0); \
    VRD(12); do{ o[1]=__builtin_amdgcn_mfma_f32_32x32x16_bf16(PAF(2),VFR(1),o[1],0,0,0); C1[2]=EX(C1[2]); C1[3]=EX(C1[3]); PIN(C1); SBAR(); }while(0); \
    VRD(13); KRD(GL,1); do{ o[2]=__builtin_amdgcn_mfma_f32_32x32x16_bf16(PAF(2),VFR(2),o[2],0,0,0); C1[4]=EX(C1[4]); C1[5]=EX(C1[5]); PIN(C1); SBAR(); }while(0); \
    VRD(14); do{ o[3]=__builtin_amdgcn_mfma_f32_32x32x16_bf16(PAF(2),VFR(3),o[3],0,0,0); C1[6]=EX(C1[6]); C1[7]=EX(C1[7]); PIN(C1); SBAR(); }while(0); \
    VRD(15); KRD(GL,2); do{ o[0]=__builtin_amdgcn_mfma_f32_32x32x16_bf16(PAF(3),VFR(0),o[0],0,0,0); C1[8]=EX(C1[8]); C1[9]=EX(C1[9]); PIN(C1); SBAR(); }while(0); \
    do{ o[1]=__builtin_amdgcn_mfma_f32_32x32x16_bf16(PAF(3),VFR(1),o[1],0,0,0); C1[10]=EX(C1[10]); C1[11]=EX(C1[11]); PIN(C1); SBAR(); }while(0); \
    KRD(GL,3); do{ o[2]=__builtin_amdgcn_mfma_f32_32x32x16_bf16(PAF(3),VFR(2),o[2],0,0,0); C1[12]=EX(C1[12]); C1[13]=EX(C1[13]); PIN(C1); SBAR(); }while(0); \
    do{ o[3]=__builtin_amdgcn_mfma_f32_32x32x16_bf16(PAF(3),VFR(3),o[3],0,0,0); C1[14]=EX(C1[14]); C1[15]=EX(C1[15]); PIN(C1); SBAR(); }while(0); \
    }while(0)
  int t=1;
  #undef CMASK
  #define CMASK(P0,P1,t) do{}while(0)
  for(;t+5<NT;t+=2){
    STEP(pB0,pB1,pA0,pA1,t,true,true,true);     WAIT_BAR(3); ROT();
    STEP(pA0,pA1,pB0,pB1,t+1,true,true,true);   WAIT_BAR(3); ROT();
  }
  #undef CMASK
  #define CMASK(P0,P1,t) do{int jb_=(t)-(NT-4); if(jb_>=0)cmask<0>(P0,P1,jb_,qrel,hi);}while(0)
  #define ENDW(tt) do{ if((tt)+3<NT){WAIT_BAR(3);} else if((tt)+2<NT){WAIT_BAR(2);} else {WAIT_BAR(0);} }while(0)
  for(;t+1<NT;t+=2){
    STEP(pB0,pB1,pA0,pA1,t,(t+3<NT),(t+1<NT),(t+1<NT));       ENDW(t);   ROT();
    STEP(pA0,pA1,pB0,pB1,t+1,(t+4<NT),(t+2<NT),(t+2<NT));     ENDW(t+1); ROT();
  }
  STEP(pB0,pB1,pA0,pA1,NT-1,false,false,false);
  { float sacc=pB0[0]+pB0[1]; _Pragma("unroll") for(int r=2;r<16;++r)sacc+=pB0[r]; _Pragma("unroll") for(int r=0;r<16;++r)sacc+=pB1[r]; l_reg+=sacc;
    pw0=(u32x4){PKW(pB0,0),PKW(pB0,2),PKW(pB0,4),PKW(pB0,6)};pw1=(u32x4){PKW(pB0,8),PKW(pB0,10),PKW(pB0,12),PKW(pB0,14)};pw2=(u32x4){PKW(pB1,0),PKW(pB1,2),PKW(pB1,4),PKW(pB1,6)};pw3=(u32x4){PKW(pB1,8),PKW(pB1,10),PKW(pB1,12),PKW(pB1,14)};
    SBAR(); pv(o,vb0+2*sl_cur,PAF(0),PAF(1),PAF(2),PAF(3)); pv(o+2,vb0+2*sl_cur+8192,PAF(0),PAF(1),PAF(2),PAF(3)); }
  #undef PKW
  #undef PAF
  #undef VFR
  #undef PIN
  #undef MX3
  #undef GAPA
  #undef GAPB
  #undef EX
  #undef VRD
  #undef KRD
  #undef STEP
  #undef ENDW
  {auto rr=__builtin_amdgcn_permlane32_swap(__float_as_uint(l_reg),__float_as_uint(l_reg),false,false);l_reg=__uint_as_float(rr[0])+__uint_as_float(rr[1]);}
  if(hi==0)wsf[32+r32]=l_reg;asm volatile("s_waitcnt lgkmcnt(0)":::"memory");
  float rli[16];
  #pragma unroll
  for(int r=0;r<16;++r)rli[r]=__builtin_amdgcn_rcpf(wsf[32+crow(r,hi)]);
  bf16*Ow=Oh+(long)(q0+wid*QBLK)*PO;
  { bf16*stg=(bf16*)(shm+W_LDS_OST)+wid*2048;
    #pragma unroll
    for(int hf=0;hf<2;++hf){
      #pragma unroll
      for(int r=0;r<16;++r){const int orow=crow(r,hi);
        #pragma unroll
        for(int d0=0;d0<2;++d0)stg[orow*64+d0*32+r32]=__float2bfloat16(o[2*hf+d0][r]*rli[r]);}
      asm volatile("s_waitcnt lgkmcnt(0)":::"memory");
      #pragma unroll
      for(int i=0;i<4;++i){const int row=i*8+(lane>>3),ch=lane&7; const u32x4 v=*(const u32x4*)(stg+row*64+ch*8); ATTN_STORE16(Ow+(long)row*PO+hf*64+ch*8,v);}
      asm volatile("s_waitcnt lgkmcnt(0)":::"memory");
    } }
  asm volatile("s_waitcnt lgkmcnt(0)\n\ts_barrier":::"memory");
  #undef DMA_K
  #undef DMA_V
  #undef CMASK
  #undef START
  #undef ROT
  #undef SETBM
  #undef BIASMF
}
#undef SBAR
#undef WAIT_BAR
}
constexpr int NWAVES = 8;
constexpr int BATCH = 2, SEQ = 16384, D = 1024, T = BATCH * SEQ;
constexpr int IN_COLS = 2304, NEXP = 32, FF = 512, NASSIGN = 2 * T, NCHUNK = 256, CHUNK_TOK = T / NCHUNK;
constexpr int PSLOTS = (NASSIGN / 256 + NEXP) * 256;
constexpr int NBLK_MAX = PSLOTS / 256;
constexpr float RMS_EPS = 1e-6f;
static_assert(CHUNK_TOK == 128 && SEQ == pg8::SEQ_LEN && IN_COLS == pg8::QKV_LD, "shapes");
constexpr size_t MiB = 1u << 20;
constexpr size_t WS_CTL = 0, CTL_ZERO_BYTES = 1 * MiB;
constexpr size_t WS_WR = 1 * MiB;
constexpr size_t WS_TOK = WS_WR + 256 * 1024;
constexpr size_t WS_ROPE = 4 * MiB;
constexpr size_t WS_WIN = 8 * MiB;
constexpr size_t WS_WO = 13 * MiB;
constexpr size_t WS_WGU = 16 * MiB;
constexpr size_t WS_WD = 80 * MiB;
constexpr size_t WS_A = 112 * MiB;
constexpr size_t WS_MIX = 176 * MiB;
constexpr size_t WS_QKV = 240 * MiB;
constexpr size_t WS_HM = 384 * MiB;
constexpr size_t WS_END = 456 * MiB;
static_assert(WS_TOK + (size_t)(T * 2 * 4) * 2 + T * 4 + NCHUNK * 32 * 4 + 288 * 4 + (size_t)PSLOTS * 16 <= WS_ROPE, "routing tables");
static_assert(WS_WIN + (size_t)IN_COLS * D * 2 <= WS_WO && WS_WO + (size_t)D * D * 2 <= WS_WGU && WS_WGU + (size_t)NEXP * 1024 * D * 2 <= WS_WD && WS_WD + (size_t)NEXP * D * FF * 2 <= WS_A, "weights");
static_assert(WS_A + (size_t)T * D * 2 <= WS_MIX && WS_MIX + (size_t)T * D * 2 <= WS_QKV && WS_QKV + (size_t)T * IN_COLS * 2 <= WS_HM && WS_QKV + (size_t)PSLOTS * D * 2 <= WS_HM && WS_HM + (size_t)PSLOTS * FF * 2 <= WS_END, "activations");
static_assert(WS_MIX + (size_t)NASSIGN * D * 2 <= WS_HM, "Y (P5b-P6) overlays MIX and the head of XS, both dead after P5a; HB stays live in WS_A until P6");
constexpr int CW_KMAX = 128;
constexpr int CW_SWAQ = 80;
constexpr int CW_RANK = 100;
constexpr int CW_BQ = 400;
constexpr int CW_DONE = 512;
constexpr int CW_NBU = 64;
constexpr int CW_BAR = 4096;
constexpr int RING_OFF = 0, RING_BYTES = 131072;
constexpr int LDSCTL_OFF = RING_BYTES, MISC_OFF = LDSCTL_OFF + 320;
constexpr int LDS_BYTES = 147456;
constexpr int ROWTAB_OFF = MISC_OFF + 128, ROWTAB_UNITS = 6;
static_assert(ROWTAB_OFF + ROWTAB_UNITS * 1024 <= LDS_BYTES, "LDS map");
#define GAS __attribute__((address_space(1)))
#define LAS __attribute__((address_space(3)))
typedef unsigned short bf16;
typedef unsigned v4u __attribute__((ext_vector_type(4)));
typedef float f32x4 __attribute__((ext_vector_type(4)));
typedef short bf16x8 __attribute__((ext_vector_type(8)));
typedef GAS unsigned gu32;
typedef GAS unsigned long long gu64;
#define RLX_AGENT __ATOMIC_RELAXED, __HIP_MEMORY_SCOPE_AGENT
#define LDS_WAIT() asm volatile("s_waitcnt lgkmcnt(0)" ::: "memory")
#define VM_WAIT() asm volatile("s_waitcnt vmcnt(0)" ::: "memory")
__device__ __forceinline__ unsigned long long rt() { return __builtin_amdgcn_s_memrealtime(); }
__device__ __forceinline__ unsigned f2bf(float f) { unsigned u = __builtin_bit_cast(unsigned, f); return (u + 0x7fffu + ((u >> 16) & 1u)) >> 16; }
__device__ __forceinline__ unsigned pk2(float lo, float hi) { return f2bf(lo) | (f2bf(hi) << 16); }

#define XB_TMO      128
#define XB_XCNT(j)  (256  + 64 * (j))
#define XB_XSUB(j)  (1280 + 64 * (j))
#define XB_XGEN(j)  (2304 + 64 * (j))
#define XB_TOP      3328
#define XB_TOPGEN   3392
#define XCD_BAR_WORDS 3456
#define XB_SPIN_CAP (1u << 18)

__device__ __forceinline__ unsigned xb_ld(unsigned* p)              { return __hip_atomic_load(p, __ATOMIC_RELAXED, __HIP_MEMORY_SCOPE_AGENT); }
__device__ __forceinline__ unsigned xb_add(unsigned* p, unsigned v) { return __hip_atomic_fetch_add(p, v, __ATOMIC_RELAXED, __HIP_MEMORY_SCOPE_AGENT); }
__device__ __forceinline__ unsigned xb_xcc_id() { return (unsigned)__builtin_amdgcn_s_getreg((3 << 11) | 20) & 0xFu; }
#define XB_SPIN(cond, bar) do { unsigned _sp = 0; while (cond) { __builtin_amdgcn_s_sleep(1); \
    if ((++_sp & 255u) == 0u) { if (xb_ld(&(bar)[XB_TMO])) break; if (_sp > XB_SPIN_CAP) { atomicAdd(&(bar)[XB_TMO], 1u); break; } } } } while (0)

struct XcdBarrier {
    unsigned* bar; unsigned x;
    volatile LAS unsigned* st;
};

__device__ __forceinline__ XcdBarrier xcd_barrier_post(unsigned* bar, volatile LAS unsigned* st) {
    XcdBarrier b; b.bar = bar; b.x = xb_xcc_id(); b.st = st;
    if (threadIdx.x == 0) (void)xb_add(&bar[XB_XCNT(b.x)], 1u);
    return b;
}
__device__ __forceinline__ void xcd_barrier_complete(unsigned* bar, unsigned x, unsigned& nloc, unsigned& nx) {
    const unsigned G = gridDim.x * gridDim.y * gridDim.z;
    unsigned sum, cnt, mine, sp = 0u;
    for (;;) {
        sum = 0u; cnt = 0u; mine = 0u;
#pragma unroll
        for (unsigned j = 0; j < 16; ++j) { const unsigned c = xb_ld(&bar[XB_XCNT(j)]); sum += c; cnt += (c > 0u) ? 1u : 0u; mine = (j == x) ? c : mine; }
        if (sum == G) break;
        __builtin_amdgcn_s_sleep(1);
        if ((++sp & 255u) == 0u) { if (xb_ld(&bar[XB_TMO])) break; if (sp > XB_SPIN_CAP) { atomicAdd(&bar[XB_TMO], 1u); break; } }
    }
    nloc = mine > 0u ? mine : 1u; nx = cnt > 0u ? cnt : 1u;
}

__device__ __forceinline__ void xcd_barrier(const XcdBarrier& b) {
    asm volatile("s_waitcnt vmcnt(0)" ::: "memory");
    __syncthreads();
    if (threadIdx.x == 0) {
        unsigned* bar = b.bar;
        __builtin_amdgcn_s_waitcnt(0);
        unsigned nloc = b.st[0], nx = b.st[1];
        if (nloc == 0u) { xcd_barrier_complete(bar, b.x, nloc, nx); b.st[0] = nloc; b.st[1] = nx; }
        const unsigned old = xb_add(&bar[XB_XSUB(b.x)], 1u);
        const unsigned gen = old / nloc;
        if (old + 1u == (gen + 1u) * nloc) {
            __builtin_amdgcn_fence(__ATOMIC_RELEASE, "agent");
            asm volatile("s_waitcnt vmcnt(0)" ::: "memory");
            const unsigned og = xb_add(&bar[XB_TOP], 1u);
            const unsigned tg = og / nx;
            if (og + 1u == (tg + 1u) * nx) xb_add(&bar[XB_TOPGEN], 1u);
            else XB_SPIN(xb_ld(&bar[XB_TOPGEN]) == tg, bar);
            __builtin_amdgcn_fence(__ATOMIC_ACQUIRE, "agent");
            xb_add(&bar[XB_XGEN(b.x)], 1u);
            asm volatile("s_waitcnt vmcnt(0)" ::: "memory");
        } else {
            XB_SPIN(xb_ld(&bar[XB_XGEN(b.x)]) == gen, bar);
            __builtin_amdgcn_fence(__ATOMIC_ACQUIRE, "agent");
            asm volatile("s_waitcnt vmcnt(0)" ::: "memory");
        }
    }
    __syncthreads();
}
struct Frame {
    LAS unsigned char* lds;
    volatile LAS unsigned* MISC;
    gu32* ctl;
    int tid, lane, wave;
    int vcu, G;
    const float* x; float* out;
    const float *g1, *w_in, *lq1, *lk1, *lq2, *lk2, *subg, *sinks, *w_out, *g2, *w_rg, *b_rg, *w_re, *b_re, *w_gate, *w_up, *w_down, *gf;
    bf16 *Win_t, *Wo_t, *Wgu_t, *Wd_t;
    bf16 *XN, *OD, *HB, *Y, *MIX, *QKV, *XS, *HM;
    float *Wr, *rope;
    int* tok_e; float* tok_g; float* tok_rstd; int* cnt; unsigned* blk_e; int* slot_dst; float* slot_gate; float* slot_rstd; int* slot_tok;
};
__device__ __forceinline__ float wave_sum(float v) {
#pragma unroll
    for (int o = 1; o < 64; o <<= 1) v += __shfl_xor(v, o);
    return v;
}
__device__ __forceinline__ void tr_item(const float* W, int ldn, int k0, int sc, const float* ksc, bf16* WT, int Kd, int drow0, LAS float* scr, int lane) {
#pragma unroll 8
    for (int i = 0; i < 32; ++i) { const int kk = 2 * i + (lane >> 5); float v = W[(size_t)(k0 + kk) * ldn + sc]; if (ksc) v *= ksc[k0 + kk]; scr[kk * 33 + (lane & 31)] = v; }
    LDS_WAIT(); asm volatile("" ::: "memory");
    const int c = lane & 7;
#pragma unroll
    for (int j = 0; j < 4; ++j) { const int n = (lane >> 3) + 8 * j; const LAS float* s = scr + (8 * c) * 33 + n;
        v4u o; o.x = pk2(s[0 * 33], s[1 * 33]); o.y = pk2(s[2 * 33], s[3 * 33]); o.z = pk2(s[4 * 33], s[5 * 33]); o.w = pk2(s[6 * 33], s[7 * 33]);
        *(GAS v4u*)(WT + (size_t)(drow0 + n) * Kd + k0 + 8 * c) = o; }
    LDS_WAIT(); asm volatile("" ::: "memory");
}
__device__ __forceinline__ void tr_item_w(const float* W, int ldn, int k0, int n0, const float* ksc, bf16* WT, int Kd, int drow0, LAS float* scr, int lane) {
    const int r = lane >> 3, c4 = (lane & 7) * 4;
    f32x4 v[8];
#pragma unroll
    for (int i = 0; i < 8; ++i) v[i] = *(const GAS f32x4*)(W + (size_t)(k0 + 8 * i + r) * ldn + n0 + c4);
    if (ksc) {
#pragma unroll
        for (int i = 0; i < 8; ++i) v[i] = v[i] * ksc[k0 + 8 * i + r]; }
#pragma unroll
    for (int i = 0; i < 8; ++i) { LAS float* d = scr + (8 * i + r) * 33 + c4; d[0] = v[i].x; d[1] = v[i].y; d[2] = v[i].z; d[3] = v[i].w; }
    LDS_WAIT(); asm volatile("" ::: "memory");
    const int c = lane & 7;
#pragma unroll
    for (int j = 0; j < 4; ++j) { const int n = (lane >> 3) + 8 * j; const LAS float* s = scr + (8 * c) * 33 + n;
        v4u o; o.x = pk2(s[0 * 33], s[1 * 33]); o.y = pk2(s[2 * 33], s[3 * 33]); o.z = pk2(s[4 * 33], s[5 * 33]); o.w = pk2(s[6 * 33], s[7 * 33]);
        *(GAS v4u*)(WT + (size_t)(drow0 + n) * Kd + k0 + 8 * c) = o; }
    LDS_WAIT(); asm volatile("" ::: "memory");
}
__device__ __forceinline__ int win_src_col(int n) {
    const bool isrope = (n < 1024) || (n >= 1536 && n < 2176);
    if (!isrope) return n;
    const int j = n & 63; return (n & ~63) + (j >> 1) + 32 * (j & 1);
}
constexpr int I_IN = (IN_COLS / 32) * (D / 64), I_O = (D / 32) * (D / 64), I_GU = NEXP * (1024 / 32) * (D / 64), I_D = NEXP * (D / 32) * (FF / 64), I_MOE = I_GU + I_D;
constexpr int MOE_TAIL_ITEMS = 17408;
__device__ __forceinline__ void moe_weight_items(Frame& F, int lo, int hi, int w, int nw) {
    LAS float* scr = (LAS float*)(F.lds + RING_OFF + F.wave * 16384);
    int lane_ = F.lane; asm volatile("" : "+v"(lane_)); const int lane = lane_;
    for (int it = lo + w; it < hi; it += nw) {
        int r = it;
        if (r < I_GU) { const int e = r / 512, q = r % 512, nb = q % 32, kb = q / 32;
            const float* src = (((nb >> 2) & 1) ? F.w_up : F.w_gate) + (size_t)e * D * FF; const int f0 = (nb >> 3) * 128 + (nb & 3) * 32;
            tr_item_w(src, FF, 64 * kb, f0, F.g2, F.Wgu_t + (size_t)e * 1024 * D, D, 32 * nb, scr, lane); continue; } r -= I_GU;
        { const int e = r / 256, q = r % 256, nb = q % 32, kb = q / 32;
            tr_item_w(F.w_down + (size_t)e * FF * D, D, 64 * kb, 32 * nb, nullptr, F.Wd_t + (size_t)e * D * FF, FF, 32 * nb, scr, lane); }
    }
}
__device__ __forceinline__ void p0_prologue(Frame& F) {
    LAS float* scr = (LAS float*)(F.lds + RING_OFF + F.wave * 16384);
    int lane_ = F.lane; asm volatile("" : "+v"(lane_)); const int gw = F.vcu * NWAVES + F.wave, NGW = F.G * NWAVES, lane = lane_;
    for (int it = gw; it < I_IN + I_O; it += NGW) {
        int r = it;
        if (r < I_IN) { const int nb = r % (IN_COLS / 32), kb = r / (IN_COLS / 32); tr_item(F.w_in, IN_COLS, 64 * kb, win_src_col(32 * nb + (lane & 31)), nullptr, F.Win_t, D, 32 * nb, scr, lane); continue; } r -= I_IN;
        { const int nb = r % (D / 32), kb = r / (D / 32); tr_item_w(F.w_out, D, 64 * kb, 32 * nb, nullptr, F.Wo_t, D, 32 * nb, scr, lane); }
    }
    if (F.G != 256) moe_weight_items(F, 0, I_MOE, gw, NGW);
    for (int i = (gw * 64 + lane); i < 3 * 8 * 4 * 64; i += NGW * 64) { const int ln = i & 63, q = (i >> 6) & 3, S = (i >> 8) & 7, blk = i >> 11, j = 16 * blk + (ln & 15), k0 = 128 * S + 32 * (ln >> 4) + 8 * q;
        unsigned hi[8], lo[8];
#pragma unroll
        for (int e = 0; e < 8; ++e) { const int k = k0 + e; const float w = j < 4 ? F.g2[k] * F.w_rg[k * 4 + j] : j < 36 ? F.g2[k] * F.w_re[k * NEXP + (j - 4)] : 0.f;
            hi[e] = f2bf(w); lo[e] = f2bf(w - __uint_as_float(hi[e] << 16)); }
        v4u oh, ol; oh.x = hi[0] | (hi[1] << 16); oh.y = hi[2] | (hi[3] << 16); oh.z = hi[4] | (hi[5] << 16); oh.w = hi[6] | (hi[7] << 16);
        ol.x = lo[0] | (lo[1] << 16); ol.y = lo[2] | (lo[3] << 16); ol.z = lo[4] | (lo[5] << 16); ol.w = lo[6] | (lo[7] << 16);
        *((GAS v4u*)F.Wr + i) = oh; *((GAS v4u*)F.Wr + 3 * 8 * 4 * 64 + i) = ol; }
    for (int i = (gw * 64 + lane); i < SEQ * 32; i += NGW * 64) { const int pos = i >> 5, fi = i & 31;
        double inv = 1.0; for (int q = 0; q < fi; ++q) inv *= 0.74989420933245582730;
        const double rev = (double)pos * inv * 0.15915494309189533577; const float fr = (float)(rev - __builtin_rint(rev));
        typedef float f32x2g __attribute__((ext_vector_type(2))); f32x2g cs; cs.x = __builtin_amdgcn_cosf(fr); cs.y = __builtin_amdgcn_sinf(fr); *(GAS f32x2g*)(F.rope + 2 * (size_t)i) = cs; }
    { f32x4 g[4];
#pragma unroll
      for (int j = 0; j < 4; ++j) g[j] = *((const GAS f32x4*)F.g1 + lane + 64 * j);
      for (int m = 2 * gw; m < T; m += 2 * NGW) {
        const GAS f32x4* xr = (const GAS f32x4*)(F.x + (size_t)m * D) + lane;
        f32x4 v[8]; float s0 = 0.f, s1 = 0.f;
#pragma unroll
        for (int j = 0; j < 8; ++j) v[j] = xr[64 * j];
#pragma unroll
        for (int j = 0; j < 4; ++j) { s0 += (v[j].x * v[j].x + v[j].y * v[j].y) + (v[j].z * v[j].z + v[j].w * v[j].w); s1 += (v[4 + j].x * v[4 + j].x + v[4 + j].y * v[4 + j].y) + (v[4 + j].z * v[4 + j].z + v[4 + j].w * v[4 + j].w); }
        const float r0 = 1.0f / sqrtf(wave_sum(s0) * (1.f / D) + RMS_EPS), r1 = 1.0f / sqrtf(wave_sum(s1) * (1.f / D) + RMS_EPS);
        GAS unsigned long long* o8 = (GAS unsigned long long*)(F.XN + (size_t)m * D) + lane;
#pragma unroll
        for (int j = 0; j < 8; ++j) { const f32x4 gg = g[j & 3]; const float rs = j < 4 ? r0 : r1;
            o8[64 * j] = (unsigned long long)pk2(v[j].x * rs * gg.x, v[j].y * rs * gg.y) | ((unsigned long long)pk2(v[j].z * rs * gg.z, v[j].w * rs * gg.w) << 32); }
      } }
}
#ifndef SWA_ABL
#define SWA_ABL 0
#endif
template <int PART> __device__ __forceinline__ void p2_attention(Frame& F, char* lds) {
    using abf = attn_body::bf16;
#ifndef SKIP_DIFF
    if (PART != 2) for (int L = F.vcu; L < 16 * 64; L += F.G) {
        const int i = L >> 8, v = L & 255, hh = v >> 4, s = v & 15, qb = 32 * (i >> 1) + ((i & 1) ? 31 - s : s);
        const int c = hh & 1, h = (hh >> 1) & 3, b = hh >> 3;
        const abf* base = (const abf*)F.QKV + (size_t)b * SEQ * IN_COLS;
        attn_body::attn_unit_w<8>(base + h * 128 + c * 64, base + 512 + h * 128 + c * 64, base + 1024 + h * 128,
                                  (abf*)F.OD + (size_t)b * SEQ * D + c * 512 + h * 128, (const unsigned*)(F.ctl + CW_KMAX) + (b * 8 + h * 2 + c) * 8, qb * 256, 4 * qb + 4, lds);
        if (F.G == 256 && PART == 0 && i < 3) { constexpr int NREST = I_MOE - MOE_TAIL_ITEMS, SL = (NREST + 2) / 3;
            const int lo_ = i * SL, hi_ = (i + 1) * SL < NREST ? (i + 1) * SL : NREST; moe_weight_items(F, lo_, hi_, F.vcu * NWAVES + F.wave, F.G * NWAVES); __syncthreads(); }
    }
#endif
#ifndef SKIP_SWA
    if (PART != 1) for (int L0 = F.vcu;; L0 += F.G) {
        int L = L0;
        if (PART == 0) { if (F.tid == 0) F.MISC[12] = __hip_atomic_fetch_add(F.ctl + CW_SWAQ, 1u, __ATOMIC_RELAXED, __HIP_MEMORY_SCOPE_AGENT); __syncthreads(); L = (int)F.MISC[12]; __syncthreads(); }
        L = __builtin_amdgcn_readfirstlane(L);
        if (L >= 2 * 2 * 64) break;
        const int qb = L & 63, kvh = (L >> 6) & 1, b = L >> 7;
        const abf* base = (const abf*)F.QKV + (size_t)b * SEQ * IN_COLS;
        float sk[4];
#pragma unroll
        for (int g = 0; g < 4; ++g) sk[g] = F.sinks[kvh * 4 + g] * 1.4426950408889634f;
        attn_body::swa_unit<(PART == 2) ? SWA_ABL : 0>(base + 1536 + kvh * 256, base + 2048 + kvh * 64, base + 2176 + kvh * 64, (abf*)F.MIX + (size_t)b * SEQ * D + 512 + kvh * 256, (const unsigned*)(F.ctl + CW_KMAX) + 128 + (b * 2 + kvh) * 8, qb * 256, sk, lds);
    }
#endif
}
__device__ __forceinline__ void p2b_combine(Frame& F) {
    int lane_ = F.lane; asm volatile("" : "+v"(lane_)); const int gw = F.vcu * NWAVES + F.wave, NGW = F.G * NWAVES, lane = lane_;
    const float lam = __expf(wave_sum(F.lq1[lane] * F.lk1[lane])) - __expf(wave_sum(F.lq2[lane] * F.lk2[lane])) + 0.2f;
    const f32x4 ga = *(const f32x4*)(F.subg + (lane & 15) * 8), gb = *(const f32x4*)(F.subg + (lane & 15) * 8 + 4);
    for (int m = gw; m < T; m += NGW) {
        const v4u a = *(const GAS v4u*)(F.OD + (size_t)m * D + 8 * lane), b = *(const GAS v4u*)(F.OD + (size_t)m * D + 512 + 8 * lane);
        float o[8]; float ss = 0.f;
#pragma unroll
        for (int q = 0; q < 4; ++q) { const unsigned ua = q == 0 ? a.x : q == 1 ? a.y : q == 2 ? a.z : a.w, ub = q == 0 ? b.x : q == 1 ? b.y : q == 2 ? b.z : b.w;
            o[2 * q] = __uint_as_float(ua << 16) - lam * __uint_as_float(ub << 16); o[2 * q + 1] = __uint_as_float(ua & 0xffff0000u) - lam * __uint_as_float(ub & 0xffff0000u);
            ss += o[2 * q] * o[2 * q] + o[2 * q + 1] * o[2 * q + 1]; }
        ss += __shfl_xor(ss, 1); ss += __shfl_xor(ss, 2); ss += __shfl_xor(ss, 4); ss += __shfl_xor(ss, 8);
        const float r = 0.8f / sqrtf(ss * (1.f / 128.f) + RMS_EPS);
        v4u w; w.x = pk2(o[0] * r * ga[0], o[1] * r * ga[1]); w.y = pk2(o[2] * r * ga[2], o[3] * r * ga[3]); w.z = pk2(o[4] * r * gb[0], o[5] * r * gb[1]); w.w = pk2(o[6] * r * gb[2], o[7] * r * gb[3]);
        *(GAS v4u*)(F.MIX + (size_t)m * D + 8 * lane) = w;
    }
}
__device__ __forceinline__ void p4a_router(Frame& F) {
    typedef float f32x4m __attribute__((ext_vector_type(4)));
    LAS int* lcnt = (LAS int*)(F.lds + RING_OFF);
    LAS float* lgs = (LAS float*)(F.lds + RING_OFF + 1024) + F.wave * 768;
    int lane_ = F.lane; asm volatile("" : "+v"(lane_)); const int lane = lane_, n = lane & 15, g = lane >> 4;
    const GAS v4u* Wh = (const GAS v4u*)F.Wr; const GAS v4u* Wl = Wh + 3 * 8 * 4 * 64;
    for (int ch = F.vcu; ch < NCHUNK; ch += F.G) {
        if (F.tid < 32) lcnt[F.tid] = 0;
        __syncthreads();
        const int t = ch * CHUNK_TOK + F.wave * 16 + n;
        const bf16* hrow = F.HB + (size_t)t * D + 32 * g;
        f32x4m acc[3]; acc[0] = (f32x4m){0.f, 0.f, 0.f, 0.f}; acc[1] = acc[0]; acc[2] = acc[0];
        float ss = 0.f;
#pragma unroll 2
        for (int S = 0; S < 8; ++S) {
            v4u hb[4];
#pragma unroll
            for (int q = 0; q < 4; ++q) hb[q] = *(const GAS v4u*)(hrow + 128 * S + 8 * q);
#pragma unroll
            for (int q = 0; q < 4; ++q) {
#pragma unroll
                for (int e = 0; e < 4; ++e) { const unsigned u = e == 0 ? hb[q].x : e == 1 ? hb[q].y : e == 2 ? hb[q].z : hb[q].w; const float a = __uint_as_float(u << 16), c = __uint_as_float(u & 0xffff0000u); ss += a * a + c * c; }
#pragma unroll
                for (int blk = 0; blk < 3; ++blk) { const int fi = ((blk * 8 + S) * 4 + q) * 64 + lane;
                    const v4u wh = Wh[fi], wl = Wl[fi];
                    acc[blk] = __builtin_amdgcn_mfma_f32_16x16x32_bf16(__builtin_bit_cast(bf16x8, wh), __builtin_bit_cast(bf16x8, hb[q]), acc[blk], 0, 0, 0);
                    acc[blk] = __builtin_amdgcn_mfma_f32_16x16x32_bf16(__builtin_bit_cast(bf16x8, wl), __builtin_bit_cast(bf16x8, hb[q]), acc[blk], 0, 0, 0); }
            }
        }
        ss += __shfl_xor(ss, 16); ss += __shfl_xor(ss, 32);
#pragma unroll
        for (int blk = 0; blk < 3; ++blk)
#pragma unroll
            for (int r = 0; r < 4; ++r) lgs[n * 48 + 16 * blk + 4 * g + r] = acc[blk][r];
        LDS_WAIT(); asm volatile("" ::: "memory");
        const LAS float* lg = lgs + n * 48;
        const float rstd = 1.0f / sqrtf(ss * (1.f / D) + RMS_EPS);
        float gl[4];
#pragma unroll
        for (int j = 0; j < 4; ++j) gl[j] = lg[j] * rstd + F.b_rg[j];
        int gi = 0; float gm = gl[0];
#pragma unroll
        for (int j = 1; j < 4; ++j) if (gl[j] > gm) { gm = gl[j]; gi = j; }
        float den = 0.f;
#pragma unroll
        for (int j = 0; j < 4; ++j) den += __expf(gl[j] - gm);
        const float ptop = 1.0f / den;
        float el[8];
#pragma unroll
        for (int i = 0; i < 8; ++i) el[i] = lg[4 + gi * 8 + i] * rstd + F.b_re[gi * 8 + i];
        int i0 = 0; float v0 = el[0];
#pragma unroll
        for (int i = 1; i < 8; ++i) if (el[i] > v0) { v0 = el[i]; i0 = i; }
        int i1 = -1; float v1 = -INFINITY;
#pragma unroll
        for (int i = 0; i < 8; ++i) if (i != i0 && el[i] > v1) { v1 = el[i]; i1 = i; }
        const float e1w = __expf(v1 - v0), gt0 = ptop / (1.0f + e1w), gt1 = gt0 * e1w;
        if (g == 0) { const int e0 = gi * 8 + i0, e1 = gi * 8 + i1;
            F.tok_e[2 * t] = e0; F.tok_e[2 * t + 1] = e1; F.tok_g[2 * t] = gt0; F.tok_g[2 * t + 1] = gt1; F.tok_rstd[t] = rstd;
            atomicAdd((int*)&lcnt[e0], 1); atomicAdd((int*)&lcnt[e1], 1); }
        __syncthreads();
        if (F.tid < 32) F.cnt[ch * 32 + F.tid] = lcnt[F.tid];
        __syncthreads();
    }
}
__device__ __forceinline__ void p4b_scatter(Frame& F) {
    LAS int* E = (LAS int*)(F.lds + RING_OFF);
    LAS int* SL = E + 256;
    LAS int* base = SL + 256;
    LAS int* padded = base + 32;
    LAS int* padlo = padded + 32;
    LAS int* padhi = padlo + 32;
    LAS int* ptot = padhi + 32; LAS int* ppre = ptot + 512;
    int tid_ = F.tid; asm volatile("" : "+v"(tid_)); const int tid = tid_;
    for (int ch = F.vcu; ch < NCHUNK; ch += F.G) {
        int pre = 0, total = 0;
        if (tid < 256) E[tid] = F.tok_e[ch * 256 + tid];
        { const int e_ = tid & 31, part = tid >> 5; int tsum = 0, psum = 0;
#pragma unroll
          for (int q = 0; q < 16; ++q) { const int c2 = part * 16 + q; const int vv = F.cnt[c2 * 32 + e_]; tsum += vv; psum += (c2 < ch) ? vv : 0; }
          ptot[part * 32 + e_] = tsum; ppre[part * 32 + e_] = psum; }
        __syncthreads();
        if (tid < 32) {
#pragma unroll
            for (int q = 0; q < 16; ++q) { total += ptot[q * 32 + tid]; pre += ppre[q * 32 + tid]; }
            padded[tid] = (total + 255) & ~255; }
        __syncthreads();
        if (tid < 32) { int ps = 0; for (int e2 = 0; e2 < tid; ++e2) ps += padded[e2];
            base[tid] = ps + pre; padlo[tid] = ps + total; padhi[tid] = ps + padded[tid];
            if (ch == 0) { for (int rb = ps >> 8; rb < ((ps + padded[tid]) >> 8); ++rb) F.blk_e[rb] = (unsigned)tid; if (tid == 31) __hip_atomic_store(F.ctl + CW_NBU, (unsigned)((ps + padded[tid]) >> 8), RLX_AGENT); } }
        __syncthreads();
        if (tid < 256) { const int e = E[tid]; int rank = 0; for (int a2 = 0; a2 < tid; ++a2) rank += (E[a2] == e) ? 1 : 0;
            const int slot = base[e] + rank; SL[tid] = slot;
            F.slot_dst[slot] = ch * 256 + tid; F.slot_tok[slot] = ch * CHUNK_TOK + (tid >> 1); F.slot_gate[slot] = F.tok_g[ch * 256 + tid]; F.slot_rstd[slot] = F.tok_rstd[ch * CHUNK_TOK + (tid >> 1)]; }
        __syncthreads();
        if (ch < NEXP) { const int lo = padlo[ch], hi = padhi[ch];
            for (int s = lo + tid; s < hi; s += NWAVES * 64) { F.slot_dst[s] = -1; F.slot_tok[s] = 0; F.slot_gate[s] = 0.f; F.slot_rstd[s] = 0.f; } }
        __syncthreads();
    }
}
__device__ __forceinline__ void p6_final(Frame& F) {
    int lane_ = F.lane; asm volatile("" : "+v"(lane_)); const int gw = F.vcu * NWAVES + F.wave, NGW = F.G * NWAVES, lane = lane_;
    f32x4 g[4];
#pragma unroll
    for (int j = 0; j < 4; ++j) g[j] = *((const GAS f32x4*)F.gf + 2 * lane + (j & 1) + 128 * (j >> 1));
    for (int m = gw; m < T; m += NGW) {
        const GAS v4u* hr = (const GAS v4u*)(F.HB + (size_t)m * D) + lane; const GAS v4u* y0 = (const GAS v4u*)(F.Y + (size_t)(2 * m) * D) + lane; const GAS v4u* y1 = (const GAS v4u*)(F.Y + (size_t)(2 * m + 1) * D) + lane;
        v4u a[2], b[2], c[2];
#pragma unroll
        for (int j = 0; j < 2; ++j) { a[j] = hr[64 * j]; b[j] = y0[64 * j]; c[j] = y1[64 * j]; }
        float v[16]; float s = 0.f;
#pragma unroll
        for (int j = 0; j < 2; ++j)
#pragma unroll
            for (int q = 0; q < 4; ++q) { const unsigned ua = q == 0 ? a[j].x : q == 1 ? a[j].y : q == 2 ? a[j].z : a[j].w, ub = q == 0 ? b[j].x : q == 1 ? b[j].y : q == 2 ? b[j].z : b[j].w, uc = q == 0 ? c[j].x : q == 1 ? c[j].y : q == 2 ? c[j].z : c[j].w;
                const float lo = __uint_as_float(ua << 16) + __uint_as_float(ub << 16) + __uint_as_float(uc << 16), hi = __uint_as_float(ua & 0xffff0000u) + __uint_as_float(ub & 0xffff0000u) + __uint_as_float(uc & 0xffff0000u);
                v[8 * j + 2 * q] = lo; v[8 * j + 2 * q + 1] = hi; s += lo * lo + hi * hi; }
        const float rstd = 1.0f / sqrtf(wave_sum(s) * (1.f / D) + RMS_EPS);
        GAS f32x4* orow = (GAS f32x4*)(F.out + (size_t)m * D) + 2 * lane;
#pragma unroll
        for (int j = 0; j < 2; ++j) { const f32x4 g0 = g[2 * j], g1 = g[2 * j + 1];
            orow[128 * j] = (f32x4){v[8 * j] * rstd * g0.x, v[8 * j + 1] * rstd * g0.y, v[8 * j + 2] * rstd * g0.z, v[8 * j + 3] * rstd * g0.w};
            orow[128 * j + 1] = (f32x4){v[8 * j + 4] * rstd * g1.x, v[8 * j + 5] * rstd * g1.y, v[8 * j + 6] * rstd * g1.z, v[8 * j + 7] * rstd * g1.w}; }
    }
}

struct Args { const float* in[19]; float* out; unsigned char* ws; };
__global__ void __launch_bounds__(NWAVES * 64, 2) hymba_fwd(Args args) {
    extern __shared__ __attribute__((aligned(16))) unsigned char lds[];
    Frame F;
    F.lds = (LAS unsigned char*)lds;
    F.MISC = (volatile LAS unsigned*)(F.lds + MISC_OFF);
    F.tid = threadIdx.x; F.lane = F.tid & 63; F.wave = __builtin_amdgcn_readfirstlane(F.tid >> 6);
    F.G = gridDim.x; { const int bx = blockIdx.x; F.vcu = (F.G % 8 == 0) ? (bx % 8) * (F.G / 8) + bx / 8 : bx; }
    unsigned char* ws = args.ws;
    F.ctl = (gu32*)(ws + WS_CTL);
    F.x = args.in[0]; F.g1 = args.in[1]; F.w_in = args.in[2]; F.lq1 = args.in[3]; F.lk1 = args.in[4]; F.lq2 = args.in[5]; F.lk2 = args.in[6]; F.subg = args.in[7]; F.sinks = args.in[8];
    F.w_out = args.in[9]; F.g2 = args.in[10]; F.w_rg = args.in[11]; F.b_rg = args.in[12]; F.w_re = args.in[13]; F.b_re = args.in[14]; F.w_gate = args.in[15]; F.w_up = args.in[16]; F.w_down = args.in[17]; F.gf = args.in[18];
    F.out = args.out;
    F.Win_t = (bf16*)(ws + WS_WIN); F.Wo_t = (bf16*)(ws + WS_WO); F.Wgu_t = (bf16*)(ws + WS_WGU); F.Wd_t = (bf16*)(ws + WS_WD);
    F.XN = (bf16*)(ws + WS_A); F.OD = F.XN; F.HB = F.XN; F.MIX = (bf16*)(ws + WS_MIX); F.Y = F.MIX; F.QKV = (bf16*)(ws + WS_QKV); F.XS = F.QKV; F.HM = (bf16*)(ws + WS_HM);
    F.Wr = (float*)(ws + WS_WR); F.rope = (float*)(ws + WS_ROPE);
    { unsigned char* p = ws + WS_TOK; F.tok_e = (int*)p; p += (size_t)T * 8; F.tok_g = (float*)p; p += (size_t)T * 8; F.tok_rstd = (float*)p; p += (size_t)T * 4; F.cnt = (int*)p; p += NCHUNK * 32 * 4;
      F.blk_e = (unsigned*)p; p += 288 * 4; F.slot_dst = (int*)p; p += (size_t)PSLOTS * 4; F.slot_gate = (float*)p; p += (size_t)PSLOTS * 4; F.slot_rstd = (float*)p; p += (size_t)PSLOTS * 4; F.slot_tok = (int*)p; }
    for (int u = F.tid; u < (LDS_BYTES - LDSCTL_OFF) / 4; u += NWAVES * 64) ((LAS unsigned*)(F.lds + LDSCTL_OFF))[u] = 0u;
    __syncthreads();
    XcdBarrier bar = xcd_barrier_post((unsigned*)(F.ctl + CW_BAR), F.MISC + 8);
    if (F.tid == 0) F.MISC[13] = __hip_atomic_fetch_add(F.ctl + CW_RANK + bar.x, 1u, RLX_AGENT);
#define GRID_BAR() xcd_barrier(bar)

#define RUN_P0() p0_prologue(F)
#define RUN_P1() do { pg8::Gemm g{F.XN, F.Win_t, T, IN_COLS, D}; pg8::StaticOrder S; S.init(T, IN_COLS, F.G, (int)blockIdx.x); \
      pg8::EpiQKV E{F.QKV, F.rope, attn_body::C2, 0, (unsigned*)(F.ctl + CW_KMAX)}; \
      pg8::gemm_phase<pg8::EpiQKV, pg8::StaticOrder, PG8_ALIGN, PG8_SP2>(F.lds + RING_OFF, g, S, E); \
      if (F.G == 256 && blockIdx.x >= 128) moe_weight_items(F, I_MOE - MOE_TAIL_ITEMS, I_MOE, ((int)blockIdx.x - 128) * NWAVES + F.wave, 128 * NWAVES); } while (0)
#define RUN_P2() p2_attention<0>(F, (char*)lds + RING_OFF)
#define RUN_P2B() p2b_combine(F)
#define RUN_P3() do { pg8::Gemm g{F.MIX, F.Wo_t, T, D, D}; pg8::StaticOrder S; S.init(T, D, F.G, (int)blockIdx.x); \
      pg8::EpiResid E{F.x, F.HB}; \
      pg8::gemm_phase<pg8::EpiResid, pg8::StaticOrder, PG8_ALIGN, PG8_SP2>(F.lds + RING_OFF, g, S, E); } while (0)
#define RUN_P4A() p4a_router(F)
#define RUN_P4B() p4b_scatter(F)
#define RUN_P5() do { const int nbu = __builtin_amdgcn_readfirstlane((int)__hip_atomic_load(F.ctl + CW_NBU, RLX_AGENT)); \
      if (F.tid == 0) { unsigned pre = 0u, mine = 1u; for (unsigned j = 0; j < 16u; ++j) { const unsigned cj = xb_ld(bar.bar + XB_XCNT(j)); if (j < bar.x) pre += cj; if (j == bar.x) mine = cj; } F.MISC[16] = pre; F.MISC[17] = mine; } \
      __syncthreads(); \
      const int pre_ = __builtin_amdgcn_readfirstlane((int)F.MISC[16]), nloc_ = __builtin_amdgcn_readfirstlane((int)F.MISC[17]), rank_ = __builtin_amdgcn_readfirstlane((int)F.MISC[13]); \
      const int lo_ = (int)(((long)nbu * pre_) / F.G), hi_ = (int)(((long)nbu * (pre_ + nloc_)) / F.G); \
      { pg8::Gemm g{F.HB, F.Wgu_t, PSLOTS, NEXP * 1024, D}; pg8::XcdSched S{F.blk_e, lo_, hi_, rank_, nloc_, (unsigned*)(F.ctl + CW_DONE)}; \
        LAS int* rowtab = (LAS int*)(F.lds + ROWTAB_OFF); pg8::Unit uu; \
        for (int ui = 0; ui < ROWTAB_UNITS && S.next(ui, uu); ++ui) if (F.tid < 256) rowtab[ui * 256 + F.tid] = F.slot_tok[uu.pm * 256 + F.tid];     \
        __syncthreads(); \
        pg8::EpiGateUp E{F.HM, F.slot_rstd}; \
        pg8::gemm_phase<pg8::EpiGateUp, pg8::XcdSched, PG8_ALIGN, true, true>(F.lds + RING_OFF, g, S, E, rowtab); } \
      { pg8::Gemm g{F.HM, F.Wd_t, PSLOTS, NEXP * 1024, FF}; pg8::XcdDyn S{F.blk_e, lo_, hi_, (unsigned*)(F.ctl + CW_BQ + bar.x), (unsigned*)(F.ctl + CW_DONE), F.MISC + 14, 0u}; \
        pg8::EpiDown E{F.Y, F.slot_dst, F.slot_gate}; \
        pg8::gemm_phase<pg8::EpiDown, pg8::XcdDyn, PG8_ALIGN, true>(F.lds + RING_OFF, g, S, E); } } while (0)
#ifdef DUP_P0
    RUN_P0(); GRID_BAR();
#endif
    RUN_P0(); GRID_BAR();
#ifdef DUP_P1
    { pg8::Gemm g{F.XN, F.Win_t, T, IN_COLS, D}; pg8::StaticOrder S; S.init(T, IN_COLS, F.G, (int)blockIdx.x);
      pg8::EpiQKV E{F.QKV, F.rope, attn_body::C2, DUP_P1, (unsigned*)(F.ctl + CW_KMAX)};
      pg8::gemm_phase<pg8::EpiQKV, pg8::StaticOrder, PG8_ALIGN, PG8_SP2>(F.lds + RING_OFF, g, S, E); }
    GRID_BAR();
#endif
    RUN_P1(); GRID_BAR();
#ifdef DUP_P2
    p2_attention<DUP_P2>(F, (char*)lds + RING_OFF); GRID_BAR();
#endif
    RUN_P2(); GRID_BAR();
#ifdef DUP_P2B
    RUN_P2B(); GRID_BAR();
#endif
    RUN_P2B(); GRID_BAR();
#ifdef DUP_P3
    RUN_P3(); GRID_BAR();
#endif
    RUN_P3(); GRID_BAR();
#ifdef DUP_P4A
    RUN_P4A(); GRID_BAR();
#endif
    RUN_P4A(); GRID_BAR();
#ifdef DUP_P4B
    RUN_P4B(); GRID_BAR();
#endif
    RUN_P4B(); GRID_BAR();
    RUN_P5(); GRID_BAR();
#ifndef SKIP_P6
    p6_final(F);
#endif
}

extern "C" void kernel_launch(void* const* d_in, const int* in_sizes, int n_in, void* d_out, int out_size, void* d_ws, size_t ws_size, hipStream_t stream) {
    static int grid = 0;
    if (grid == 0) {
        if (n_in != 19 || in_sizes[0] != T * D || out_size != T * D || ws_size < WS_END) { fprintf(stderr, "kernel_launch: unexpected shapes (n_in %d, in0 %d, out %d, ws %zu); nothing launched\n", n_in, n_in > 0 ? in_sizes[0] : -1, out_size, ws_size); grid = -1; return; }
        int dev = 0, cus = 0, per_cu = 0;
        if (hipGetDevice(&dev) != hipSuccess || hipDeviceGetAttribute(&cus, hipDeviceAttributeMultiprocessorCount, dev) != hipSuccess) { grid = -1; return; }
        if (hipFuncSetAttribute((const void*)hymba_fwd, hipFuncAttributeMaxDynamicSharedMemorySize, LDS_BYTES) != hipSuccess) { grid = -1; return; }
        if (hipOccupancyMaxActiveBlocksPerMultiprocessor(&per_cu, (const void*)hymba_fwd, NWAVES * 64, LDS_BYTES) != hipSuccess || per_cu < 1) { fprintf(stderr, "kernel_launch: occupancy query reports %d\n", per_cu); }
        (void)hipGetLastError();
        grid = cus;
    }
    if (grid < 0) return;
    if (hipMemsetAsync((char*)d_ws + WS_CTL, 0, CTL_ZERO_BYTES, stream) != hipSuccess) return;
    Args a{};
    for (int i = 0; i < 19; ++i) a.in[i] = (const float*)d_in[i];
    a.out = (float*)d_out; a.ws = (unsigned char*)d_ws;
    hipLaunchKernelGGL(hymba_fwd, dim3(grid), dim3(NWAVES * 64), LDS_BYTES, stream, a);
}
```

```cpp
#include <hip/hip_runtime.h>
#include <cstdio>
#include <cstdint>
namespace pg8 {
#define PG8_LAS __attribute__((address_space(3)))
typedef unsigned short bf16_t;
typedef short bf16x8 __attribute__((ext_vector_type(8)));
typedef float f32x4 __attribute__((ext_vector_type(4)));
typedef unsigned u32x4 __attribute__((ext_vector_type(4)));
constexpr int BM = 256, BK = 64, HALF = 128, HTB = HALF * BK * 2  , STAGE_BYTES = 8 * HTB, NXCD = 8, WGM = 2;

__host__ __device__ __forceinline__ int lds_byte(int r, int c) { const int st = (r >> 4) * 2 + (c >> 5), rr = r & 15, cc = c & 31, ob = rr * 64 + cc * 2; return st * 1024 + (ob ^ (((ob >> 9) & 1) << 5)); }
__host__ __device__ __forceinline__ void stage_rc(int b, int& R, int& C) { const int st = b / 1024, sb = b % 1024, swz = sb ^ (((sb >> 9) & 1) << 5); R = (st >> 1) * 16 + swz / 64; C = (st & 1) * 32 + (swz % 64) / 2; }
__host__ __device__ __forceinline__ int perm32(int rho) { const int n = rho >> 4, i = rho & 15; return 8 * (i >> 2) + 4 * n + (i & 3); }

struct Unit { int pm, pn; };
struct Gemm { const bf16_t* A; const bf16_t* Bt; int M, N, K; };

struct StaticOrder {
    static constexpr bool DYN = false;
    int nM, nN, nwg, G, c;
    __host__ __device__ void init(int M, int N, int G_, int c_) { nM = M / BM; nN = N / BM; nwg = nM * nN; G = G_; c = c_; }
    __host__ __device__ bool next(int i, Unit& u) const {
        const long L = (long)i * G + c; if (L >= nwg) return false;
        int wgid = (int)L; { const int q = nwg / NXCD, r = nwg % NXCD, xcd = wgid % NXCD, off = wgid / NXCD; wgid = (xcd < r ? xcd * (q + 1) : r * (q + 1) + (xcd - r) * q) + off; }
        const int nig = WGM * nN, gid = wgid / nig, fm = gid * WGM, gsz = (nM - fm) < WGM ? (nM - fm) : WGM;
        u.pm = fm + ((wgid % nig) % gsz); u.pn = (wgid % nig) / gsz; return true;
    }
    __device__ __forceinline__ void a_ready(const Unit&) const {}
    __device__ __forceinline__ void done(const Unit&) const {}
};

__device__ __forceinline__ unsigned cvt_pk_bf16(float lo, float hi) { unsigned r; asm volatile("v_cvt_pk_bf16_f32 %0, %1, %2" : "=v"(r) : "v"(lo), "v"(hi)); return r; }
typedef float f32x2 __attribute__((ext_vector_type(2)));
__device__ __forceinline__ f32x2 gelu_pk(f32x2 v) {
    const f32x2 av = __builtin_elementwise_abs(v), d = av * 0.2316418882f + 1.0f;
    f32x2 t; t.x = __builtin_amdgcn_rcpf(d.x); t.y = __builtin_amdgcn_rcpf(d.y);
    f32x2 q = t * 0.5307027145f + (-0.7265760135f); q = q * t + 0.7107068705f; q = q * t + (-0.142248368f); q = q * t + 0.127414796f; q = q * t;
    const f32x2 s = (v * v) * (-0.72134752044f);
    f32x2 e; e.x = __builtin_amdgcn_exp2f(s.x); e.y = __builtin_amdgcn_exp2f(s.y);
    const f32x2 m = v * (q * e), r = v - m;
    f32x2 o; o.x = v.x < 0.f ? m.x : r.x; o.y = v.y < 0.f ? m.y : r.y; return o;
}

template <int ACT  > struct EpiBf16 {
    static constexpr bool PERM = true, AFTER_DRAIN = false; static_assert(ACT == 0 || ACT == 1, "EpiBf16: ACT is 0 (none) or 1 (gelu_pk)");
    bf16_t* O; int ldc; const float* bias; int split_cols; size_t split_stride; float scale0;
    __device__ __forceinline__ void operator()(const f32x4 (&acc)[2][2][4][2], const Unit& u, int wr, int wc, int fr, int fq) const {
        const int row0 = u.pm * BM + wr * 64 + fr; int colt = u.pn * BM; bf16_t* base = O;
        float sc = 1.f; if (split_cols) { const int t = colt / split_cols; base += (size_t)t * split_stride; colt -= t * split_cols; if (t == 0) sc = scale0; }
        const int col0 = colt + wc * 32 + 8 * fq, bcol0 = u.pn * BM + wc * 32 + 8 * fq;
        f32x4 bv[2][2];
#pragma unroll
        for (int bj = 0; bj < 2; ++bj)
#pragma unroll
            for (int n = 0; n < 2; ++n) bv[bj][n] = bias ? *(const f32x4*)(bias + bcol0 + bj * HALF + 4 * n) : (f32x4){0.f, 0.f, 0.f, 0.f};
#pragma unroll
        for (int ai = 0; ai < 2; ++ai)
#pragma unroll
            for (int m = 0; m < 4; ++m) { bf16_t* rowp = base + (size_t)(row0 + ai * HALF + m * 16) * ldc + col0;
#pragma unroll
                for (int bj = 0; bj < 2; ++bj) { f32x4 v0 = acc[ai][bj][m][0] + bv[bj][0], v1 = acc[ai][bj][m][1] + bv[bj][1];
                    if (ACT == 1) { f32x2 a = gelu_pk((f32x2){v0[0], v0[1]}), b = gelu_pk((f32x2){v0[2], v0[3]}), c = gelu_pk((f32x2){v1[0], v1[1]}), d = gelu_pk((f32x2){v1[2], v1[3]});
                        v0 = (f32x4){a.x, a.y, b.x, b.y}; v1 = (f32x4){c.x, c.y, d.x, d.y}; }
                    v0 = v0 * sc; v1 = v1 * sc; u32x4 w; w.x = cvt_pk_bf16(v0[0], v0[1]); w.y = cvt_pk_bf16(v0[2], v0[3]); w.z = cvt_pk_bf16(v1[0], v1[1]); w.w = cvt_pk_bf16(v1[2], v1[3]);
                    *(u32x4*)(rowp + bj * HALF) = w; } }
    }
};

constexpr int QKV_LD = 2304, SEQ_LEN = 16384;
struct EpiQKV {
    static constexpr bool PERM = true, AFTER_DRAIN = false;
    bf16_t* O; const float* rope; float qscale; int norope; unsigned* kmax;
    __device__ __forceinline__ void operator()(const f32x4 (&acc)[2][2][4][2], const Unit& u, int wr, int wc, int fr, int fq) const {
        const int row0 = u.pm * BM + wr * 64 + fr;
#pragma unroll
        for (int bj = 0; bj < 2; ++bj) {
            const int cb = u.pn * BM + bj * HALF, col0 = cb + wc * 32 + 8 * fq;
            const bool isrope = !norope && ((cb < 1024) || (cb >= 1536 && cb < 2176));
            const float sc = ((cb < 512) || (cb >= 1536 && cb < 2048)) ? qscale : 1.f;
            const int i0 = (col0 & 63) >> 1;
            const bool iskd = ((cb >= 512) && (cb < 1024)) || cb == 2048; float kmx = 0.f;
#pragma unroll
            for (int ai = 0; ai < 2; ++ai)
#pragma unroll
                for (int m = 0; m < 4; ++m) {
                    const int row = row0 + ai * HALF + m * 16;
                    f32x4 v0 = acc[ai][bj][m][0], v1 = acc[ai][bj][m][1];
                    if (isrope) {
                        const int pos = row & (SEQ_LEN - 1);
                        const f32x4* tp = (const f32x4*)(rope + ((size_t)pos * 32 + i0) * 2);
                        const f32x4 t0 = tp[0], t1 = tp[1];
                        f32x4 r0, r1;
                        r0[0] = v0[0] * t0[0] - v0[1] * t0[1]; r0[1] = v0[0] * t0[1] + v0[1] * t0[0];
                        r0[2] = v0[2] * t0[2] - v0[3] * t0[3]; r0[3] = v0[2] * t0[3] + v0[3] * t0[2];
                        r1[0] = v1[0] * t1[0] - v1[1] * t1[1]; r1[1] = v1[0] * t1[1] + v1[1] * t1[0];
                        r1[2] = v1[2] * t1[2] - v1[3] * t1[3]; r1[3] = v1[2] * t1[3] + v1[3] * t1[2];
                        v0 = r0; v1 = r1;
                    }
                    if (iskd) kmx = __builtin_fmaxf(kmx, (v0[0] * v0[0] + v0[1] * v0[1]) + (v0[2] * v0[2] + v0[3] * v0[3]) + (v1[0] * v1[0] + v1[1] * v1[1]) + (v1[2] * v1[2] + v1[3] * v1[3]));
                    v0 = v0 * sc; v1 = v1 * sc;
                    u32x4 w; w.x = cvt_pk_bf16(v0[0], v0[1]); w.y = cvt_pk_bf16(v0[2], v0[3]); w.z = cvt_pk_bf16(v1[0], v1[1]); w.w = cvt_pk_bf16(v1[2], v1[3]);
                    *(u32x4*)(O + (size_t)row * QKV_LD + col0) = w;
                }
            if (iskd) {
                kmx = __builtin_fmaxf(kmx, __builtin_bit_cast(float, __builtin_amdgcn_mov_dpp(__builtin_bit_cast(int, kmx), 0xB1, 0xF, 0xF, true)));
                kmx = __builtin_fmaxf(kmx, __builtin_bit_cast(float, __builtin_amdgcn_mov_dpp(__builtin_bit_cast(int, kmx), 0x4E, 0xF, 0xF, true)));
                kmx = __builtin_fmaxf(kmx, __builtin_bit_cast(float, __builtin_amdgcn_mov_dpp(__builtin_bit_cast(int, kmx), 0x141, 0xF, 0xF, true)));
                kmx = __builtin_fmaxf(kmx, __builtin_bit_cast(float, __builtin_amdgcn_mov_dpp(__builtin_bit_cast(int, kmx), 0x140, 0xF, 0xF, true)));
                const int slot = cb < 1024 ? (((u.pm >> 6) * 8 + ((cb + wc * 32 - 512) >> 6)) * 8) : (128 + ((u.pm >> 6) * 2 + (wc >> 1)) * 8);
                if (fr == 0) __hip_atomic_fetch_max(kmax + slot + (wc & 1) * 4 + fq, __builtin_bit_cast(unsigned, kmx), __ATOMIC_RELAXED, __HIP_MEMORY_SCOPE_AGENT); }
        }
    }
};
struct EpiResid {
    static constexpr bool PERM = true, AFTER_DRAIN = false;
    const float* x; bf16_t* hb;
    __device__ __forceinline__ void operator()(const f32x4 (&acc)[2][2][4][2], const Unit& u, int wr, int wc, int fr, int fq) const {
        const int row0 = u.pm * BM + wr * 64 + fr;
#pragma unroll
        for (int ai = 0; ai < 2; ++ai)
#pragma unroll
            for (int m = 0; m < 4; ++m) {
                const size_t ro = (size_t)(row0 + ai * HALF + m * 16) * 1024;
#pragma unroll
                for (int bj = 0; bj < 2; ++bj) {
                    const size_t o = ro + u.pn * BM + bj * HALF + wc * 32 + 8 * fq;
                    const f32x4 v0 = acc[ai][bj][m][0] + *(const f32x4*)(x + o), v1 = acc[ai][bj][m][1] + *(const f32x4*)(x + o + 4);
                    u32x4 w; w.x = cvt_pk_bf16(v0[0], v0[1]); w.y = cvt_pk_bf16(v0[2], v0[3]); w.z = cvt_pk_bf16(v1[0], v1[1]); w.w = cvt_pk_bf16(v1[2], v1[3]);
                    *(u32x4*)(hb + o) = w;
                }
            }
    }
};
__device__ __forceinline__ float silu_mul(float g, float up) { return g * __builtin_amdgcn_rcpf(1.0f + __builtin_amdgcn_exp2f(-1.4426950408889634f * g)) * up; }
struct EpiGateUp {
    static constexpr bool PERM = true, AFTER_DRAIN = false;
    bf16_t* hm; const float* slot_rstd;
    __device__ __forceinline__ void operator()(const f32x4 (&acc)[2][2][4][2], const Unit& u, int wr, int wc, int fr, int fq) const {
        const int row0 = u.pm * BM + wr * 64 + fr, f0 = (u.pn & 3) * 128 + wc * 32 + 8 * fq;
#pragma unroll
        for (int ai = 0; ai < 2; ++ai)
#pragma unroll
            for (int m = 0; m < 4; ++m) {
                const int row = row0 + ai * HALF + m * 16; const float rs = slot_rstd[row];
                const f32x4 g0 = acc[ai][0][m][0] * rs, g1 = acc[ai][0][m][1] * rs, u0 = acc[ai][1][m][0] * rs, u1 = acc[ai][1][m][1] * rs;
                u32x4 w; w.x = cvt_pk_bf16(silu_mul(g0[0], u0[0]), silu_mul(g0[1], u0[1])); w.y = cvt_pk_bf16(silu_mul(g0[2], u0[2]), silu_mul(g0[3], u0[3]));
                w.z = cvt_pk_bf16(silu_mul(g1[0], u1[0]), silu_mul(g1[1], u1[1])); w.w = cvt_pk_bf16(silu_mul(g1[2], u1[2]), silu_mul(g1[3], u1[3]));
                *(u32x4*)(hm + (size_t)row * 512 + f0) = w;
            }
    }
};
struct EpiDown {
    static constexpr bool PERM = true, AFTER_DRAIN = false;
    bf16_t* Y; const int* slot_dst; const float* slot_gate;
    __device__ __forceinline__ void operator()(const f32x4 (&acc)[2][2][4][2], const Unit& u, int wr, int wc, int fr, int fq) const {
        const int row0 = u.pm * BM + wr * 64 + fr, c0 = (u.pn & 3) * BM + wc * 32 + 8 * fq;
#pragma unroll
        for (int ai = 0; ai < 2; ++ai)
#pragma unroll
            for (int m = 0; m < 4; ++m) {
                const int row = row0 + ai * HALF + m * 16; const int dst = slot_dst[row]; const float gt = slot_gate[row];
                if (dst >= 0) {
#pragma unroll
                    for (int bj = 0; bj < 2; ++bj) { const f32x4 v0 = acc[ai][bj][m][0] * gt, v1 = acc[ai][bj][m][1] * gt;
                        u32x4 w; w.x = cvt_pk_bf16(v0[0], v0[1]); w.y = cvt_pk_bf16(v0[2], v0[3]); w.z = cvt_pk_bf16(v1[0], v1[1]); w.w = cvt_pk_bf16(v1[2], v1[3]);
                        *(u32x4*)(Y + (size_t)dst * 1024 + c0 + bj * HALF) = w; }
                }
            }
    }
};
struct MoeSched {
    static constexpr bool DYN = false;
    const unsigned* blk_e; int nunits, G, c;
    __device__ __forceinline__ bool next(int i, Unit& u) const {
        const long L = (long)i * G + c; if (L >= nunits) return false;
        int wgid = (int)L; { const int q = nunits / NXCD, r = nunits % NXCD, xcd = wgid % NXCD, off = wgid / NXCD; wgid = (xcd < r ? xcd * (q + 1) : r * (q + 1) + (xcd - r) * q) + off; }
        const int rb = wgid >> 2, j = wgid & 3;
        const int e = __builtin_amdgcn_readfirstlane((int)__hip_atomic_load(blk_e + rb, __ATOMIC_RELAXED, __HIP_MEMORY_SCOPE_AGENT));
        u.pm = rb; u.pn = e * 4 + j; return true;
    }
    __device__ __forceinline__ void a_ready(const Unit&) const {}
    __device__ __forceinline__ void done(const Unit&) const {}
};
struct XcdSched {
    static constexpr bool DYN = false;
    const unsigned* blk_e; int lo, hi, r, nloc; unsigned* donew;
    __device__ __forceinline__ bool next(int i, Unit& u) const {
        const int L = i * nloc + r; if (L >= 4 * (hi - lo)) return false;
        const int rb = lo + (L >> 2), j = L & 3;
        const int e = __builtin_amdgcn_readfirstlane((int)__hip_atomic_load(blk_e + rb, __ATOMIC_RELAXED, __HIP_MEMORY_SCOPE_AGENT));
        u.pm = rb; u.pn = e * 4 + j; return true;
    }
    __device__ __forceinline__ void a_ready(const Unit&) const {}
    __device__ __forceinline__ void done(const Unit& u) const {
        asm volatile("s_waitcnt vmcnt(0)" ::: "memory");
        if ((threadIdx.x & 63) == 0) (void)__hip_atomic_fetch_add(donew + u.pm, 1u, __ATOMIC_RELAXED, __HIP_MEMORY_SCOPE_AGENT);
    }
};
struct XcdDyn {
    static constexpr bool DYN = true;
    const unsigned* blk_e; int lo, hi; unsigned* ctr; unsigned* donew; volatile PG8_LAS unsigned* w;
    mutable unsigned nx;
    __device__ __forceinline__ bool unit_of(unsigned k, Unit& u) const {
        if (k >= (unsigned)(4 * (hi - lo))) return false;
        const int rb = lo + (int)(k >> 2), j = (int)(k & 3u);
        const int e = __builtin_amdgcn_readfirstlane((int)__hip_atomic_load(blk_e + rb, __ATOMIC_RELAXED, __HIP_MEMORY_SCOPE_AGENT));
        u.pm = rb; u.pn = e * 4 + j; return true;
    }
    __device__ __forceinline__ bool first(Unit& u) const {
        if (threadIdx.x == 0) w[0] = __hip_atomic_fetch_add(ctr, 1u, __ATOMIC_RELAXED, __HIP_MEMORY_SCOPE_AGENT);
        __syncthreads(); const unsigned k = (unsigned)__builtin_amdgcn_readfirstlane((int)w[0]); return unit_of(k, u);
    }
    __device__ __forceinline__ void claim_issue() const { if (threadIdx.x == 0) nx = __hip_atomic_fetch_add(ctr, 1u, __ATOMIC_RELAXED, __HIP_MEMORY_SCOPE_AGENT); }
    __device__ __forceinline__ void publish(int i) const { if (threadIdx.x == 0) w[i & 1] = nx; }
    __device__ __forceinline__ bool read(int i, Unit& u) const { const unsigned k = (unsigned)__builtin_amdgcn_readfirstlane((int)w[i & 1]); return unit_of(k, u); }
    __device__ __forceinline__ void a_ready(const Unit& u) const {
        unsigned sp = 0u;
        while (__hip_atomic_load(donew + u.pm, __ATOMIC_RELAXED, __HIP_MEMORY_SCOPE_AGENT) < 32u) { __builtin_amdgcn_s_sleep(1); if (++sp > (1u << 22)) break; }
    }
    __device__ __forceinline__ void done(const Unit&) const {}
};
template <class Epi, class Sched, bool ALIGN_EPI = false, bool SP2 = false, bool GATHER = false>
__device__ __forceinline__ void gemm_phase(PG8_LAS unsigned char* lds, const Gemm g, const Sched& S, const Epi& E, PG8_LAS const int* rowtab = nullptr) {
    static_assert(!GATHER || SP2, "GATHER is wired into the SP2 loop only");
    int tid_ = threadIdx.x; asm volatile("" : "+v"(tid_));
    const int tid = tid_, wid = __builtin_amdgcn_readfirstlane(tid >> 6), lane = tid & 63, wr = wid >> 2, wc = wid & 3, fr = lane & 15, fq = lane >> 4;
    const int K = g.K, nt = K / BK;
    unsigned voffA[2], voffB[2];
#pragma unroll
    for (int i = 0; i < 2; ++i) { int R, C; stage_rc(tid * 16 + i * 8192, R, C); const int Rb = Epi::PERM ? ((R & ~31) + perm32(R & 31)) : R;
        voffA[i] = (unsigned)(R * K + C) * 2u; voffB[i] = (unsigned)(Rb * K + C) * 2u; }
    const size_t kstep = (size_t)(BK * 2);
    const size_t hstep = (size_t)HALF * K * 2;
    const size_t tstep = 2 * hstep;
    const unsigned ldsw = (unsigned)wid * 1024u;
    const int aoff = lds_byte(wr * 64 + fr, fq * 8), boff = lds_byte(wc * 32 + fr, fq * 8);
#define PG8_SA(b, h) (((b) * 2 + (h)) * HTB)
#define PG8_SB(b, h) ((4 + (b) * 2 + (h)) * HTB)
#define PG8_STAGE(bufoff, gbase, voff) do { _Pragma("unroll") for (int _i = 0; _i < 2; ++_i) \
        __builtin_amdgcn_global_load_lds((const unsigned*)((const char*)(gbase) + (voff)[_i]), (PG8_LAS unsigned*)(lds + (bufoff) + ldsw + _i * 8192), 16, 0, 0); } while (0)
#define PG8_LDA(dst, b, h) do { _Pragma("unroll") for (int m = 0; m < 4; ++m) _Pragma("unroll") for (int k = 0; k < 2; ++k) dst[m][k] = *(const PG8_LAS bf16x8*)(lds + PG8_SA(b, h) + aoff + m * 2048 + k * 1024); } while (0)
#define PG8_LDB(dst, b, h) do { _Pragma("unroll") for (int n = 0; n < 2; ++n) _Pragma("unroll") for (int k = 0; k < 2; ++k) dst[n][k] = *(const PG8_LAS bf16x8*)(lds + PG8_SB(b, h) + boff + n * 2048 + k * 1024); } while (0)
#define PG8_MMA(ai, bj, At, Bt) do { __builtin_amdgcn_s_setprio(1); _Pragma("unroll") for (int m = 0; m < 4; ++m) _Pragma("unroll") for (int n = 0; n < 2; ++n) _Pragma("unroll") for (int k = 0; k < 2; ++k) \
        acc[ai][bj][m][n] = __builtin_amdgcn_mfma_f32_16x16x32_bf16(Bt[n][k], At[m][k], acc[ai][bj][m][n], 0, 0, 0); __builtin_amdgcn_s_setprio(0); } while (0)
#define PG8_WAIT_V(n) asm volatile("s_waitcnt vmcnt(" #n ")" ::: "memory")
#define PG8_WAIT_L(n) asm volatile("s_waitcnt lgkmcnt(" #n ")" ::: "memory")
#define PG8_BAR __builtin_amdgcn_s_barrier()
#define PG8_SCHED __builtin_amdgcn_sched_barrier(0)
    Unit cur, nxt; int ui = 0;
    if constexpr (Sched::DYN) { static_assert(SP2 && !GATHER, "dynamic scheds: SP2 loop, plain A"); if (!S.first(cur)) return; } else { if (!S.next(0, cur)) return; }
    f32x4 acc[2][2][4][2];
#pragma unroll
    for (int a = 0; a < 2; ++a)
#pragma unroll
        for (int b = 0; b < 2; ++b)
#pragma unroll
            for (int m = 0; m < 4; ++m)
#pragma unroll
                for (int n = 0; n < 2; ++n) acc[a][b][m][n] = (f32x4){0.f, 0.f, 0.f, 0.f};
    bf16x8 At[4][2], B0[2][2], B1[2][2];
    const char* cA = GATHER ? (const char*)g.A : (const char*)g.A + (size_t)cur.pm * tstep; const char* cB = (const char*)g.Bt + (size_t)cur.pn * tstep;
    const size_t hstepA = GATHER ? 0 : hstep;
    unsigned gc[2][2], gn[2][2];
#define PG8_GLOAD(uidx, o) do { _Pragma("unroll") for (int _h = 0; _h < 2; ++_h) _Pragma("unroll") for (int _i = 0; _i < 2; ++_i) { int R_, C_; stage_rc(tid * 16 + _i * 8192, R_, C_); \
        o[_h][_i] = (unsigned)(rowtab[(uidx) * 256 + _h * HALF + R_] * K + C_) * 2u; } } while (0)
    if constexpr (GATHER) { PG8_GLOAD(0, gc); } else { gc[0][0] = gc[1][0] = voffA[0]; gc[0][1] = gc[1][1] = voffA[1]; }
#define PG8_ACUR(bufoff, half, kt) PG8_STAGE(bufoff, cA + (half) * hstepA + (size_t)(kt) * kstep, gc[half])
    S.a_ready(cur);
    if constexpr (SP2) {
        PG8_STAGE(PG8_SB(0, 0), cB, voffB); PG8_STAGE(PG8_SB(0, 1), cB + hstep, voffB); PG8_ACUR(PG8_SA(0, 0), 0, 0); PG8_ACUR(PG8_SA(0, 1), 1, 0);
        if (wr == 1) PG8_BAR;
        PG8_WAIT_V(2); PG8_BAR;
        PG8_STAGE(PG8_SB(1, 0), cB + kstep, voffB); PG8_ACUR(PG8_SA(1, 0), 0, 1); PG8_STAGE(PG8_SB(1, 1), cB + hstep + kstep, voffB);
        PG8_WAIT_V(6); PG8_BAR;
    } else {
        PG8_STAGE(PG8_SB(0, 0), cB, voffB); PG8_STAGE(PG8_SA(0, 0), cA, voffA); PG8_STAGE(PG8_SB(0, 1), cB + hstep, voffB); PG8_STAGE(PG8_SA(0, 1), cA + hstep, voffA);
        if (wr == 1) PG8_BAR;
        PG8_WAIT_V(4); PG8_BAR;
        PG8_STAGE(PG8_SB(1, 0), cB + kstep, voffB); PG8_STAGE(PG8_SA(1, 0), cA + kstep, voffA); PG8_STAGE(PG8_SB(1, 1), cB + hstep + kstep, voffB);
        PG8_WAIT_V(6); PG8_BAR;
    }
    for (;;) {
        bool has_next = false; if constexpr (Sched::DYN) { S.claim_issue(); } else { has_next = S.next(ui + 1, nxt); }
        const char* nA = GATHER ? cA : (has_next ? (const char*)g.A + (size_t)nxt.pm * tstep : cA); const char* nB = has_next ? (const char*)g.Bt + (size_t)nxt.pn * tstep : cB;
        if constexpr (GATHER) { if (has_next) { PG8_GLOAD(ui + 1, gn); } else { gn[0][0] = gc[0][0]; gn[0][1] = gc[0][1]; gn[1][0] = gc[1][0]; gn[1][1] = gc[1][1]; } }
        else { gn[0][0] = gc[0][0]; gn[0][1] = gc[0][1]; gn[1][0] = gc[1][0]; gn[1][1] = gc[1][1]; }
        for (int t = 0; t < nt; t += 2) {
            const bool last = (t == nt - 2);
            const char* a1 = cA + (size_t)(t + 1) * kstep;
            const char* a2; const char* b2; const char* a3; const char* b3; unsigned o2[2][2];
#define PG8_NEXTPTRS() do { a2 = last ? nA : cA + (size_t)(t + 2) * kstep; b2 = last ? nB : cB + (size_t)(t + 2) * kstep; a3 = a2 + kstep; b3 = b2 + kstep; \
            o2[0][0] = last ? gn[0][0] : gc[0][0]; o2[0][1] = last ? gn[0][1] : gc[0][1]; o2[1][0] = last ? gn[1][0] : gc[1][0]; o2[1][1] = last ? gn[1][1] : gc[1][1]; } while (0)
            if constexpr (!Sched::DYN) { PG8_NEXTPTRS(); if (last && has_next) S.a_ready(nxt); }
            else { if (last) S.publish(ui + 1); }
            if constexpr (SP2) {
            PG8_LDB(B0, 0, 0); PG8_LDB(B1, 0, 1); PG8_SCHED; PG8_LDA(At, 0, 0); PG8_STAGE(PG8_SA(1, 1), a1 + hstepA, gc[1]);
            PG8_WAIT_V(8); PG8_WAIT_L(0); PG8_BAR; PG8_MMA(0, 0, At, B0); PG8_MMA(0, 1, At, B1); PG8_BAR; PG8_SCHED;
            if constexpr (Sched::DYN) { if (last) { has_next = S.read(ui + 1, nxt); if (has_next) { S.a_ready(nxt); nA = (const char*)g.A + (size_t)nxt.pm * tstep; nB = (const char*)g.Bt + (size_t)nxt.pn * tstep; } } PG8_NEXTPTRS(); }
            PG8_LDA(At, 0, 1); PG8_STAGE(PG8_SB(0, 0), b2, voffB); PG8_STAGE(PG8_SB(0, 1), b2 + hstep, voffB); PG8_STAGE(PG8_SA(0, 0), a2, o2[0]);
            PG8_WAIT_V(8); PG8_WAIT_L(0); PG8_BAR; PG8_MMA(1, 0, At, B0); PG8_MMA(1, 1, At, B1); PG8_BAR; PG8_SCHED;
            PG8_LDB(B0, 1, 0); PG8_LDB(B1, 1, 1); PG8_SCHED; PG8_LDA(At, 1, 0); PG8_STAGE(PG8_SA(0, 1), a2 + hstepA, o2[1]);
            PG8_WAIT_V(8); PG8_WAIT_L(0); PG8_BAR; PG8_MMA(0, 0, At, B0); PG8_MMA(0, 1, At, B1); PG8_BAR; PG8_SCHED;
            PG8_LDA(At, 1, 1); PG8_STAGE(PG8_SB(1, 0), b3, voffB); PG8_STAGE(PG8_SB(1, 1), b3 + hstep, voffB); PG8_STAGE(PG8_SA(1, 0), a3, o2[0]);
            PG8_WAIT_V(8); PG8_WAIT_L(0); PG8_BAR; PG8_MMA(1, 0, At, B0); PG8_MMA(1, 1, At, B1); PG8_BAR; PG8_SCHED;
            } else {
            PG8_LDB(B0, 0, 0); PG8_SCHED; PG8_LDA(At, 0, 0); PG8_STAGE(PG8_SA(1, 1), a1 + hstep, voffA);
            PG8_WAIT_L(8); PG8_BAR; PG8_WAIT_L(0); PG8_MMA(0, 0, At, B0); PG8_BAR; PG8_SCHED;
            PG8_LDB(B1, 0, 1); PG8_STAGE(PG8_SB(0, 0), b2, voffB);
            PG8_BAR; PG8_WAIT_L(0); PG8_MMA(0, 1, At, B1); PG8_BAR;
            PG8_LDA(At, 0, 1); PG8_STAGE(PG8_SA(0, 0), a2, voffA);
            PG8_BAR; PG8_WAIT_L(0); PG8_MMA(1, 0, At, B0); PG8_BAR; PG8_SCHED;
            PG8_STAGE(PG8_SB(0, 1), b2 + hstep, voffB);
            PG8_WAIT_V(6); PG8_BAR; PG8_MMA(1, 1, At, B1); PG8_BAR;
            PG8_LDB(B0, 1, 0); PG8_SCHED; PG8_LDA(At, 1, 0); PG8_STAGE(PG8_SA(0, 1), a2 + hstep, voffA);
            PG8_WAIT_L(8); PG8_BAR; PG8_WAIT_L(0); PG8_MMA(0, 0, At, B0); PG8_BAR; PG8_SCHED;
            PG8_LDB(B1, 1, 1); PG8_STAGE(PG8_SB(1, 0), b3, voffB);
            PG8_BAR; PG8_WAIT_L(0); PG8_MMA(0, 1, At, B1); PG8_BAR;
            PG8_LDA(At, 1, 1); PG8_STAGE(PG8_SA(1, 0), a3, voffA);
            PG8_BAR; PG8_WAIT_L(0); PG8_MMA(1, 0, At, B0); PG8_BAR; PG8_SCHED;
            PG8_STAGE(PG8_SB(1, 1), b3 + hstep, voffB);
            PG8_WAIT_V(6); PG8_BAR; PG8_MMA(1, 1, At, B1); PG8_BAR;
            }
        }
        if constexpr (ALIGN_EPI) { if (wr == 0) PG8_BAR; }
        if constexpr (!Epi::AFTER_DRAIN) { E(acc, cur, wr, wc, fr, fq); S.done(cur); }
        if (!has_next) break;
#pragma unroll
        for (int a = 0; a < 2; ++a)
#pragma unroll
            for (int b = 0; b < 2; ++b)
#pragma unroll
                for (int m = 0; m < 4; ++m)
#pragma unroll
                    for (int n = 0; n < 2; ++n) acc[a][b][m][n] = (f32x4){0.f, 0.f, 0.f, 0.f};
        cur = nxt; cA = nA; cB = nB; ++ui; gc[0][0] = gn[0][0]; gc[0][1] = gn[0][1]; gc[1][0] = gn[1][0]; gc[1][1] = gn[1][1];
        if constexpr (ALIGN_EPI) { if (wr == 1) PG8_BAR; }
    }
    PG8_WAIT_V(0);
    if constexpr (!ALIGN_EPI) { if (wr == 0) PG8_BAR; }
    PG8_BAR;
    if constexpr (Epi::AFTER_DRAIN) { E.fused(acc, cur, wr, wc, fr, fq, lds, wid, lane); S.done(cur); }
#undef PG8_SA
#undef PG8_SB
#undef PG8_STAGE
#undef PG8_GLOAD
#undef PG8_ACUR
#undef PG8_LDA
#undef PG8_LDB
#undef PG8_MMA
#undef PG8_WAIT_V
#undef PG8_WAIT_L
#undef PG8_BAR
#undef PG8_SCHED
#undef PG8_NEXTPTRS
}
}

#ifndef PG8_SP2
#define PG8_SP2 true
#endif
#ifndef PG8_ALIGN
#define PG8_ALIGN true
#endif
#include <hip/hip_bf16.h>
#include <cmath>
namespace attn_body {
using bf16=__hip_bfloat16;
using bf16x8=__attribute__((ext_vector_type(8)))short;
using s16x4=__attribute__((ext_vector_type(4)))short;
using f32x16=__attribute__((ext_vector_type(16)))float;
using u32x4=__attribute__((ext_vector_type(4)))unsigned;
constexpr int D=64,PQ=2304,PO=1024,WIN=128;
constexpr int NW=8,QBLK=32,QB=QBLK*NW,KVBLK=64;
constexpr int ATTN_UNIT_ROWS=QB;
__device__ __forceinline__ int crow(int r,int hi){return (r&3)+8*(r>>2)+4*hi;}
#define SBAR() __builtin_amdgcn_sched_barrier(0)
template<int MODE> __device__ __forceinline__ void cmask(f32x16&p0,f32x16&p1,int jb,int qrel,int hi){
  const float NEG=-INFINITY; int kb=64*jb+4*hi;
  #pragma unroll
  for(int r=0;r<16;++r){int kv=kb+(r&3)+8*(r>>2);
    if(MODE==1){ if((unsigned)(qrel-kv)>=(unsigned)WIN)p0[r]=NEG; if((unsigned)(qrel-kv-32)>=(unsigned)WIN)p1[r]=NEG; }
    else { if(kv>qrel)p0[r]=NEG; if(kv+32>qrel)p1[r]=NEG; } }
}

constexpr int NSLOT=3, SLOTB=8192;
constexpr int LDS_K=0, LDS_V=NSLOT*SLOTB, LDS_WS=2*NSLOT*SLOTB, LDS_OST=LDS_WS+NW*64*4, LDS_BYTES=LDS_OST+NW*4096;
constexpr float C2=0.125f*1.4426950408889634f;
__device__ __forceinline__ void glds16(const void*gsrc,unsigned lds_dst){unsigned keep;
  asm volatile("s_mov_b32 %0, m0\n\ts_mov_b32 m0, %2\n\ts_nop 0\n\tglobal_load_lds_dwordx4 %1, off\n\ts_mov_b32 m0, %0":"=&s"(keep):"v"(gsrc),"s"(lds_dst):"memory");}
__device__ __forceinline__ float max3f(float a,float b,float c){float r;asm("v_max3_f32 %0, %1, %2, %3":"=v"(r):"v"(a),"v"(b),"v"(c));return r;}
__device__ __forceinline__ float max2f(float a,float b){float r;asm("v_max_f32_e32 %0, %1, %2":"=v"(r):"v"(a),"v"(b));return r;}
__device__ __forceinline__ float fadd_s(float a,float b){float r;asm("v_add_f32_e32 %0, %1, %2":"=v"(r):"v"(a),"v"(b));return r;}
__device__ __forceinline__ float fsub_s(float a,float b){float r;asm("v_sub_f32_e32 %0, %1, %2":"=v"(r):"v"(a),"v"(b));return r;}
typedef float f32x2_t __attribute__((ext_vector_type(2))); typedef __bf16 bf16x2_t __attribute__((ext_vector_type(2)));
__device__ __forceinline__ unsigned cvtpk_s(float lo,float hi){f32x2_t v={lo,hi};bf16x2_t b=__builtin_convertvector(v,bf16x2_t);return __builtin_bit_cast(unsigned,b);}
#define WAIT_BAR(N) asm volatile("s_waitcnt vmcnt(" #N ") lgkmcnt(0)\n\ts_barrier":::"memory")

__device__ __forceinline__ void qkt(f32x16&p0,f32x16&p1,const char*Kslot,const bf16x8*qr,const f32x16&negm,int r32,int hi){
  const char*kb=Kslot+hi*1024+r32*16;
  #pragma unroll
  for(int d0=0;d0<4;++d0){
    const bf16x8 b0=*reinterpret_cast<const bf16x8*>(kb+d0*2048);
    const bf16x8 b1=*reinterpret_cast<const bf16x8*>(kb+d0*2048+512);
    if(d0==0){p0=__builtin_amdgcn_mfma_f32_32x32x16_bf16(b0,qr[0],negm,0,0,0);p1=__builtin_amdgcn_mfma_f32_32x32x16_bf16(b1,qr[0],negm,0,0,0);}
    else{p0=__builtin_amdgcn_mfma_f32_32x32x16_bf16(b0,qr[d0],p0,0,0,0);p1=__builtin_amdgcn_mfma_f32_32x32x16_bf16(b1,qr[d0],p1,0,0,0);}}
}
typedef __attribute__((address_space(3))) const char* lds_cptr;
typedef short v4i16_t __attribute__((ext_vector_type(4)));
__device__ __forceinline__ void kload8(bf16x8*kf,lds_cptr kp){
  kf[0]=*(const __attribute__((address_space(3))) bf16x8*)(kp);      kf[1]=*(const __attribute__((address_space(3))) bf16x8*)(kp+512);
  kf[2]=*(const __attribute__((address_space(3))) bf16x8*)(kp+2048); kf[3]=*(const __attribute__((address_space(3))) bf16x8*)(kp+2560);
  kf[4]=*(const __attribute__((address_space(3))) bf16x8*)(kp+4096); kf[5]=*(const __attribute__((address_space(3))) bf16x8*)(kp+4608);
  kf[6]=*(const __attribute__((address_space(3))) bf16x8*)(kp+6144); kf[7]=*(const __attribute__((address_space(3))) bf16x8*)(kp+6656);
}
__device__ __forceinline__ void kload2(bf16x8*kf,lds_cptr kp,int j){ kf[2*j]=*(const __attribute__((address_space(3))) bf16x8*)(kp+j*2048); kf[2*j+1]=*(const __attribute__((address_space(3))) bf16x8*)(kp+j*2048+512); }
__device__ __forceinline__ s16x4 vtr(lds_cptr p){ return __builtin_bit_cast(s16x4,__builtin_amdgcn_ds_read_tr16_b64_v4i16((__attribute__((address_space(3))) v4i16_t*)p)); }
__device__ __forceinline__ float rowmax(const f32x16&p0,const f32x16&p1){
  float a=max3f(p0[0],p0[1],p1[0]),b=max3f(p0[2],p0[3],p1[1]);a=max3f(a,p1[2],p1[3]);
  #pragma unroll
  for(int r=4;r<16;r+=4){a=max3f(a,p0[r],p0[r+1]);b=max3f(b,p0[r+2],p0[r+3]);a=max3f(a,p1[r],p1[r+1]);b=max3f(b,p1[r+2],p1[r+3]);}
  const float m=max2f(a,b);
  auto rr=__builtin_amdgcn_permlane32_swap(__float_as_uint(m),__float_as_uint(m),false,false);
  return max2f(__uint_as_float(rr[0]),__uint_as_float(rr[1]));
}
__device__ __forceinline__ void pv(f32x16*o,int vb,bf16x8 pa0,bf16x8 pa1,bf16x8 pa2,bf16x8 pa3){
  #pragma unroll
  for(int d0=0;d0<2;++d0){s16x4 lo[4],hi[4];
    #pragma unroll
    for(int ks=0;ks<4;++ks){
      asm volatile("ds_read_b64_tr_b16 %0,%1 offset:%c2":"=&v"(lo[ks]):"v"(vb),"i"(d0*4096+ks*1024):"memory");
      asm volatile("ds_read_b64_tr_b16 %0,%1 offset:%c2":"=&v"(hi[ks]):"v"(vb),"i"(d0*4096+ks*1024+512):"memory");}
    asm volatile("s_waitcnt lgkmcnt(0)":::"memory");SBAR();
    #define PK(k) (bf16x8){lo[k][0],lo[k][1],lo[k][2],lo[k][3],hi[k][0],hi[k][1],hi[k][2],hi[k][3]}
    o[d0]=__builtin_amdgcn_mfma_f32_32x32x16_bf16(pa0,PK(0),o[d0],0,0,0);
    o[d0]=__builtin_amdgcn_mfma_f32_32x32x16_bf16(pa1,PK(1),o[d0],0,0,0);
    o[d0]=__builtin_amdgcn_mfma_f32_32x32x16_bf16(pa2,PK(2),o[d0],0,0,0);
    o[d0]=__builtin_amdgcn_mfma_f32_32x32x16_bf16(pa3,PK(3),o[d0],0,0,0);
    #undef PK
  }
}

#ifndef ATTN_STORE16
#define ATTN_STORE16(p,v) (*(u32x4*)(p)=(v))
#endif
template<int MODE,int THRL> __device__ __forceinline__ void attn_unit(const bf16*Qh,const bf16*__restrict__ Kh,const bf16*__restrict__ Vh,bf16*Oh,int q0,int kt0,const int NT,float sink2,char*shm){
  int tid_=threadIdx.x; asm volatile("":"+v"(tid_)); const int tid=tid_,lane=tid&63,r32=lane&31,hi=lane>>5; const int wid=__builtin_amdgcn_readfirstlane(tid>>6);
  const bf16*Qw=Qh+(long)(q0+wid*QBLK)*PQ;
  const unsigned lds0=(unsigned)(uintptr_t)shm;
  float*wsf=(float*)(shm+LDS_WS)+wid*64;
  const bf16*ksrc=Kh+(long)(kt0*KVBLK+lane)*PQ+wid*8;
  const bf16*vsrc=Vh+(long)(kt0*KVBLK+16*(wid&3)+(lane>>2))*PQ+(wid>>2)*32+(lane&3)*8;
  const unsigned kdst=lds0+LDS_K+wid*1024, vdst=lds0+LDS_V+wid*1024;
  #define DMA_K(t,slot) glds16(ksrc+(long)(t)*KVBLK*PQ,(unsigned)__builtin_amdgcn_readfirstlane(kdst+(slot)))
  #define DMA_V(t,slot) glds16(vsrc+(long)(t)*KVBLK*PQ,(unsigned)__builtin_amdgcn_readfirstlane(vdst+(slot)))
  const int vb0=(int)(lds0+LDS_V)+((lane>>4)&1)*32+(lane&3)*8+(4*hi+((lane&15)>>2))*64;
  const char*Kbase=shm+LDS_K; bf16x8 kf[8];
  const lds_cptr shm3=(lds_cptr)shm; const lds_cptr kp0=shm3+LDS_K+hi*1024+r32*16; const lds_cptr vp0=shm3+LDS_V+((lane>>4)&1)*32+(lane&3)*8+(4*hi+((lane&15)>>2))*64;
  DMA_K(0,0);DMA_V(0,0);DMA_K(1,SLOTB);
  bf16x8 qr[4];
  #pragma unroll
  for(int d0=0;d0<4;++d0)qr[d0]=*reinterpret_cast<const bf16x8*>(&Qw[(long)r32*PQ+d0*16+hi*8]);
  float mhat=0.f,l_reg=0.f;f32x16 o[2];o[0]=f32x16{};o[1]=f32x16{};f32x16 negm=f32x16{};asm volatile("":"+v"(negm));
  const int qrel=wid*QBLK+r32;
  #define CMASK(P0,P1,t) do{int jb_=(t)-(NT-4); if(MODE==1||jb_>=0)cmask<MODE>(P0,P1,jb_,qrel,hi);}while(0)
  bool resc=false;
  #define START(P0,P1) do{ const float rm=rowmax(P0,P1); resc=false; \
    { const float dl=(MODE==1)?__builtin_fmaxf(rm,-60.f):rm; mhat=fadd_s(mhat,dl); \
      _Pragma("unroll") for(int r=0;r<16;++r){P0[r]=fsub_s(P0[r],dl);P1[r]=fsub_s(P1[r],dl);} \
      _Pragma("unroll") for(int r=0;r<16;++r)negm[r]=-mhat; asm volatile("":"+v"(negm)); } \
    _Pragma("unroll") for(int r=0;r<16;++r)P0[r]=__builtin_amdgcn_exp2f(P0[r]); }while(0)
  #define RESC() do{ if(resc){ asm volatile("s_waitcnt lgkmcnt(0)":::"memory"); \
      _Pragma("unroll") for(int d_=0;d_<2;++d_) _Pragma("unroll") for(int r=0;r<16;++r)o[d_][r]*=wsf[crow(r,hi)]; } }while(0)
  f32x16 pA0,pA1,pB0,pB1;
  int sl_prev=0,sl_cur=0,sl_next=SLOTB;
  #define ROT() do{sl_prev=sl_cur;sl_cur=sl_next;sl_next=(sl_next==(NSLOT-1)*SLOTB)?0:sl_next+SLOTB;}while(0)
  DMA_K(2,2*SLOTB);
  WAIT_BAR(3);
  qkt(pA0,pA1,Kbase,qr,negm,r32,hi);asm volatile("s_nop 15\n\ts_nop 7":"+v"(pA0),"+v"(pA1));CMASK(pA0,pA1,0);
  START(pA0,pA1);
  _Pragma("unroll") for(int r=0;r<16;++r)pA1[r]=__builtin_amdgcn_exp2f(pA1[r]);
  WAIT_BAR(0);
  DMA_K(3,0);DMA_V(1,SLOTB);
  ROT();
  kload8(kf,kp0+sl_cur);
  WAIT_BAR(2);
  s16x4 vlo[8],vhi[8]; u32x4 pw0,pw1,pw2,pw3;
  #define PKW(P,B) cvtpk_s(P[B],P[B+1])
  #define PAF(k) __builtin_bit_cast(bf16x8,pw##k)
  #define VFR(i) (bf16x8){vlo[i][0],vlo[i][1],vlo[i][2],vlo[i][3],vhi[i][0],vhi[i][1],vhi[i][2],vhi[i][3]}
  #define PIN(x) asm volatile("":"+v"(x))
  #define MX3(a,b,c) __builtin_fmaxf(__builtin_fmaxf((a),(b)),(c))
  #define GAPA(MF,A0,A1,A2,A3,W0,W1,PW) do{ MF; sacc+=A0; sacc+=A1; sacc+=A2; sacc+=A3; PIN(sacc); W0; W1; PIN(PW); SBAR(); }while(0)
  #define EX(v) __builtin_amdgcn_exp2f(v)
  #define GAPB(MF,X,B) do{ MF; X[B]=EX(X[B]); X[B+1]=EX(X[B+1]); X[B+2]=EX(X[B+2]); X[B+3]=EX(X[B+3]); PIN(X); SBAR(); }while(0)
  #define VRD(i) do{ vlo[i]=vtr(vp_+(((i)>>2)*4096+((i)&3)*1024)); vhi[i]=vtr(vp_+(((i)>>2)*4096+((i)&3)*1024+512)); }while(0)
  #define KRD(G,j) do{ if(G){ kload2(kf,kp0+sl_next,j); SBAR(); } }while(0)
  #define STEP(C0,C1,P0,P1,t,GK,GV,GL) do{ SBAR(); \
    const lds_cptr vp_=vp0+sl_prev; \
    VRD(0); SBAR(); float sacc=(P0[0]+P0[1]); \
    GAPA(C0=__builtin_amdgcn_mfma_f32_32x32x16_bf16(kf[0],qr[0],negm,0,0,0), P0[2],P0[3],P0[4],P0[5],     pw0[0]=PKW(P0,0), pw0[1]=PKW(P0,2), pw0); \
    VRD(4); SBAR(); GAPA(C1=__builtin_amdgcn_mfma_f32_32x32x16_bf16(kf[1],qr[0],negm,0,0,0), P0[6],P0[7],P0[8],P0[9],     pw0[2]=PKW(P0,4), pw0[3]=PKW(P0,6), pw0); \
    VRD(1); SBAR(); GAPA(C0=__builtin_amdgcn_mfma_f32_32x32x16_bf16(kf[2],qr[1],C0,0,0,0),   P0[10],P0[11],P0[12],P0[13], pw1[0]=PKW(P0,8), pw1[1]=PKW(P0,10), pw1); \
    VRD(5); SBAR(); GAPA(C1=__builtin_amdgcn_mfma_f32_32x32x16_bf16(kf[3],qr[1],C1,0,0,0),   P0[14],P0[15],P1[0],P1[1],   pw1[2]=PKW(P0,12),pw1[3]=PKW(P0,14), pw1); \
    VRD(2); SBAR(); GAPA(C0=__builtin_amdgcn_mfma_f32_32x32x16_bf16(kf[4],qr[2],C0,0,0,0),   P1[2],P1[3],P1[4],P1[5],     pw2[0]=PKW(P1,0), pw2[1]=PKW(P1,2), pw2); \
    VRD(6); SBAR(); GAPA(C1=__builtin_amdgcn_mfma_f32_32x32x16_bf16(kf[5],qr[2],C1,0,0,0),   P1[6],P1[7],P1[8],P1[9],     pw2[2]=PKW(P1,4), pw2[3]=PKW(P1,6), pw2); \
    VRD(3); SBAR(); GAPA(C0=__builtin_amdgcn_mfma_f32_32x32x16_bf16(kf[6],qr[3],C0,0,0,0),   P1[10],P1[11],P1[12],P1[13], pw3[0]=PKW(P1,8), pw3[1]=PKW(P1,10), pw3); \
    VRD(7); SBAR(); GAPA(C1=__builtin_amdgcn_mfma_f32_32x32x16_bf16(kf[7],qr[3],C1,0,0,0),   P1[14],P1[15],0.f,0.f,       pw3[2]=PKW(P1,12),pw3[3]=PKW(P1,14), pw3); \
    l_reg+=sacc; \
    if(GK){DMA_K((t)+3,sl_cur);} if(GV){DMA_V((t)+1,sl_next);} \
    CMASK(C0,C1,t); \
    { float a=MX3(C0[0],C0[1],C1[0]),b=MX3(C0[2],C0[3],C1[1]); a=MX3(a,C1[2],C1[3]); \
      _Pragma("unroll") for(int r=4;r<16;r+=4){a=MX3(a,C0[r],C0[r+1]);b=MX3(b,C0[r+2],C0[r+3]);a=MX3(a,C1[r],C1[r+1]);b=MX3(b,C1[r+2],C1[r+3]);} \
      float rm=__builtin_fmaxf(a,b); { auto rr=__builtin_amdgcn_permlane32_swap(__float_as_uint(rm),__float_as_uint(rm),false,false); rm=__builtin_fmaxf(__uint_as_float(rr[0]),__uint_as_float(rr[1])); } \
      resc=false; \
      if(__builtin_expect(__any(rm>(float)THRL),0)){ const float dl=__builtin_fmaxf(rm,0.f); mhat+=dl; \
        _Pragma("unroll") for(int r=0;r<16;++r){C0[r]-=dl;C1[r]-=dl;} \
        _Pragma("unroll") for(int r=0;r<16;++r)negm[r]=-mhat; asm volatile("":"+v"(negm)); \
        const float f=__builtin_amdgcn_exp2f(-dl); l_reg*=f; if(hi==0)wsf[r32]=f; resc=true; } } \
    SBAR(); \
    GAPB(o[0]=__builtin_amdgcn_mfma_f32_32x32x16_bf16(PAF(0),VFR(0),o[0],0,0,0), C0,0); \
    GAPB(o[1]=__builtin_amdgcn_mfma_f32_32x32x16_bf16(PAF(0),VFR(4),o[1],0,0,0), C0,4); \
    KRD(GL,0); GAPB(o[0]=__builtin_amdgcn_mfma_f32_32x32x16_bf16(PAF(1),VFR(1),o[0],0,0,0), C0,8); \
    KRD(GL,1); GAPB(o[1]=__builtin_amdgcn_mfma_f32_32x32x16_bf16(PAF(1),VFR(5),o[1],0,0,0), C0,12); \
    KRD(GL,2); GAPB(o[0]=__builtin_amdgcn_mfma_f32_32x32x16_bf16(PAF(2),VFR(2),o[0],0,0,0), C1,0); \
    KRD(GL,3); GAPB(o[1]=__builtin_amdgcn_mfma_f32_32x32x16_bf16(PAF(2),VFR(6),o[1],0,0,0), C1,4); \
    GAPB(o[0]=__builtin_amdgcn_mfma_f32_32x32x16_bf16(PAF(3),VFR(3),o[0],0,0,0), C1,8); \
    GAPB(o[1]=__builtin_amdgcn_mfma_f32_32x32x16_bf16(PAF(3),VFR(7),o[1],0,0,0), C1,12); \
    }while(0)
  int t=1;
  #undef CMASK
  #define CMASK(P0,P1,t) do{}while(0)
  for(;t+5<NT;t+=2){
    STEP(pB0,pB1,pA0,pA1,t,true,true,true);     WAIT_BAR(2); RESC(); ROT();
    STEP(pA0,pA1,pB0,pB1,t+1,true,true,true);   WAIT_BAR(2); RESC(); ROT();
  }
  #undef CMASK
  #define CMASK(P0,P1,t) do{int jb_=(t)-(NT-4); if(MODE==1||jb_>=0)cmask<MODE>(P0,P1,jb_,qrel,hi);}while(0)
  #define ENDW(tt) do{ if((tt)+3<NT){WAIT_BAR(2);} else if((tt)+2<NT){WAIT_BAR(1);} else {WAIT_BAR(0);} }while(0)
  for(;t+1<NT;t+=2){
    STEP(pB0,pB1,pA0,pA1,t,(t+3<NT),(t+1<NT),(t+1<NT));       ENDW(t);   RESC(); ROT();
    STEP(pA0,pA1,pB0,pB1,t+1,(t+4<NT),(t+2<NT),(t+2<NT));     ENDW(t+1); RESC(); ROT();
  }
  STEP(pB0,pB1,pA0,pA1,NT-1,false,false,false); RESC();
  { float sacc=pB0[0]+pB0[1]; _Pragma("unroll") for(int r=2;r<16;++r)sacc+=pB0[r]; _Pragma("unroll") for(int r=0;r<16;++r)sacc+=pB1[r]; l_reg+=sacc;
    pw0=(u32x4){PKW(pB0,0),PKW(pB0,2),PKW(pB0,4),PKW(pB0,6)};pw1=(u32x4){PKW(pB0,8),PKW(pB0,10),PKW(pB0,12),PKW(pB0,14)};pw2=(u32x4){PKW(pB1,0),PKW(pB1,2),PKW(pB1,4),PKW(pB1,6)};pw3=(u32x4){PKW(pB1,8),PKW(pB1,10),PKW(pB1,12),PKW(pB1,14)};
    SBAR(); pv(o,vb0+sl_cur,PAF(0),PAF(1),PAF(2),PAF(3)); }
  #undef PKW
  #undef PAF
  #undef VFR
  #undef PIN
  #undef MX3
  #undef GAPA
  #undef GAPB
  #undef EX
  #undef VRD
  #undef KRD
  #undef STEP
  #undef ENDW
  {auto rr=__builtin_amdgcn_permlane32_swap(__float_as_uint(l_reg),__float_as_uint(l_reg),false,false);l_reg=__uint_as_float(rr[0])+__uint_as_float(rr[1]);}
  if(MODE==1)l_reg+=__builtin_amdgcn_exp2f(sink2-mhat);
  if(hi==0)wsf[32+r32]=l_reg;asm volatile("s_waitcnt lgkmcnt(0)":::"memory");
  float rli[16];
  #pragma unroll
  for(int r=0;r<16;++r)rli[r]=__builtin_amdgcn_rcpf(wsf[32+crow(r,hi)]);
  bf16*Ow=Oh+(long)(q0+wid*QBLK)*PO;
  { bf16*stg=(bf16*)(shm+LDS_OST)+wid*2048;
    #pragma unroll
    for(int r=0;r<16;++r){const int orow=crow(r,hi);
      #pragma unroll
      for(int d0=0;d0<2;++d0)stg[orow*64+d0*32+r32]=__float2bfloat16(o[d0][r]*rli[r]);}
    asm volatile("s_waitcnt lgkmcnt(0)":::"memory");
    #pragma unroll
    for(int i=0;i<4;++i){const int row=i*8+(lane>>3),ch=lane&7; const u32x4 v=*(const u32x4*)(stg+row*64+ch*8); ATTN_STORE16(Ow+(long)row*PO+ch*8,v);} }
  asm volatile("s_waitcnt lgkmcnt(0)\n\ts_barrier":::"memory");
  #undef DMA_K
  #undef DMA_V
  #undef CMASK
  #undef START
  #undef RESC
  #undef ROT
}
constexpr int ATTN_LDS_BYTES=LDS_BYTES;

constexpr int SW_K=0, SW_V=6*8192, SW_WS=12*8192, SW_ST=SW_WS+2048, SWA_LDS_BYTES=SW_ST+NW*2048;
template<int ABL=0> __device__ __forceinline__ void swa_unit(const bf16*Qb,const bf16*__restrict__ Kh,const bf16*__restrict__ Vh,bf16*Ob,const unsigned*kmx,int q0,const float*sink2v,char*shm){
  int tid_=threadIdx.x; asm volatile("":"+v"(tid_)); const int tid=tid_,lane=tid&63,r32=lane&31,hi=lane>>5; const int wid=__builtin_amdgcn_readfirstlane(tid>>6);
  const unsigned lds0=(unsigned)(uintptr_t)shm;
  const int nt=(q0==0)?4:6, kt0=q0/KVBLK-(nt-4);
  const bf16*ksrc=Kh+(long)(kt0*KVBLK+lane)*PQ+wid*8;
  const bf16*vsrc=Vh+(long)(kt0*KVBLK+16*(wid&3)+(lane>>2))*PQ+(wid>>2)*32+(lane&3)*8;
  for(int ti=0;ti<nt;++ti){
    glds16(ksrc+(long)ti*KVBLK*PQ,(unsigned)__builtin_amdgcn_readfirstlane(lds0+SW_K+ti*8192+wid*1024));
    glds16(vsrc+(long)ti*KVBLK*PQ,(unsigned)__builtin_amdgcn_readfirstlane(lds0+SW_V+ti*8192+wid*1024)); }
  const bf16*Qw=Qb+(long)(q0+wid*QBLK+r32)*PQ+hi*8;
  bf16x8 qa[4],qb[4];
  #pragma unroll
  for(int d0=0;d0<4;++d0){qa[d0]=*reinterpret_cast<const bf16x8*>(Qw+d0*16);qb[d0]=*reinterpret_cast<const bf16x8*>(Qw+D+d0*16);}
  float kb2=0.f;
  #pragma unroll
  for(int g_=0;g_<8;++g_)kb2+=__uint_as_float(kmx[g_]);
  asm volatile("s_waitcnt vmcnt(0) lgkmcnt(0)\n\ts_barrier":::"memory");
  float*wsf=(float*)(shm+SW_WS)+wid*64;
  const u32x4 a1w=(u32x4){hi==0?0x3F803F80u:0u,0u,0u,0u};
  const int kb0=8*(q0>>8)+wid-4;
  const lds_cptr shm3=(lds_cptr)shm;
  const lds_cptr kpl=shm3+SW_K+hi*1024+r32*16;
  const lds_cptr vpl=shm3+SW_V+((lane>>4)&1)*32+(lane&3)*8+(4*hi+((lane&15)>>2))*64;
  #pragma unroll
  for(int g=0;g<4;g+=2){
    float mA,mB; f32x16 cbA,cbB;
    { float qsA=0.f,qsB=0.f;
      #pragma unroll
      for(int d0=0;d0<4;++d0){ const u32x4 va=__builtin_bit_cast(u32x4,qa[d0]),vb_=__builtin_bit_cast(u32x4,qb[d0]);
        #pragma unroll
        for(int e_=0;e_<4;++e_){ const float a_=__uint_as_float(va[e_]<<16),c_=__uint_as_float(va[e_]&0xffff0000u),d_=__uint_as_float(vb_[e_]<<16),f_=__uint_as_float(vb_[e_]&0xffff0000u); qsA+=a_*a_+c_*c_; qsB+=d_*d_+f_*f_; } }
      { auto rr=__builtin_amdgcn_permlane32_swap(__float_as_uint(qsA),__float_as_uint(qsA),false,false); qsA=__uint_as_float(rr[0])+__uint_as_float(rr[1]); }
      { auto rr=__builtin_amdgcn_permlane32_swap(__float_as_uint(qsB),__float_as_uint(qsB),false,false); qsB=__uint_as_float(rr[0])+__uint_as_float(rr[1]); }
      mA=sqrtf(qsA*kb2)*1.01f+1e-3f-64.f; mB=sqrtf(qsB*kb2)*1.01f+1e-3f-64.f;
      u32x4 bw=(u32x4){0u,0u,0u,0u};
      { const float nm_=-mA; const unsigned h_=cvtpk_s(nm_,0.f)&0xffffu; const float r_=nm_-__uint_as_float(h_<<16); const unsigned l_=cvtpk_s(r_,0.f)&0xffffu; bw[0]=(hi==0)?(h_|(l_<<16)):0u; }
      cbA=__builtin_amdgcn_mfma_f32_32x32x16_bf16(__builtin_bit_cast(bf16x8,a1w),__builtin_bit_cast(bf16x8,bw),f32x16{},0,0,0);
      { const float nm_=-mB; const unsigned h_=cvtpk_s(nm_,0.f)&0xffffu; const float r_=nm_-__uint_as_float(h_<<16); const unsigned l_=cvtpk_s(r_,0.f)&0xffffu; bw[0]=(hi==0)?(h_|(l_<<16)):0u; }
      cbB=__builtin_amdgcn_mfma_f32_32x32x16_bf16(__builtin_bit_cast(bf16x8,a1w),__builtin_bit_cast(bf16x8,bw),f32x16{},0,0,0); }
    float lA=0.f,lB=0.f; f32x16 oA[2],oB[2]; oA[0]=f32x16{};oA[1]=f32x16{};oB[0]=f32x16{};oB[1]=f32x16{};
    for(int j=0;j<5;++j){ const int kb=kb0+j; if(kb<0)continue; if(ABL==1)continue;
      const int ti=(kb>>1)-kt0, half=kb&1;
      f32x16 sA=cbA,sB=cbB;
      { const lds_cptr kp=kpl+ti*8192+half*512;
        #pragma unroll
        for(int d0=0;d0<4;++d0){ const bf16x8 kf=*(const __attribute__((address_space(3))) bf16x8*)(kp+d0*2048);
          sA=__builtin_amdgcn_mfma_f32_32x32x16_bf16(kf,qa[d0],sA,0,0,0); sB=__builtin_amdgcn_mfma_f32_32x32x16_bf16(kf,qb[d0],sB,0,0,0); } }
      if(j==0){
        #pragma unroll
        for(int r=0;r<16;++r){ const int i_=(r&3)+8*(r>>2)+4*hi; if(i_<=r32){sA[r]=-INFINITY;sB[r]=-INFINITY;} } }
      if(j==4){
        #pragma unroll
        for(int r=0;r<16;++r){ const int i_=(r&3)+8*(r>>2)+4*hi; if(i_>r32){sA[r]=-INFINITY;sB[r]=-INFINITY;} } }
      #pragma unroll
      for(int r=0;r<16;++r){ sA[r]=__builtin_amdgcn_exp2f(sA[r]); sB[r]=__builtin_amdgcn_exp2f(sB[r]); lA+=sA[r]; lB+=sB[r]; }
      u32x4 pa[2],pb[2];
      #pragma unroll
      for(int k=0;k<2;++k){
        pa[k]=(u32x4){cvtpk_s(sA[8*k],sA[8*k+1]),cvtpk_s(sA[8*k+2],sA[8*k+3]),cvtpk_s(sA[8*k+4],sA[8*k+5]),cvtpk_s(sA[8*k+6],sA[8*k+7])};
        pb[k]=(u32x4){cvtpk_s(sB[8*k],sB[8*k+1]),cvtpk_s(sB[8*k+2],sB[8*k+3]),cvtpk_s(sB[8*k+4],sB[8*k+5]),cvtpk_s(sB[8*k+6],sB[8*k+7])}; }
      { const lds_cptr vp=vpl+ti*8192+half*2048;
        #pragma unroll
        for(int d0=0;d0<2;++d0)
          #pragma unroll
          for(int k=0;k<2;++k){ const s16x4 lo=vtr(vp+d0*4096+k*1024), hh=vtr(vp+d0*4096+k*1024+512);
            const bf16x8 vf=(bf16x8){lo[0],lo[1],lo[2],lo[3],hh[0],hh[1],hh[2],hh[3]};
            oA[d0]=__builtin_amdgcn_mfma_f32_32x32x16_bf16(__builtin_bit_cast(bf16x8,pa[k]),vf,oA[d0],0,0,0);
            oB[d0]=__builtin_amdgcn_mfma_f32_32x32x16_bf16(__builtin_bit_cast(bf16x8,pb[k]),vf,oB[d0],0,0,0); } }
    }
    if(g==0){
      #pragma unroll
      for(int d0=0;d0<4;++d0){qa[d0]=*reinterpret_cast<const bf16x8*>(Qw+2*D+d0*16);qb[d0]=*reinterpret_cast<const bf16x8*>(Qw+3*D+d0*16);} }
    #pragma unroll
    for(int hsel=0;hsel<2;++hsel){
      float l=hsel?lB:lA; const float m=hsel?mB:mA; const f32x16*o=hsel?oB:oA;
      {auto rr=__builtin_amdgcn_permlane32_swap(__float_as_uint(l),__float_as_uint(l),false,false);l=__uint_as_float(rr[0])+__uint_as_float(rr[1]);}
      l+=__builtin_amdgcn_exp2f(sink2v[g+hsel]-m);
      if(hi==0)wsf[32+r32]=l; asm volatile("s_waitcnt lgkmcnt(0)":::"memory");
      float rli[16];
      #pragma unroll
      for(int r=0;r<16;++r)rli[r]=__builtin_amdgcn_rcpf(wsf[32+crow(r,hi)]);
      bf16*Ow=Ob+(long)(q0+wid*QBLK)*PO+(g+hsel)*D;
      bf16*stg=(bf16*)(shm+SW_ST)+wid*1024;
      #pragma unroll
      for(int d0=0;d0<2;++d0){
        #pragma unroll
        for(int r=0;r<16;++r)stg[crow(r,hi)*32+r32]=__float2bfloat16(o[d0][r]*rli[r]);
        asm volatile("s_waitcnt lgkmcnt(0)":::"memory");
        #pragma unroll
        for(int i=0;i<2;++i){const int row=i*16+(lane>>2),ch=lane&3; const u32x4 v=*(const u32x4*)(stg+row*32+ch*8); ATTN_STORE16(Ow+(long)row*PO+d0*32+ch*8,v);}
        asm volatile("s_waitcnt lgkmcnt(0)":::"memory");
      }
    }
  }
  asm volatile("s_waitcnt lgkmcnt(0)\n\ts_barrier":::"memory");
}

constexpr int W_SLK=8192, W_SLV=16384, W_LDS_K=0, W_LDS_V=NSLOT*W_SLK, W_LDS_WS=W_LDS_V+NSLOT*W_SLV, W_LDS_OST=W_LDS_WS+NW*64*4, W_LDS_BYTES=W_LDS_OST+NW*4096;
template<int THRL> __device__ __forceinline__ void attn_unit_w(const bf16*Qh,const bf16*__restrict__ Kh,const bf16*__restrict__ Vh,bf16*Oh,const unsigned*kmx,int q0,const int NT,char*shm){
  int tid_=threadIdx.x; asm volatile("":"+v"(tid_)); const int tid=tid_,lane=tid&63,r32=lane&31,hi=lane>>5; const int wid=__builtin_amdgcn_readfirstlane(tid>>6);
  const bf16*Qw=Qh+(long)(q0+wid*QBLK)*PQ;
  const unsigned lds0=(unsigned)(uintptr_t)shm;
  float*wsf=(float*)(shm+W_LDS_WS)+wid*64;
  const bf16*ksrc=Kh+(long)lane*PQ+wid*8;
  const bf16*vsrc=Vh+(long)(16*(wid&3)+(lane>>2))*PQ+(wid>>2)*32+(lane&3)*8;
  const unsigned kdst=lds0+W_LDS_K+wid*1024, vdst=lds0+W_LDS_V+wid*1024;
  #define DMA_K(t,slot) glds16(ksrc+(long)(t)*KVBLK*PQ,(unsigned)__builtin_amdgcn_readfirstlane(kdst+(slot)))
  #define DMA_V(t,slot) do{ glds16(vsrc+(long)(t)*KVBLK*PQ,(unsigned)__builtin_amdgcn_readfirstlane(vdst+2*(slot))); glds16(vsrc+64+(long)(t)*KVBLK*PQ,(unsigned)__builtin_amdgcn_readfirstlane(vdst+2*(slot)+8192)); }while(0)
  const char*Kbase=shm+W_LDS_K; bf16x8 kf[8];
  const lds_cptr shm3=(lds_cptr)shm; const lds_cptr kp0=shm3+W_LDS_K+hi*1024+r32*16; const lds_cptr vp0=shm3+W_LDS_V+((lane>>4)&1)*32+(lane&3)*8+(4*hi+((lane&15)>>2))*64;
  const int vb0=(int)(lds0+W_LDS_V)+((lane>>4)&1)*32+(lane&3)*8+(4*hi+((lane&15)>>2))*64;
  DMA_K(0,0);DMA_V(0,0);DMA_K(1,W_SLK);
  bf16x8 qr[4];
  #pragma unroll
  for(int d0=0;d0<4;++d0)qr[d0]=*reinterpret_cast<const bf16x8*>(&Qw[(long)r32*PQ+d0*16+hi*8]);
  float mhat=0.f,l_reg=0.f;f32x16 o[4];o[0]=f32x16{};o[1]=f32x16{};o[2]=f32x16{};o[3]=f32x16{};const f32x16 zacc=f32x16{};
  const u32x4 a1w=(u32x4){hi==0?0x3F803F80u:0u,0u,0u,0u}; u32x4 bmw=(u32x4){0u,0u,0u,0u}; f32x16 cb;
  #define SETBM() do{ const float nm_=-mhat; const unsigned h_=cvtpk_s(nm_,0.f)&0xffffu; const float r_=nm_-__uint_as_float(h_<<16); const unsigned l_=cvtpk_s(r_,0.f)&0xffffu; bmw[0]=(hi==0)?(h_|(l_<<16)):0u; }while(0)
  #define BIASMF() __builtin_amdgcn_mfma_f32_32x32x16_bf16(__builtin_bit_cast(bf16x8,a1w),__builtin_bit_cast(bf16x8,bmw),zacc,0,0,0)
  const int qrel=wid*QBLK+r32;
  { float kb2=0.f; _Pragma("unroll") for(int g=0;g<8;++g)kb2+=__uint_as_float(kmx[g]);
    float qs=0.f; _Pragma("unroll") for(int d0=0;d0<4;++d0){ const u32x4 qv=__builtin_bit_cast(u32x4,qr[d0]); _Pragma("unroll") for(int e_=0;e_<4;++e_){ const float a_=__uint_as_float(qv[e_]<<16),b_=__uint_as_float(qv[e_]&0xffff0000u); qs+=a_*a_+b_*b_; } }
    { auto rr=__builtin_amdgcn_permlane32_swap(__float_as_uint(qs),__float_as_uint(qs),false,false); qs=__uint_as_float(rr[0])+__uint_as_float(rr[1]); }
    mhat=sqrtf(qs*kb2)*1.01f+1e-3f-64.f; }
  SETBM(); cb=BIASMF();
  #define CMASK(P0,P1,t) do{int jb_=(t)-(NT-4); if(jb_>=0)cmask<0>(P0,P1,jb_,qrel,hi);}while(0)
  #define START(P0,P1) do{ _Pragma("unroll") for(int r=0;r<16;++r)P0[r]=__builtin_amdgcn_exp2f(P0[r]); }while(0)
  f32x16 pA0,pA1,pB0,pB1;
  int sl_prev=0,sl_cur=0,sl_next=W_SLK;
  #define ROT() do{sl_prev=sl_cur;sl_cur=sl_next;sl_next=(sl_next==(NSLOT-1)*W_SLK)?0:sl_next+W_SLK;}while(0)
  DMA_K(2,2*W_SLK);
  WAIT_BAR(4);
  qkt(pA0,pA1,Kbase,qr,cb,r32,hi);asm volatile("s_nop 15\n\ts_nop 7":"+v"(pA0),"+v"(pA1));CMASK(pA0,pA1,0);
  START(pA0,pA1);
  _Pragma("unroll") for(int r=0;r<16;++r)pA1[r]=__builtin_amdgcn_exp2f(pA1[r]);
  WAIT_BAR(0);
  DMA_K(3,0);DMA_V(1,W_SLK);
  ROT();
  kload8(kf,kp0+sl_cur);
  WAIT_BAR(3);
  s16x4 vlo[4],vhi[4]; u32x4 pw0,pw1,pw2,pw3;
  #define PKW(P,B) cvtpk_s(P[B],P[B+1])
  #define PAF(k) __builtin_bit_cast(bf16x8,pw##k)
  #define VFR(i) (bf16x8){vlo[i][0],vlo[i][1],vlo[i][2],vlo[i][3],vhi[i][0],vhi[i][1],vhi[i][2],vhi[i][3]}
  #define PIN(x) asm volatile("":"+v"(x))
  #define MX3(a,b,c) __builtin_fmaxf(__builtin_fmaxf((a),(b)),(c))
  #define GAPA(MF,A0,A1,A2,A3,W0,W1,PW) do{ MF; sacc+=A0; sacc+=A1; sacc+=A2; sacc+=A3; PIN(sacc); W0; W1; PIN(PW); SBAR(); }while(0)
  #define EX(v) __builtin_amdgcn_exp2f(v)
  #define GAPB(MF,X,B) do{ MF; X[B]=EX(X[B]); X[B+1]=EX(X[B+1]); PIN(X); SBAR(); }while(0)
  #define VRD(j) do{ vlo[(j)&3]=vtr(vp_+(((j)&3)*4096+((j)>>2)*1024)); vhi[(j)&3]=vtr(vp_+(((j)&3)*4096+((j)>>2)*1024+512)); SBAR(); }while(0)
  #define KRD(G,j) do{ if(G){ kload2(kf,kp0+sl_next,j); SBAR(); } }while(0)
  #define STEP(C0,C1,P0,P1,t,GK,GV,GL) do{ SBAR(); \
    const lds_cptr vp_=vp0+2*sl_prev; \
    float sacc=(P0[0]+P0[1]); \
    GAPA(C0=__builtin_amdgcn_mfma_f32_32x32x16_bf16(kf[0],qr[0],cb,0,0,0), P0[2],P0[3],P0[4],P0[5],     pw0[0]=PKW(P0,0), pw0[1]=PKW(P0,2), pw0); \
    GAPA(C1=__builtin_amdgcn_mfma_f32_32x32x16_bf16(kf[1],qr[0],cb,0,0,0), P0[6],P0[7],P0[8],P0[9],     pw0[2]=PKW(P0,4), pw0[3]=PKW(P0,6), pw0); \
    GAPA(C0=__builtin_amdgcn_mfma_f32_32x32x16_bf16(kf[2],qr[1],C0,0,0,0),   P0[10],P0[11],P0[12],P0[13], pw1[0]=PKW(P0,8), pw1[1]=PKW(P0,10), pw1); \
    GAPA(C1=__builtin_amdgcn_mfma_f32_32x32x16_bf16(kf[3],qr[1],C1,0,0,0),   P0[14],P0[15],P1[0],P1[1],   pw1[2]=PKW(P0,12),pw1[3]=PKW(P0,14), pw1); \
    GAPA(C0=__builtin_amdgcn_mfma_f32_32x32x16_bf16(kf[4],qr[2],C0,0,0,0),   P1[2],P1[3],P1[4],P1[5],     pw2[0]=PKW(P1,0), pw2[1]=PKW(P1,2), pw2); \
    VRD(0); GAPA(C1=__builtin_amdgcn_mfma_f32_32x32x16_bf16(kf[5],qr[2],C1,0,0,0),   P1[6],P1[7],P1[8],P1[9],     pw2[2]=PKW(P1,4), pw2[3]=PKW(P1,6), pw2); \
    VRD(1); GAPA(C0=__builtin_amdgcn_mfma_f32_32x32x16_bf16(kf[6],qr[3],C0,0,0,0),   P1[10],P1[11],P1[12],P1[13], pw3[0]=PKW(P1,8), pw3[1]=PKW(P1,10), pw3); \
    VRD(2); GAPA(C1=__builtin_amdgcn_mfma_f32_32x32x16_bf16(kf[7],qr[3],C1,0,0,0),   P1[14],P1[15],0.f,0.f,       pw3[2]=PKW(P1,12),pw3[3]=PKW(P1,14), pw3); \
    l_reg+=sacc; \
    if(GK){DMA_K((t)+3,sl_cur);} if(GV){DMA_V((t)+1,sl_next);} \
    CMASK(C0,C1,t); \
    SBAR(); \
    VRD(3); do{ o[0]=__builtin_amdgcn_mfma_f32_32x32x16_bf16(PAF(0),VFR(0),o[0],0,0,0); C0[0]=EX(C0[0]); C0[1]=EX(C0[1]); PIN(C0); SBAR(); }while(0); \
    VRD(4); do{ o[1]=__builtin_amdgcn_mfma_f32_32x32x16_bf16(PAF(0),VFR(1),o[1],0,0,0); C0[2]=EX(C0[2]); C0[3]=EX(C0[3]); PIN(C0); SBAR(); }while(0); \
    VRD(5); do{ o[2]=__builtin_amdgcn_mfma_f32_32x32x16_bf16(PAF(0),VFR(2),o[2],0,0,0); C0[4]=EX(C0[4]); C0[5]=EX(C0[5]); PIN(C0); SBAR(); }while(0); \
    VRD(6); do{ o[3]=__builtin_amdgcn_mfma_f32_32x32x16_bf16(PAF(0),VFR(3),o[3],0,0,0); C0[6]=EX(C0[6]); C0[7]=EX(C0[7]); PIN(C0); SBAR(); }while(0); \
    VRD(7); do{ o[0]=__builtin_amdgcn_mfma_f32_32x32x16_bf16(PAF(1),VFR(0),o[0],0,0,0); C0[8]=EX(C0[8]); C0[9]=EX(C0[9]); PIN(C0); SBAR(); }while(0); \
    VRD(8); do{ o[1]=__builtin_amdgcn_mfma_f32_32x32x16_bf16(PAF(1),VFR(1),o[1],0,0,0); C0[10]=EX(C0[10]); C0[11]=EX(C0[11]); PIN(C0); SBAR(); }while(0); \
    VRD(9); do{ o[2]=__builtin_amdgcn_mfma_f32_32x32x16_bf16(PAF(1),VFR(2),o[2],0,0,0); C0[12]=EX(C0[12]); C0[13]=EX(C0[13]); PIN(C0); SBAR(); }while(0); \
    VRD(10); do{ o[3]=__builtin_amdgcn_mfma_f32_32x32x16_bf16(PAF(1),VFR(3),o[3],0,0,0); C0[14]=EX(C0[14]); C0[15]=EX(C0[15]); PIN(C0); SBAR(); }while(0); \
    VRD(11); KRD(GL,0); do{ o[0]=__builtin_amdgcn_mfma_f32_32x32x16_bf16(PAF(2),VFR(0),o[0],0,0,0); C1[0]=EX(C1[0]); C1[1]=EX(C1[1]); PIN(C1); SBAR(); }while(0); \
    VRD(12); do{ o[1]=__builtin_amdgcn_mfma_f32_32x32x16_bf16(PAF(2),VFR(1),o[1],0,0,0); C1[2]=EX(C1[2]); C1[3]=EX(C1[3]); PIN(C1); SBAR(); }while(0); \
    VRD(13); KRD(GL,1); do{ o[2]=__builtin_amdgcn_mfma_f32_32x32x16_bf16(PAF(2),VFR(2),o[2],0,0,0); C1[4]=EX(C1[4]); C1[5]=EX(C1[5]); PIN(C1); SBAR(); }while(0); \
    VRD(14); do{ o[3]=__builtin_amdgcn_mfma_f32_32x32x16_bf16(PAF(2),VFR(3),o[3],0,0,0); C1[6]=EX(C1[6]); C1[7]=EX(C1[7]); PIN(C1); SBAR(); }while(0); \
    VRD(15); KRD(GL,2); do{ o[0]=__builtin_amdgcn_mfma_f32_32x32x16_bf16(PAF(3),VFR(0),o[0],0,0,0); C1[8]=EX(C1[8]); C1[9]=EX(C1[9]); PIN(C1); SBAR(); }while(0); \
    do{ o[1]=__builtin_amdgcn_mfma_f32_32x32x16_bf16(PAF(3),VFR(1),o[1],0,0,0); C1[10]=EX(C1[10]); C1[11]=EX(C1[11]); PIN(C1); SBAR(); }while(0); \
    KRD(GL,3); do{ o[2]=__builtin_amdgcn_mfma_f32_32x32x16_bf16(PAF(3),VFR(2),o[2],0,0,0); C1[12]=EX(C1[12]); C1[13]=EX(C1[13]); PIN(C1); SBAR(); }while(0); \
    do{ o[3]=__builtin_amdgcn_mfma_f32_32x32x16_bf16(PAF(3),VFR(3),o[3],0,0,0); C1[14]=EX(C1[14]); C1[15]=EX(C1[15]); PIN(C1); SBAR(); }while(0); \
    }while(0)
  int t=1;
  #undef CMASK
  #define CMASK(P0,P1,t) do{}while(0)
  for(;t+5<NT;t+=2){
    STEP(pB0,pB1,pA0,pA1,t,true,true,true);     WAIT_BAR(3); ROT();
    STEP(pA0,pA1,pB0,pB1,t+1,true,true,true);   WAIT_BAR(3); ROT();
  }
  #undef CMASK
  #define CMASK(P0,P1,t) do{int jb_=(t)-(NT-4); if(jb_>=0)cmask<0>(P0,P1,jb_,qrel,hi);}while(0)
  #define ENDW(tt) do{ if((tt)+3<NT){WAIT_BAR(3);} else if((tt)+2<NT){WAIT_BAR(2);} else {WAIT_BAR(0);} }while(0)
  for(;t+1<NT;t+=2){
    STEP(pB0,pB1,pA0,pA1,t,(t+3<NT),(t+1<NT),(t+1<NT));       ENDW(t);   ROT();
    STEP(pA0,pA1,pB0,pB1,t+1,(t+4<NT),(t+2<NT),(t+2<NT));     ENDW(t+1); ROT();
  }
  STEP(pB0,pB1,pA0,pA1,NT-1,false,false,false);
  { float sacc=pB0[0]+pB0[1]; _Pragma("unroll") for(int r=2;r<16;++r)sacc+=pB0[r]; _Pragma("unroll") for(int r=0;r<16;++r)sacc+=pB1[r]; l_reg+=sacc;
    pw0=(u32x4){PKW(pB0,0),PKW(pB0,2),PKW(pB0,4),PKW(pB0,6)};pw1=(u32x4){PKW(pB0,8),PKW(pB0,10),PKW(pB0,12),PKW(pB0,14)};pw2=(u32x4){PKW(pB1,0),PKW(pB1,2),PKW(pB1,4),PKW(pB1,6)};pw3=(u32x4){PKW(pB1,8),PKW(pB1,10),PKW(pB1,12),PKW(pB1,14)};
    SBAR(); pv(o,vb0+2*sl_cur,PAF(0),PAF(1),PAF(2),PAF(3)); pv(o+2,vb0+2*sl_cur+8192,PAF(0),PAF(1),PAF(2),PAF(3)); }
  #undef PKW
  #undef PAF
  #undef VFR
  #undef PIN
  #undef MX3
  #undef GAPA
  #undef GAPB
  #undef EX
  #undef VRD
  #undef KRD
  #undef STEP
  #undef ENDW
  {auto rr=__builtin_amdgcn_permlane32_swap(__float_as_uint(l_reg),__float_as_uint(l_reg),false,false);l_reg=__uint_as_float(rr[0])+__uint_as_float(rr[1]);}
  if(hi==0)wsf[32+r32]=l_reg;asm volatile("s_waitcnt lgkmcnt(0)":::"memory");
  float rli[16];
  #pragma unroll
  for(int r=0;r<16;++r)rli[r]=__builtin_amdgcn_rcpf(wsf[32+crow(r,hi)]);
  bf16*Ow=Oh+(long)(q0+wid*QBLK)*PO;
  { bf16*stg=(bf16*)(shm+W_LDS_OST)+wid*2048;
    #pragma unroll
    for(int hf=0;hf<2;++hf){
      #pragma unroll
      for(int r=0;r<16;++r){const int orow=crow(r,hi);
        #pragma unroll
        for(int d0=0;d0<2;++d0)stg[orow*64+d0*32+r32]=__float2bfloat16(o[2*hf+d0][r]*rli[r]);}
      asm volatile("s_waitcnt lgkmcnt(0)":::"memory");
      #pragma unroll
      for(int i=0;i<4;++i){const int row=i*8+(lane>>3),ch=lane&7; const u32x4 v=*(const u32x4*)(stg+row*64+ch*8); ATTN_STORE16(Ow+(long)row*PO+hf*64+ch*8,v);}
      asm volatile("s_waitcnt lgkmcnt(0)":::"memory");
    } }
  asm volatile("s_waitcnt lgkmcnt(0)\n\ts_barrier":::"memory");
  #undef DMA_K
  #undef DMA_V
  #undef CMASK
  #undef START
  #undef ROT
  #undef SETBM
  #undef BIASMF
}
#undef SBAR
#undef WAIT_BAR
}
constexpr int NWAVES = 8;
constexpr int BATCH = 2, SEQ = 16384, D = 1024, T = BATCH * SEQ;
constexpr int IN_COLS = 2304, NEXP = 32, FF = 512, NASSIGN = 2 * T, NCHUNK = 256, CHUNK_TOK = T / NCHUNK;
constexpr int PSLOTS = (NASSIGN / 256 + NEXP) * 256;
constexpr int NBLK_MAX = PSLOTS / 256;
constexpr float RMS_EPS = 1e-6f;
static_assert(CHUNK_TOK == 128 && SEQ == pg8::SEQ_LEN && IN_COLS == pg8::QKV_LD, "shapes");
constexpr size_t MiB = 1u << 20;
constexpr size_t WS_CTL = 0, CTL_ZERO_BYTES = 1 * MiB;
constexpr size_t WS_WR = 1 * MiB;
constexpr size_t WS_TOK = WS_WR + 256 * 1024;
constexpr size_t WS_ROPE = 4 * MiB;
constexpr size_t WS_WIN = 8 * MiB;
constexpr size_t WS_WO = 13 * MiB;
constexpr size_t WS_WGU = 16 * MiB;
constexpr size_t WS_WD = 80 * MiB;
constexpr size_t WS_A = 112 * MiB;
constexpr size_t WS_MIX = 176 * MiB;
constexpr size_t WS_QKV = 240 * MiB;
constexpr size_t WS_HM = 384 * MiB;
constexpr size_t WS_END = 456 * MiB;
static_assert(WS_TOK + (size_t)(T * 2 * 4) * 2 + T * 4 + NCHUNK * 32 * 4 + 288 * 4 + (size_t)PSLOTS * 16 <= WS_ROPE, "routing tables");
static_assert(WS_WIN + (size_t)IN_COLS * D * 2 <= WS_WO && WS_WO + (size_t)D * D * 2 <= WS_WGU && WS_WGU + (size_t)NEXP * 1024 * D * 2 <= WS_WD && WS_WD + (size_t)NEXP * D * FF * 2 <= WS_A, "weights");
static_assert(WS_A + (size_t)T * D * 2 <= WS_MIX && WS_MIX + (size_t)T * D * 2 <= WS_QKV && WS_QKV + (size_t)T * IN_COLS * 2 <= WS_HM && WS_QKV + (size_t)PSLOTS * D * 2 <= WS_HM && WS_HM + (size_t)PSLOTS * FF * 2 <= WS_END, "activations");
static_assert(WS_MIX + (size_t)NASSIGN * D * 2 <= WS_HM, "Y (P5b-P6) overlays MIX and the head of XS, both dead after P5a; HB stays live in WS_A until P6");
constexpr int CW_KMAX = 128;
constexpr int CW_SWAQ = 80;
constexpr int CW_RANK = 100;
constexpr int CW_BQ = 400;
constexpr int CW_DONE = 512;
constexpr int CW_NBU = 64;
constexpr int CW_BAR = 4096;
constexpr int RING_OFF = 0, RING_BYTES = 131072;
constexpr int LDSCTL_OFF = RING_BYTES, MISC_OFF = LDSCTL_OFF + 320;
constexpr int LDS_BYTES = 147456;
constexpr int ROWTAB_OFF = MISC_OFF + 128, ROWTAB_UNITS = 6;
static_assert(ROWTAB_OFF + ROWTAB_UNITS * 1024 <= LDS_BYTES, "LDS map");
#define GAS __attribute__((address_space(1)))
#define LAS __attribute__((address_space(3)))
typedef unsigned short bf16;
typedef unsigned v4u __attribute__((ext_vector_type(4)));
typedef float f32x4 __attribute__((ext_vector_type(4)));
typedef short bf16x8 __attribute__((ext_vector_type(8)));
typedef GAS unsigned gu32;
typedef GAS unsigned long long gu64;
#define RLX_AGENT __ATOMIC_RELAXED, __HIP_MEMORY_SCOPE_AGENT
#define LDS_WAIT() asm volatile("s_waitcnt lgkmcnt(0)" ::: "memory")
#define VM_WAIT() asm volatile("s_waitcnt vmcnt(0)" ::: "memory")
__device__ __forceinline__ unsigned long long rt() { return __builtin_amdgcn_s_memrealtime(); }
__device__ __forceinline__ unsigned f2bf(float f) { unsigned u = __builtin_bit_cast(unsigned, f); return (u + 0x7fffu + ((u >> 16) & 1u)) >> 16; }
__device__ __forceinline__ unsigned pk2(float lo, float hi) { return f2bf(lo) | (f2bf(hi) << 16); }

#define XB_TMO      128
#define XB_XCNT(j)  (256  + 64 * (j))
#define XB_XSUB(j)  (1280 + 64 * (j))
#define XB_XGEN(j)  (2304 + 64 * (j))
#define XB_TOP      3328
#define XB_TOPGEN   3392
#define XCD_BAR_WORDS 3456
#define XB_SPIN_CAP (1u << 18)

__device__ __forceinline__ unsigned xb_ld(unsigned* p)              { return __hip_atomic_load(p, __ATOMIC_RELAXED, __HIP_MEMORY_SCOPE_AGENT); }
__device__ __forceinline__ unsigned xb_add(unsigned* p, unsigned v) { return __hip_atomic_fetch_add(p, v, __ATOMIC_RELAXED, __HIP_MEMORY_SCOPE_AGENT); }
__device__ __forceinline__ unsigned xb_xcc_id() { return (unsigned)__builtin_amdgcn_s_getreg((3 << 11) | 20) & 0xFu; }
#define XB_SPIN(cond, bar) do { unsigned _sp = 0; while (cond) { __builtin_amdgcn_s_sleep(1); \
    if ((++_sp & 255u) == 0u) { if (xb_ld(&(bar)[XB_TMO])) break; if (_sp > XB_SPIN_CAP) { atomicAdd(&(bar)[XB_TMO], 1u); break; } } } } while (0)

struct XcdBarrier {
    unsigned* bar; unsigned x;
    volatile LAS unsigned* st;
};

__device__ __forceinline__ XcdBarrier xcd_barrier_post(unsigned* bar, volatile LAS unsigned* st) {
    XcdBarrier b; b.bar = bar; b.x = xb_xcc_id(); b.st = st;
    if (threadIdx.x == 0) (void)xb_add(&bar[XB_XCNT(b.x)], 1u);
    return b;
}
__device__ __forceinline__ void xcd_barrier_complete(unsigned* bar, unsigned x, unsigned& nloc, unsigned& nx) {
    const unsigned G = gridDim.x * gridDim.y * gridDim.z;
    unsigned sum, cnt, mine, sp = 0u;
    for (;;) {
        sum = 0u; cnt = 0u; mine = 0u;
#pragma unroll
        for (unsigned j = 0; j < 16; ++j) { const unsigned c = xb_ld(&bar[XB_XCNT(j)]); sum += c; cnt += (c > 0u) ? 1u : 0u; mine = (j == x) ? c : mine; }
        if (sum == G) break;
        __builtin_amdgcn_s_sleep(1);
        if ((++sp & 255u) == 0u) { if (xb_ld(&bar[XB_TMO])) break; if (sp > XB_SPIN_CAP) { atomicAdd(&bar[XB_TMO], 1u); break; } }
    }
    nloc = mine > 0u ? mine : 1u; nx = cnt > 0u ? cnt : 1u;
}

__device__ __forceinline__ void xcd_barrier(const XcdBarrier& b) {
    asm volatile("s_waitcnt vmcnt(0)" ::: "memory");
    __syncthreads();
    if (threadIdx.x == 0) {
        unsigned* bar = b.bar;
        __builtin_amdgcn_s_waitcnt(0);
        unsigned nloc = b.st[0], nx = b.st[1];
        if (nloc == 0u) { xcd_barrier_complete(bar, b.x, nloc, nx); b.st[0] = nloc; b.st[1] = nx; }
        const unsigned old = xb_add(&bar[XB_XSUB(b.x)], 1u);
        const unsigned gen = old / nloc;
        if (old + 1u == (gen + 1u) * nloc) {
            __builtin_amdgcn_fence(__ATOMIC_RELEASE, "agent");
            asm volatile("s_waitcnt vmcnt(0)" ::: "memory");
            const unsigned og = xb_add(&bar[XB_TOP], 1u);
            const unsigned tg = og / nx;
            if (og + 1u == (tg + 1u) * nx) xb_add(&bar[XB_TOPGEN], 1u);
            else XB_SPIN(xb_ld(&bar[XB_TOPGEN]) == tg, bar);
            __builtin_amdgcn_fence(__ATOMIC_ACQUIRE, "agent");
            xb_add(&bar[XB_XGEN(b.x)], 1u);
            asm volatile("s_waitcnt vmcnt(0)" ::: "memory");
        } else {
            XB_SPIN(xb_ld(&bar[XB_XGEN(b.x)]) == gen, bar);
            __builtin_amdgcn_fence(__ATOMIC_ACQUIRE, "agent");
            asm volatile("s_waitcnt vmcnt(0)" ::: "memory");
        }
    }
    __syncthreads();
}
struct Frame {
    LAS unsigned char* lds;
    volatile LAS unsigned* MISC;
    gu32* ctl;
    int tid, lane, wave;
    int vcu, G;
    const float* x; float* out;
    const float *g1, *w_in, *lq1, *lk1, *lq2, *lk2, *subg, *sinks, *w_out, *g2, *w_rg, *b_rg, *w_re, *b_re, *w_gate, *w_up, *w_down, *gf;
    bf16 *Win_t, *Wo_t, *Wgu_t, *Wd_t;
    bf16 *XN, *OD, *HB, *Y, *MIX, *QKV, *XS, *HM;
    float *Wr, *rope;
    int* tok_e; float* tok_g; float* tok_rstd; int* cnt; unsigned* blk_e; int* slot_dst; float* slot_gate; float* slot_rstd; int* slot_tok;
};
__device__ __forceinline__ float wave_sum(float v) {
#pragma unroll
    for (int o = 1; o < 64; o <<= 1) v += __shfl_xor(v, o);
    return v;
}
__device__ __forceinline__ void tr_item(const float* W, int ldn, int k0, int sc, const float* ksc, bf16* WT, int Kd, int drow0, LAS float* scr, int lane) {
#pragma unroll 8
    for (int i = 0; i < 32; ++i) { const int kk = 2 * i + (lane >> 5); float v = W[(size_t)(k0 + kk) * ldn + sc]; if (ksc) v *= ksc[k0 + kk]; scr[kk * 33 + (lane & 31)] = v; }
    LDS_WAIT(); asm volatile("" ::: "memory");
    const int c = lane & 7;
#pragma unroll
    for (int j = 0; j < 4; ++j) { const int n = (lane >> 3) + 8 * j; const LAS float* s = scr + (8 * c) * 33 + n;
        v4u o; o.x = pk2(s[0 * 33], s[1 * 33]); o.y = pk2(s[2 * 33], s[3 * 33]); o.z = pk2(s[4 * 33], s[5 * 33]); o.w = pk2(s[6 * 33], s[7 * 33]);
        *(GAS v4u*)(WT + (size_t)(drow0 + n) * Kd + k0 + 8 * c) = o; }
    LDS_WAIT(); asm volatile("" ::: "memory");
}
__device__ __forceinline__ void tr_item_w(const float* W, int ldn, int k0, int n0, const float* ksc, bf16* WT, int Kd, int drow0, LAS float* scr, int lane) {
    const int r = lane >> 3, c4 = (lane & 7) * 4;
    f32x4 v[8];
#pragma unroll
    for (int i = 0; i < 8; ++i) v[i] = *(const GAS f32x4*)(W + (size_t)(k0 + 8 * i + r) * ldn + n0 + c4);
    if (ksc) {
#pragma unroll
        for (int i = 0; i < 8; ++i) v[i] = v[i] * ksc[k0 + 8 * i + r]; }
#pragma unroll
    for (int i = 0; i < 8; ++i) { LAS float* d = scr + (8 * i + r) * 33 + c4; d[0] = v[i].x; d[1] = v[i].y; d[2] = v[i].z; d[3] = v[i].w; }
    LDS_WAIT(); asm volatile("" ::: "memory");
    const int c = lane & 7;
#pragma unroll
    for (int j = 0; j < 4; ++j) { const int n = (lane >> 3) + 8 * j; const LAS float* s = scr + (8 * c) * 33 + n;
        v4u o; o.x = pk2(s[0 * 33], s[1 * 33]); o.y = pk2(s[2 * 33], s[3 * 33]); o.z = pk2(s[4 * 33], s[5 * 33]); o.w = pk2(s[6 * 33], s[7 * 33]);
        *(GAS v4u*)(WT + (size_t)(drow0 + n) * Kd + k0 + 8 * c) = o; }
    LDS_WAIT(); asm volatile("" ::: "memory");
}
__device__ __forceinline__ int win_src_col(int n) {
    const bool isrope = (n < 1024) || (n >= 1536 && n < 2176);
    if (!isrope) return n;
    const int j = n & 63; return (n & ~63) + (j >> 1) + 32 * (j & 1);
}
constexpr int I_IN = (IN_COLS / 32) * (D / 64), I_O = (D / 32) * (D / 64), I_GU = NEXP * (1024 / 32) * (D / 64), I_D = NEXP * (D / 32) * (FF / 64), I_MOE = I_GU + I_D;
constexpr int MOE_TAIL_ITEMS = 4096;
__device__ __forceinline__ void moe_weight_items(Frame& F, int lo, int hi, int w, int nw) {
    LAS float* scr = (LAS float*)(F.lds + RING_OFF + F.wave * 16384);
    int lane_ = F.lane; asm volatile("" : "+v"(lane_)); const int lane = lane_;
    for (int it = lo + w; it < hi; it += nw) {
        int r = it;
        if (r < I_GU) { const int e = r / 512, q = r % 512, nb = q % 32, kb = q / 32;
            const float* src = (((nb >> 2) & 1) ? F.w_up : F.w_gate) + (size_t)e * D * FF; const int f0 = (nb >> 3) * 128 + (nb & 3) * 32;
            tr_item_w(src, FF, 64 * kb, f0, F.g2, F.Wgu_t + (size_t)e * 1024 * D, D, 32 * nb, scr, lane); continue; } r -= I_GU;
        { const int e = r / 256, q = r % 256, nb = q % 32, kb = q / 32;
            tr_item_w(F.w_down + (size_t)e * FF * D, D, 64 * kb, 32 * nb, nullptr, F.Wd_t + (size_t)e * D * FF, FF, 32 * nb, scr, lane); }
    }
}
__device__ __forceinline__ void p0_prologue(Frame& F) {
    LAS float* scr = (LAS float*)(F.lds + RING_OFF + F.wave * 16384);
    int lane_ = F.lane; asm volatile("" : "+v"(lane_)); const int gw = F.vcu * NWAVES + F.wave, NGW = F.G * NWAVES, lane = lane_;
    for (int it = gw; it < I_IN + I_O; it += NGW) {
        int r = it;
        if (r < I_IN) { const int nb = r % (IN_COLS / 32), kb = r / (IN_COLS / 32); tr_item(F.w_in, IN_COLS, 64 * kb, win_src_col(32 * nb + (lane & 31)), nullptr, F.Win_t, D, 32 * nb, scr, lane); continue; } r -= I_IN;
        { const int nb = r % (D / 32), kb = r / (D / 32); tr_item_w(F.w_out, D, 64 * kb, 32 * nb, nullptr, F.Wo_t, D, 32 * nb, scr, lane); }
    }
    if (F.G != 256) moe_weight_items(F, 0, I_MOE, gw, NGW);
    for (int i = (gw * 64 + lane); i < 3 * 8 * 4 * 64; i += NGW * 64) { const int ln = i & 63, q = (i >> 6) & 3, S = (i >> 8) & 7, blk = i >> 11, j = 16 * blk + (ln & 15), k0 = 128 * S + 32 * (ln >> 4) + 8 * q;
        unsigned hi[8], lo[8];
#pragma unroll
        for (int e = 0; e < 8; ++e) { const int k = k0 + e; const float w = j < 4 ? F.g2[k] * F.w_rg[k * 4 + j] : j < 36 ? F.g2[k] * F.w_re[k * NEXP + (j - 4)] : 0.f;
            hi[e] = f2bf(w); lo[e] = f2bf(w - __uint_as_float(hi[e] << 16)); }
        v4u oh, ol; oh.x = hi[0] | (hi[1] << 16); oh.y = hi[2] | (hi[3] << 16); oh.z = hi[4] | (hi[5] << 16); oh.w = hi[6] | (hi[7] << 16);
        ol.x = lo[0] | (lo[1] << 16); ol.y = lo[2] | (lo[3] << 16); ol.z = lo[4] | (lo[5] << 16); ol.w = lo[6] | (lo[7] << 16);
        *((GAS v4u*)F.Wr + i) = oh; *((GAS v4u*)F.Wr + 3 * 8 * 4 * 64 + i) = ol; }
    for (int i = (gw * 64 + lane); i < SEQ * 32; i += NGW * 64) { const int pos = i >> 5, fi = i & 31;
        double inv = 1.0; for (int q = 0; q < fi; ++q) inv *= 0.74989420933245582730;
        const double rev = (double)pos * inv * 0.15915494309189533577; const float fr = (float)(rev - __builtin_rint(rev));
        typedef float f32x2g __attribute__((ext_vector_type(2))); f32x2g cs; cs.x = __builtin_amdgcn_cosf(fr); cs.y = __builtin_amdgcn_sinf(fr); *(GAS f32x2g*)(F.rope + 2 * (size_t)i) = cs; }
    { f32x4 g[4];
#pragma unroll
      for (int j = 0; j < 4; ++j) g[j] = *((const GAS f32x4*)F.g1 + lane + 64 * j);
      for (int m = 2 * gw; m < T; m += 2 * NGW) {
        const GAS f32x4* xr = (const GAS f32x4*)(F.x + (size_t)m * D) + lane;
        f32x4 v[8]; float s0 = 0.f, s1 = 0.f;
#pragma unroll
        for (int j = 0; j < 8; ++j) v[j] = xr[64 * j];
#pragma unroll
        for (int j = 0; j < 4; ++j) { s0 += (v[j].x * v[j].x + v[j].y * v[j].y) + (v[j].z * v[j].z + v[j].w * v[j].w); s1 += (v[4 + j].x * v[4 + j].x + v[4 + j].y * v[4 + j].y) + (v[4 + j].z * v[4 + j].z + v[4 + j].w * v[4 + j].w); }
        const float r0 = 1.0f / sqrtf(wave_sum(s0) * (1.f / D) + RMS_EPS), r1 = 1.0f / sqrtf(wave_sum(s1) * (1.f / D) + RMS_EPS);
        GAS unsigned long long* o8 = (GAS unsigned long long*)(F.XN + (size_t)m * D) + lane;
#pragma unroll
        for (int j = 0; j < 8; ++j) { const f32x4 gg = g[j & 3]; const float rs = j < 4 ? r0 : r1;
            o8[64 * j] = (unsigned long long)pk2(v[j].x * rs * gg.x, v[j].y * rs * gg.y) | ((unsigned long long)pk2(v[j].z * rs * gg.z, v[j].w * rs * gg.w) << 32); }
      } }
}
#ifndef SWA_ABL
#define SWA_ABL 0
#endif
template <int PART> __device__ __forceinline__ void p2_attention(Frame& F, char* lds) {
    using abf = attn_body::bf16;
#ifndef SKIP_DIFF
    if (PART != 2) for (int L = F.vcu; L < 16 * 64; L += F.G) {
        const int i = L >> 8, v = L & 255, hh = v >> 4, s = v & 15, qb = 32 * (i >> 1) + ((i & 1) ? 31 - s : s);
        const int c = hh & 1, h = (hh >> 1) & 3, b = hh >> 3;
        const abf* base = (const abf*)F.QKV + (size_t)b * SEQ * IN_COLS;
        attn_body::attn_unit_w<8>(base + h * 128 + c * 64, base + 512 + h * 128 + c * 64, base + 1024 + h * 128,
                                  (abf*)F.OD + (size_t)b * SEQ * D + c * 512 + h * 128, (const unsigned*)(F.ctl + CW_KMAX) + (b * 8 + h * 2 + c) * 8, qb * 256, 4 * qb + 4, lds);
        if (F.G == 256 && PART == 0 && i < 3) { constexpr int NREST = I_MOE - MOE_TAIL_ITEMS, SL = (NREST + 2) / 3;
            const int lo_ = i * SL, hi_ = (i + 1) * SL < NREST ? (i + 1) * SL : NREST; moe_weight_items(F, lo_, hi_, F.vcu * NWAVES + F.wave, F.G * NWAVES); __syncthreads(); }
    }
#endif
#ifndef SKIP_SWA
    if (PART != 1) for (int L0 = F.vcu;; L0 += F.G) {
        int L = L0;
        if (PART == 0) { if (F.tid == 0) F.MISC[12] = __hip_atomic_fetch_add(F.ctl + CW_SWAQ, 1u, __ATOMIC_RELAXED, __HIP_MEMORY_SCOPE_AGENT); __syncthreads(); L = (int)F.MISC[12]; __syncthreads(); }
        L = __builtin_amdgcn_readfirstlane(L);
        if (L >= 2 * 2 * 64) break;
        const int qb = L & 63, kvh = (L >> 6) & 1, b = L >> 7;
        const abf* base = (const abf*)F.QKV + (size_t)b * SEQ * IN_COLS;
        float sk[4];
#pragma unroll
        for (int g = 0; g < 4; ++g) sk[g] = F.sinks[kvh * 4 + g] * 1.4426950408889634f;
        attn_body::swa_unit<(PART == 2) ? SWA_ABL : 0>(base + 1536 + kvh * 256, base + 2048 + kvh * 64, base + 2176 + kvh * 64, (abf*)F.MIX + (size_t)b * SEQ * D + 512 + kvh * 256, (const unsigned*)(F.ctl + CW_KMAX) + 128 + (b * 2 + kvh) * 8, qb * 256, sk, lds);
    }
#endif
}
__device__ __forceinline__ void p2b_combine(Frame& F) {
    int lane_ = F.lane; asm volatile("" : "+v"(lane_)); const int gw = F.vcu * NWAVES + F.wave, NGW = F.G * NWAVES, lane = lane_;
    const float lam = __expf(wave_sum(F.lq1[lane] * F.lk1[lane])) - __expf(wave_sum(F.lq2[lane] * F.lk2[lane])) + 0.2f;
    const f32x4 ga = *(const f32x4*)(F.subg + (lane & 15) * 8), gb = *(const f32x4*)(F.subg + (lane & 15) * 8 + 4);
    for (int m = gw; m < T; m += NGW) {
        const v4u a = *(const GAS v4u*)(F.OD + (size_t)m * D + 8 * lane), b = *(const GAS v4u*)(F.OD + (size_t)m * D + 512 + 8 * lane);
        float o[8]; float ss = 0.f;
#pragma unroll
        for (int q = 0; q < 4; ++q) { const unsigned ua = q == 0 ? a.x : q == 1 ? a.y : q == 2 ? a.z : a.w, ub = q == 0 ? b.x : q == 1 ? b.y : q == 2 ? b.z : b.w;
            o[2 * q] = __uint_as_float(ua << 16) - lam * __uint_as_float(ub << 16); o[2 * q + 1] = __uint_as_float(ua & 0xffff0000u) - lam * __uint_as_float(ub & 0xffff0000u);
            ss += o[2 * q] * o[2 * q] + o[2 * q + 1] * o[2 * q + 1]; }
        ss += __shfl_xor(ss, 1); ss += __shfl_xor(ss, 2); ss += __shfl_xor(ss, 4); ss += __shfl_xor(ss, 8);
        const float r = 0.8f / sqrtf(ss * (1.f / 128.f) + RMS_EPS);
        v4u w; w.x = pk2(o[0] * r * ga[0], o[1] * r * ga[1]); w.y = pk2(o[2] * r * ga[2], o[3] * r * ga[3]); w.z = pk2(o[4] * r * gb[0], o[5] * r * gb[1]); w.w = pk2(o[6] * r * gb[2], o[7] * r * gb[3]);
        *(GAS v4u*)(F.MIX + (size_t)m * D + 8 * lane) = w;
    }
}
__device__ __forceinline__ void p4a_router(Frame& F) {
    typedef float f32x4m __attribute__((ext_vector_type(4)));
    LAS int* lcnt = (LAS int*)(F.lds + RING_OFF);
    LAS float* lgs = (LAS float*)(F.lds + RING_OFF + 1024) + F.wave * 768;
    int lane_ = F.lane; asm volatile("" : "+v"(lane_)); const int lane = lane_, n = lane & 15, g = lane >> 4;
    const GAS v4u* Wh = (const GAS v4u*)F.Wr; const GAS v4u* Wl = Wh + 3 * 8 * 4 * 64;
    for (int ch = F.vcu; ch < NCHUNK; ch += F.G) {
        if (F.tid < 32) lcnt[F.tid] = 0;
        __syncthreads();
        const int t = ch * CHUNK_TOK + F.wave * 16 + n;
        const bf16* hrow = F.HB + (size_t)t * D + 32 * g;
        f32x4m acc[3]; acc[0] = (f32x4m){0.f, 0.f, 0.f, 0.f}; acc[1] = acc[0]; acc[2] = acc[0];
        float ss = 0.f;
#pragma unroll 2
        for (int S = 0; S < 8; ++S) {
            v4u hb[4];
#pragma unroll
            for (int q = 0; q < 4; ++q) hb[q] = *(const GAS v4u*)(hrow + 128 * S + 8 * q);
#pragma unroll
            for (int q = 0; q < 4; ++q) {
#pragma unroll
                for (int e = 0; e < 4; ++e) { const unsigned u = e == 0 ? hb[q].x : e == 1 ? hb[q].y : e == 2 ? hb[q].z : hb[q].w; const float a = __uint_as_float(u << 16), c = __uint_as_float(u & 0xffff0000u); ss += a * a + c * c; }
#pragma unroll
                for (int blk = 0; blk < 3; ++blk) { const int fi = ((blk * 8 + S) * 4 + q) * 64 + lane;
                    const v4u wh = Wh[fi], wl = Wl[fi];
                    acc[blk] = __builtin_amdgcn_mfma_f32_16x16x32_bf16(__builtin_bit_cast(bf16x8, wh), __builtin_bit_cast(bf16x8, hb[q]), acc[blk], 0, 0, 0);
                    acc[blk] = __builtin_amdgcn_mfma_f32_16x16x32_bf16(__builtin_bit_cast(bf16x8, wl), __builtin_bit_cast(bf16x8, hb[q]), acc[blk], 0, 0, 0); }
            }
        }
        ss += __shfl_xor(ss, 16); ss += __shfl_xor(ss, 32);
#pragma unroll
        for (int blk = 0; blk < 3; ++blk)
#pragma unroll
            for (int r = 0; r < 4; ++r) lgs[n * 48 + 16 * blk + 4 * g + r] = acc[blk][r];
        LDS_WAIT(); asm volatile("" ::: "memory");
        const LAS float* lg = lgs + n * 48;
        const float rstd = 1.0f / sqrtf(ss * (1.f / D) + RMS_EPS);
        float gl[4];
#pragma unroll
        for (int j = 0; j < 4; ++j) gl[j] = lg[j] * rstd + F.b_rg[j];
        int gi = 0; float gm = gl[0];
#pragma unroll
        for (int j = 1; j < 4; ++j) if (gl[j] > gm) { gm = gl[j]; gi = j; }
        float den = 0.f;
#pragma unroll
        for (int j = 0; j < 4; ++j) den += __expf(gl[j] - gm);
        const float ptop = 1.0f / den;
        float el[8];
#pragma unroll
        for (int i = 0; i < 8; ++i) el[i] = lg[4 + gi * 8 + i] * rstd + F.b_re[gi * 8 + i];
        int i0 = 0; float v0 = el[0];
#pragma unroll
        for (int i = 1; i < 8; ++i) if (el[i] > v0) { v0 = el[i]; i0 = i; }
        int i1 = -1; float v1 = -INFINITY;
#pragma unroll
        for (int i = 0; i < 8; ++i) if (i != i0 && el[i] > v1) { v1 = el[i]; i1 = i; }
        const float e1w = __expf(v1 - v0), gt0 = ptop / (1.0f + e1w), gt1 = gt0 * e1w;
        if (g == 0) { const int e0 = gi * 8 + i0, e1 = gi * 8 + i1;
            F.tok_e[2 * t] = e0; F.tok_e[2 * t + 1] = e1; F.tok_g[2 * t] = gt0; F.tok_g[2 * t + 1] = gt1; F.tok_rstd[t] = rstd;
            atomicAdd((int*)&lcnt[e0], 1); atomicAdd((int*)&lcnt[e1], 1); }
        __syncthreads();
        if (F.tid < 32) F.cnt[ch * 32 + F.tid] = lcnt[F.tid];
        __syncthreads();
    }
}
__device__ __forceinline__ void p4b_scatter(Frame& F) {
    LAS int* E = (LAS int*)(F.lds + RING_OFF);
    LAS int* SL = E + 256;
    LAS int* base = SL + 256;
    LAS int* padded = base + 32;
    LAS int* padlo = padded + 32;
    LAS int* padhi = padlo + 32;
    LAS int* ptot = padhi + 32; LAS int* ppre = ptot + 512;
    int tid_ = F.tid; asm volatile("" : "+v"(tid_)); const int tid = tid_;
    for (int ch = F.vcu; ch < NCHUNK; ch += F.G) {
        int pre = 0, total = 0;
        if (tid < 256) E[tid] = F.tok_e[ch * 256 + tid];
        { const int e_ = tid & 31, part = tid >> 5; int tsum = 0, psum = 0;
#pragma unroll
          for (int q = 0; q < 16; ++q) { const int c2 = part * 16 + q; const int vv = F.cnt[c2 * 32 + e_]; tsum += vv; psum += (c2 < ch) ? vv : 0; }
          ptot[part * 32 + e_] = tsum; ppre[part * 32 + e_] = psum; }
        __syncthreads();
        if (tid < 32) {
#pragma unroll
            for (int q = 0; q < 16; ++q) { total += ptot[q * 32 + tid]; pre += ppre[q * 32 + tid]; }
            padded[tid] = (total + 255) & ~255; }
        __syncthreads();
        if (tid < 32) { int ps = 0; for (int e2 = 0; e2 < tid; ++e2) ps += padded[e2];
            base[tid] = ps + pre; padlo[tid] = ps + total; padhi[tid] = ps + padded[tid];
            if (ch == 0) { for (int rb = ps >> 8; rb < ((ps + padded[tid]) >> 8); ++rb) F.blk_e[rb] = (unsigned)tid; if (tid == 31) __hip_atomic_store(F.ctl + CW_NBU, (unsigned)((ps + padded[tid]) >> 8), RLX_AGENT); } }
        __syncthreads();
        if (tid < 256) { const int e = E[tid]; int rank = 0; for (int a2 = 0; a2 < tid; ++a2) rank += (E[a2] == e) ? 1 : 0;
            const int slot = base[e] + rank; SL[tid] = slot;
            F.slot_dst[slot] = ch * 256 + tid; F.slot_tok[slot] = ch * CHUNK_TOK + (tid >> 1); F.slot_gate[slot] = F.tok_g[ch * 256 + tid]; F.slot_rstd[slot] = F.tok_rstd[ch * CHUNK_TOK + (tid >> 1)]; }
        __syncthreads();
        if (ch < NEXP) { const int lo = padlo[ch], hi = padhi[ch];
            for (int s = lo + tid; s < hi; s += NWAVES * 64) { F.slot_dst[s] = -1; F.slot_tok[s] = 0; F.slot_gate[s] = 0.f; F.slot_rstd[s] = 0.f; } }
        __syncthreads();
    }
}
__device__ __forceinline__ void p6_final(Frame& F) {
    int lane_ = F.lane; asm volatile("" : "+v"(lane_)); const int gw = F.vcu * NWAVES + F.wave, NGW = F.G * NWAVES, lane = lane_;
    f32x4 g[4];
#pragma unroll
    for (int j = 0; j < 4; ++j) g[j] = *((const GAS f32x4*)F.gf + 2 * lane + (j & 1) + 128 * (j >> 1));
    for (int m = gw; m < T; m += NGW) {
        const GAS v4u* hr = (const GAS v4u*)(F.HB + (size_t)m * D) + lane; const GAS v4u* y0 = (const GAS v4u*)(F.Y + (size_t)(2 * m) * D) + lane; const GAS v4u* y1 = (const GAS v4u*)(F.Y + (size_t)(2 * m + 1) * D) + lane;
        v4u a[2], b[2], c[2];
#pragma unroll
        for (int j = 0; j < 2; ++j) { a[j] = hr[64 * j]; b[j] = y0[64 * j]; c[j] = y1[64 * j]; }
        float v[16]; float s = 0.f;
#pragma unroll
        for (int j = 0; j < 2; ++j)
#pragma unroll
            for (int q = 0; q < 4; ++q) { const unsigned ua = q == 0 ? a[j].x : q == 1 ? a[j].y : q == 2 ? a[j].z : a[j].w, ub = q == 0 ? b[j].x : q == 1 ? b[j].y : q == 2 ? b[j].z : b[j].w, uc = q == 0 ? c[j].x : q == 1 ? c[j].y : q == 2 ? c[j].z : c[j].w;
                const float lo = __uint_as_float(ua << 16) + __uint_as_float(ub << 16) + __uint_as_float(uc << 16), hi = __uint_as_float(ua & 0xffff0000u) + __uint_as_float(ub & 0xffff0000u) + __uint_as_float(uc & 0xffff0000u);
                v[8 * j + 2 * q] = lo; v[8 * j + 2 * q + 1] = hi; s += lo * lo + hi * hi; }
        const float rstd = 1.0f / sqrtf(wave_sum(s) * (1.f / D) + RMS_EPS);
        GAS f32x4* orow = (GAS f32x4*)(F.out + (size_t)m * D) + 2 * lane;
#pragma unroll
        for (int j = 0; j < 2; ++j) { const f32x4 g0 = g[2 * j], g1 = g[2 * j + 1];
            orow[128 * j] = (f32x4){v[8 * j] * rstd * g0.x, v[8 * j + 1] * rstd * g0.y, v[8 * j + 2] * rstd * g0.z, v[8 * j + 3] * rstd * g0.w};
            orow[128 * j + 1] = (f32x4){v[8 * j + 4] * rstd * g1.x, v[8 * j + 5] * rstd * g1.y, v[8 * j + 6] * rstd * g1.z, v[8 * j + 7] * rstd * g1.w}; }
    }
}

struct Args { const float* in[19]; float* out; unsigned char* ws; };
__global__ void __launch_bounds__(NWAVES * 64, 2) hymba_fwd(Args args) {
    extern __shared__ __attribute__((aligned(16))) unsigned char lds[];
    Frame F;
    F.lds = (LAS unsigned char*)lds;
    F.MISC = (volatile LAS unsigned*)(F.lds + MISC_OFF);
    F.tid = threadIdx.x; F.lane = F.tid & 63; F.wave = __builtin_amdgcn_readfirstlane(F.tid >> 6);
    F.G = gridDim.x; { const int bx = blockIdx.x; F.vcu = (F.G % 8 == 0) ? (bx % 8) * (F.G / 8) + bx / 8 : bx; }
    unsigned char* ws = args.ws;
    F.ctl = (gu32*)(ws + WS_CTL);
    F.x = args.in[0]; F.g1 = args.in[1]; F.w_in = args.in[2]; F.lq1 = args.in[3]; F.lk1 = args.in[4]; F.lq2 = args.in[5]; F.lk2 = args.in[6]; F.subg = args.in[7]; F.sinks = args.in[8];
    F.w_out = args.in[9]; F.g2 = args.in[10]; F.w_rg = args.in[11]; F.b_rg = args.in[12]; F.w_re = args.in[13]; F.b_re = args.in[14]; F.w_gate = args.in[15]; F.w_up = args.in[16]; F.w_down = args.in[17]; F.gf = args.in[18];
    F.out = args.out;
    F.Win_t = (bf16*)(ws + WS_WIN); F.Wo_t = (bf16*)(ws + WS_WO); F.Wgu_t = (bf16*)(ws + WS_WGU); F.Wd_t = (bf16*)(ws + WS_WD);
    F.XN = (bf16*)(ws + WS_A); F.OD = F.XN; F.HB = F.XN; F.MIX = (bf16*)(ws + WS_MIX); F.Y = F.MIX; F.QKV = (bf16*)(ws + WS_QKV); F.XS = F.QKV; F.HM = (bf16*)(ws + WS_HM);
    F.Wr = (float*)(ws + WS_WR); F.rope = (float*)(ws + WS_ROPE);
    { unsigned char* p = ws + WS_TOK; F.tok_e = (int*)p; p += (size_t)T * 8; F.tok_g = (float*)p; p += (size_t)T * 8; F.tok_rstd = (float*)p; p += (size_t)T * 4; F.cnt = (int*)p; p += NCHUNK * 32 * 4;
      F.blk_e = (unsigned*)p; p += 288 * 4; F.slot_dst = (int*)p; p += (size_t)PSLOTS * 4; F.slot_gate = (float*)p; p += (size_t)PSLOTS * 4; F.slot_rstd = (float*)p; p += (size_t)PSLOTS * 4; F.slot_tok = (int*)p; }
    for (int u = F.tid; u < (LDS_BYTES - LDSCTL_OFF) / 4; u += NWAVES * 64) ((LAS unsigned*)(F.lds + LDSCTL_OFF))[u] = 0u;
    __syncthreads();
    XcdBarrier bar = xcd_barrier_post((unsigned*)(F.ctl + CW_BAR), F.MISC + 8);
    if (F.tid == 0) F.MISC[13] = __hip_atomic_fetch_add(F.ctl + CW_RANK + bar.x, 1u, RLX_AGENT);
#define GRID_BAR() xcd_barrier(bar)

#define RUN_P0() p0_prologue(F)
#define RUN_P1() do { pg8::Gemm g{F.XN, F.Win_t, T, IN_COLS, D}; pg8::StaticOrder S; S.init(T, IN_COLS, F.G, (int)blockIdx.x); \
      pg8::EpiQKV E{F.QKV, F.rope, attn_body::C2, 0, (unsigned*)(F.ctl + CW_KMAX)}; \
      pg8::gemm_phase<pg8::EpiQKV, pg8::StaticOrder, PG8_ALIGN, PG8_SP2>(F.lds + RING_OFF, g, S, E); \
      if (F.G == 256 && blockIdx.x >= 128) moe_weight_items(F, I_MOE - MOE_TAIL_ITEMS, I_MOE, ((int)blockIdx.x - 128) * NWAVES + F.wave, 128 * NWAVES); } while (0)
#define RUN_P2() p2_attention<0>(F, (char*)lds + RING_OFF)
#define RUN_P2B() p2b_combine(F)
#define RUN_P3() do { pg8::Gemm g{F.MIX, F.Wo_t, T, D, D}; pg8::StaticOrder S; S.init(T, D, F.G, (int)blockIdx.x); \
      pg8::EpiResid E{F.x, F.HB}; \
      pg8::gemm_phase<pg8::EpiResid, pg8::StaticOrder, PG8_ALIGN, PG8_SP2>(F.lds + RING_OFF, g, S, E); } while (0)
#define RUN_P4A() p4a_router(F)
#define RUN_P4B() p4b_scatter(F)
#define RUN_P5() do { const int nbu = __builtin_amdgcn_readfirstlane((int)__hip_atomic_load(F.ctl + CW_NBU, RLX_AGENT)); \
      const int pre_ = __builtin_amdgcn_readfirstlane((int)F.MISC[16]), nloc_ = __builtin_amdgcn_readfirstlane((int)F.MISC[17]), rank_ = __builtin_amdgcn_readfirstlane((int)F.MISC[13]); \
      const int lo_ = (int)(((long)nbu * pre_) / F.G), hi_ = (int)(((long)nbu * (pre_ + nloc_)) / F.G); \
      { pg8::Gemm g{F.HB, F.Wgu_t, PSLOTS, NEXP * 1024, D}; pg8::XcdSched S{F.blk_e, lo_, hi_, rank_, nloc_, (unsigned*)(F.ctl + CW_DONE)}; \
        LAS int* rowtab = (LAS int*)(F.lds + ROWTAB_OFF); pg8::Unit uu; \
        for (int ui = 0; ui < ROWTAB_UNITS && S.next(ui, uu); ++ui) if (F.tid < 256) rowtab[ui * 256 + F.tid] = F.slot_tok[uu.pm * 256 + F.tid];     \
        __syncthreads(); \
        pg8::EpiGateUp E{F.HM, F.slot_rstd}; \
        pg8::gemm_phase<pg8::EpiGateUp, pg8::XcdSched, PG8_ALIGN, true, true>(F.lds + RING_OFF, g, S, E, rowtab); } \
      { pg8::Gemm g{F.HM, F.Wd_t, PSLOTS, NEXP * 1024, FF}; pg8::XcdDyn S{F.blk_e, lo_, hi_, (unsigned*)(F.ctl + CW_BQ + bar.x), (unsigned*)(F.ctl + CW_DONE), F.MISC + 14, 0u}; \
        pg8::EpiDown E{F.Y, F.slot_dst, F.slot_gate}; \
        pg8::gemm_phase<pg8::EpiDown, pg8::XcdDyn, PG8_ALIGN, true>(F.lds + RING_OFF, g, S, E); } } while (0)
#ifdef DUP_P0
    RUN_P0(); GRID_BAR();
#endif
    RUN_P0(); GRID_BAR();
    if (F.wave == 0) { unsigned cj = 0u; if (F.lane < 16) cj = xb_ld(bar.bar + XB_XCNT(F.lane)); unsigned pre = 0u, mine = 1u;
#pragma unroll
        for (unsigned j = 0; j < 16u; ++j) { const unsigned v = (unsigned)__builtin_amdgcn_readlane((int)cj, (int)j); if (j < bar.x) pre += v; if (j == bar.x) mine = v; }
        if (F.lane == 0) { F.MISC[16] = pre; F.MISC[17] = mine; } }
#ifdef DUP_P1
    { pg8::Gemm g{F.XN, F.Win_t, T, IN_COLS, D}; pg8::StaticOrder S; S.init(T, IN_COLS, F.G, (int)blockIdx.x);
      pg8::EpiQKV E{F.QKV, F.rope, attn_body::C2, DUP_P1, (unsigned*)(F.ctl + CW_KMAX)};
      pg8::gemm_phase<pg8::EpiQKV, pg8::StaticOrder, PG8_ALIGN, PG8_SP2>(F.lds + RING_OFF, g, S, E); }
    GRID_BAR();
#endif
    RUN_P1(); GRID_BAR();
#ifdef DUP_P2
    p2_attention<DUP_P2>(F, (char*)lds + RING_OFF); GRID_BAR();
#endif
    RUN_P2(); GRID_BAR();
#ifdef DUP_P2B
    RUN_P2B(); GRID_BAR();
#endif
    RUN_P2B(); GRID_BAR();
#ifdef DUP_P3
    RUN_P3(); GRID_BAR();
#endif
    RUN_P3(); GRID_BAR();
#ifdef DUP_P4A
    RUN_P4A(); GRID_BAR();
#endif
    RUN_P4A(); GRID_BAR();
#ifdef DUP_P4B
    RUN_P4B(); GRID_BAR();
#endif
    RUN_P4B(); GRID_BAR();
    RUN_P5(); GRID_BAR();
#ifndef SKIP_P6
    p6_final(F);
#endif
}

extern "C" void kernel_launch(void* const* d_in, const int* in_sizes, int n_in, void* d_out, int out_size, void* d_ws, size_t ws_size, hipStream_t stream) {
    static int grid = 0;
    if (grid == 0) {
        if (n_in != 19 || in_sizes[0] != T * D || out_size != T * D || ws_size < WS_END) { fprintf(stderr, "kernel_launch: unexpected shapes (n_in %d, in0 %d, out %d, ws %zu); nothing launched\n", n_in, n_in > 0 ? in_sizes[0] : -1, out_size, ws_size); grid = -1; return; }
        int dev = 0, cus = 0, per_cu = 0;
        if (hipGetDevice(&dev) != hipSuccess || hipDeviceGetAttribute(&cus, hipDeviceAttributeMultiprocessorCount, dev) != hipSuccess) { grid = -1; return; }
        if (hipFuncSetAttribute((const void*)hymba_fwd, hipFuncAttributeMaxDynamicSharedMemorySize, LDS_BYTES) != hipSuccess) { grid = -1; return; }
        if (hipOccupancyMaxActiveBlocksPerMultiprocessor(&per_cu, (const void*)hymba_fwd, NWAVES * 64, LDS_BYTES) != hipSuccess || per_cu < 1) { fprintf(stderr, "kernel_launch: occupancy query reports %d\n", per_cu); }
        (void)hipGetLastError();
        grid = cus;
    }
    if (grid < 0) return;
    if (hipMemsetAsync((char*)d_ws + WS_CTL, 0, CTL_ZERO_BYTES, stream) != hipSuccess) return;
    Args a{};
    for (int i = 0; i < 19; ++i) a.in[i] = (const float*)d_in[i];
    a.out = (float*)d_out; a.ws = (unsigned char*)d_ws;
    hipLaunchKernelGGL(hymba_fwd, dim3(grid), dim3(NWAVES * 64), LDS_BYTES, stream, a);
}
```
